# Optimizing an MI355X kernel written in HIP

```python
import jax, jax.numpy as jnp
from jax import lax
import numpy as np

D_MODEL = 1024
BATCH = 4
SEQ = 4096
DEPTH = 1

CTX_LEN = 256
GRID_W = 64
N_MOD = 6
EPS = 1e-6

GLA_HEADS = 4
GLA_DK = 64
GLA_DV = 128
GLA_LR = 16
GLA_TAU = 16.0
GLA_CHUNK = 64

ML_HEADS = 4
ML_DH = 128
ML_CHUNK = 64
CONV_K = 3

N_GROUPS = 4
EXP_PER_GROUP = 8
N_EXPERTS = N_GROUPS * EXP_PER_GROUP
TOP_K = 2
D_EXPERT = 512
MOE_BLOCK = 128

GLA_QK_W = GLA_HEADS * GLA_DK
GLA_V_W = GLA_HEADS * GLA_DV
ML_W = ML_HEADS * ML_DH
MIX_W = GLA_V_W + ML_W

IN_SPLITS = (GLA_QK_W, GLA_QK_W, GLA_V_W, GLA_V_W, 2 * GLA_LR, 2 * ML_W, ML_W, ML_W, 2 * ML_HEADS, 2 * ML_HEADS)
IN_W = sum(IN_SPLITS)

kernel_name = "hybrid_gla_mlstm_hmoe_ctxprefix_layer"


def rmsnorm(x, g):
    xf = x.astype(jnp.float32)
    y = xf * lax.rsqrt(jnp.mean(xf * xf, axis=-1, keepdims=True) + EPS)
    return (y * g.astype(jnp.float32)).astype(x.dtype)


def modulate(h, shift, scale):
    return h * (1 + scale) + shift


def to_heads(t, n_heads):
    b, l, w = t.shape
    return t.reshape(b, l, n_heads, w // n_heads).transpose(0, 2, 1, 3)


def from_heads(t):
    b, h, l, d = t.shape
    return t.transpose(0, 2, 1, 3).reshape(b, l, h * d)


def head_rmsnorm(t, g):
    y = t * lax.rsqrt(jnp.mean(t * t, axis=-1, keepdims=True) + EPS)
    return from_heads(y) * g.astype(jnp.float32)


def to_chunks(t, c):
    b, h, l = t.shape[:3]
    return jnp.moveaxis(t.reshape((b, h, l // c, c) + t.shape[3:]), 2, 0)


def from_chunks(t):
    n, b, h, c = t.shape[:4]
    return jnp.moveaxis(t, 0, 2).reshape((b, h, n * c) + t.shape[4:])


def flip_time(t):
    return jnp.flip(t, axis=2)


def gla_chunked(q, k, v, log_a, s0):
    mask = jnp.tril(jnp.ones((GLA_CHUNK, GLA_CHUNK), dtype=bool))

    def step(s, inp):
        qc, kc, vc, gc = inp
        b = jnp.cumsum(gc, axis=2)
        q_t = qc * jnp.exp(b)
        k_t = kc * jnp.exp(-b)
        att = jnp.where(mask, jnp.einsum('bhtd,bhsd->bhts', q_t, k_t), 0.0)
        o = jnp.einsum('bhts,bhsv->bhtv', att, vc) + jnp.einsum('bhtd,bhdv->bhtv', q_t, s)
        b_end = b[:, :, -1]
        s_new = jnp.exp(b_end)[..., None] * s + jnp.einsum(
            'bhsd,bhsv->bhdv', kc * jnp.exp(b_end[:, :, None] - b), vc)
        return s_new, o

    s_fin, o = lax.scan(step, s0, tuple(to_chunks(t, GLA_CHUNK) for t in (q, k, v, log_a)))
    return from_chunks(o), s_fin


def mlstm_chunked(q, k, v, ig, lf, state0):
    mask = jnp.tril(jnp.ones((ML_CHUNK, ML_CHUNK), dtype=bool))

    def step(state, inp):
        s, n, m = state
        qc, kc, vc, ic, fc = inp
        a = jnp.cumsum(fc, axis=-1)
        dmat = jnp.where(mask, a[..., :, None] - a[..., None, :] + ic[..., None, :], -jnp.inf)
        inter = a + m[..., None]
        m_t = jnp.maximum(inter, jnp.max(dmat, axis=-1))
        w_inter = jnp.exp(inter - m_t)
        qk = jnp.einsum('bhtd,bhsd->bhts', qc, kc) * jnp.exp(dmat - m_t[..., None])
        num = jnp.einsum('bhts,bhsv->bhtv', qk, vc) + w_inter[..., None] * jnp.einsum('bhtd,bhdv->bhtv', qc, s)
        den = jnp.sum(qk, axis=-1) + w_inter * jnp.einsum('bhtd,bhd->bht', qc, n)
        h = num / jnp.maximum(jnp.abs(den), jnp.exp(-m_t))[..., None]
        a_end = a[..., -1]
        g = a_end[..., None] - a + ic
        m_new = jnp.maximum(a_end + m, jnp.max(g, axis=-1))
        decay = jnp.exp(a_end + m - m_new)
        kw = kc * jnp.exp(g - m_new[..., None])[..., None]
        s_new = decay[..., None, None] * s + jnp.einsum('bhsd,bhsv->bhdv', kw, vc)
        n_new = decay[..., None] * n + jnp.sum(kw, axis=2)
        return (s_new, n_new, m_new), h

    state_fin, h = lax.scan(step, state0, tuple(to_chunks(t, ML_CHUNK) for t in (q, k, v, ig, lf)))
    return from_chunks(h), state_fin


def bidir(scan_fn, ctx_dirs, lat_dirs, init):
    outs_c, outs_l = [], []
    for direction in range(2):
        fl = flip_time if direction == 1 else (lambda t: t)
        oc, st = scan_fn(*[fl(t) for t in ctx_dirs[direction]], init)
        ol, _ = scan_fn(*[fl(t) for t in lat_dirs[direction]], st)
        outs_c.append(fl(oc))
        outs_l.append(fl(ol))
    return outs_c[0] + outs_c[1], outs_l[0] + outs_l[1]


def grid_conv(t, w, b, grid_w):
    bsz, l, ch = t.shape
    rows = l // grid_w
    img = t.reshape(bsz, rows, grid_w, ch)
    y = lax.conv_general_dilated(img, w.astype(t.dtype), (1, 1), 'SAME',
                                 dimension_numbers=('NHWC', 'HWIO', 'NHWC'), feature_group_count=ch)
    return y.reshape(bsz, l, ch) + b


def prepare_stream(z, grid_w, gla_up_w, gla_up_b, conv_w, conv_b, ml_i_b, ml_f_b):
    bsz, l, _ = z.shape
    zf = z.astype(jnp.float32)
    idx = np.cumsum(IN_SPLITS)[:-1].tolist()
    gq, gk, gv, gg, glr, mqk, mv, mo, mi, mf = jnp.split(zf, idx, axis=-1)
    gla_q = to_heads(gq, GLA_HEADS) * (GLA_DK ** -0.5)
    gla_k = to_heads(gk, GLA_HEADS)
    gla_v = to_heads(gv, GLA_HEADS)
    gate_logits = jnp.einsum('blrk,rkn->blrn', glr.reshape(bsz, l, 2, GLA_LR), gla_up_w) + gla_up_b
    log_a = jax.nn.log_sigmoid(gate_logits) / GLA_TAU
    gla_dirs = tuple((gla_q, gla_k, gla_v, to_heads(log_a[:, :, d], GLA_HEADS)) for d in range(2))
    qk = jax.nn.silu(grid_conv(mqk, conv_w, conv_b, grid_w))
    mq, mk = jnp.split(qk, 2, axis=-1)
    ml_q = to_heads(mq, ML_HEADS)
    ml_k = to_heads(mk, ML_HEADS) * (ML_DH ** -0.5)
    ml_v = to_heads(mv, ML_HEADS)
    ig = (mi.reshape(bsz, l, 2, ML_HEADS) + ml_i_b).transpose(2, 0, 3, 1)
    lf = jax.nn.log_sigmoid(mf.reshape(bsz, l, 2, ML_HEADS) + ml_f_b).transpose(2, 0, 3, 1)
    ml_dirs = tuple((ml_q, ml_k, ml_v, ig[d], lf[d]) for d in range(2))
    return gla_dirs, ml_dirs, gg, mo


def mixer_output(gla_h, ml_h, gg, mo, gla_norm_g, ml_norm_g, w_out, dtype):
    gla_o = head_rmsnorm(gla_h, gla_norm_g) * jax.nn.silu(gg)
    ml_o = jax.nn.sigmoid(mo) * head_rmsnorm(ml_h, ml_norm_g)
    return jnp.concatenate([gla_o, ml_o], axis=-1).astype(dtype) @ w_out


def hier_moe(h, rg_w, rg_b, re_w, re_b, e_w_in, e_w_out):
    bsz, l, d = h.shape
    t = bsz * l
    tok = h.reshape(t, d)
    g_logits = (tok @ rg_w + rg_b).astype(jnp.float32)
    p_group = jax.nn.softmax(g_logits, axis=-1)
    g_idx = jnp.argmax(g_logits, axis=-1)
    g_w = jnp.take_along_axis(p_group, g_idx[:, None], axis=-1)
    e_logits = (tok @ re_w + re_b).astype(jnp.float32).reshape(t, N_GROUPS, EXP_PER_GROUP)
    e_in_group = jnp.take_along_axis(e_logits, g_idx[:, None, None], axis=1)[:, 0]
    top_v, top_i = lax.top_k(e_in_group, TOP_K)
    weights = g_w * jax.nn.softmax(top_v, axis=-1)
    expert_ids = (g_idx[:, None] * EXP_PER_GROUP + top_i).reshape(-1)
    n_assign = t * TOP_K
    order = jnp.argsort(expert_ids)
    sorted_e = expert_ids[order]
    token_of = order // TOP_K
    counts = jnp.bincount(expert_ids, length=N_EXPERTS)
    padded = (counts + MOE_BLOCK - 1) // MOE_BLOCK * MOE_BLOCK
    pad_end = jnp.cumsum(padded)
    pad_start = pad_end - padded
    start = jnp.cumsum(counts) - counts
    dest = pad_start[sorted_e] + jnp.arange(n_assign) - start[sorted_e]
    n_blocks = (n_assign + MOE_BLOCK - 1) // MOE_BLOCK + N_EXPERTS
    buf = jnp.zeros((n_blocks * MOE_BLOCK, d), tok.dtype).at[dest].set(tok[token_of])
    block_e = jnp.minimum(jnp.searchsorted(pad_end, jnp.arange(n_blocks) * MOE_BLOCK, side='right'), N_EXPERTS - 1)

    def expert_block(args):
        xb, e = args
        gate, up = jnp.split(xb @ e_w_in[e], 2, axis=-1)
        return (jax.nn.silu(gate) * up) @ e_w_out[e]

    yb = lax.map(expert_block, (buf.reshape(n_blocks, MOE_BLOCK, d), block_e)).reshape(-1, d)
    y = yb[dest] * weights.reshape(-1)[order][:, None].astype(yb.dtype)
    out = jax.ops.segment_sum(y, token_of, num_segments=t)
    return out.reshape(bsz, l, d)


def hybrid_layer(x, ctx, c, c_ctx, ada_w, ada_b, norm1_g, w_in, gla_up_w, gla_up_b, gla_norm_g,
                 ml_conv_w, ml_conv_b, ml_i_b, ml_f_b, ml_norm_g, w_out, norm2_g,
                 rg_w, rg_b, re_w, re_b, e_w_in, e_w_out, update_ctx):
    bsz = x.shape[0]
    mod_x = (jax.nn.silu(c) @ ada_w + ada_b)[:, None, :]
    mod_c = (jax.nn.silu(c_ctx) @ ada_w + ada_b)[None, None, :]
    sh1x, sc1x, g1x, sh2x, sc2x, g2x = jnp.split(mod_x, N_MOD, axis=-1)
    sh1c, sc1c, g1c, sh2c, sc2c, g2c = jnp.split(mod_c, N_MOD, axis=-1)

    zx = modulate(rmsnorm(x, norm1_g), sh1x, sc1x) @ w_in
    zc = modulate(rmsnorm(ctx, norm1_g), sh1c, sc1c) @ w_in
    gla_c, ml_c, gg_c, mo_c = prepare_stream(zc, zc.shape[1], gla_up_w, gla_up_b, ml_conv_w, ml_conv_b, ml_i_b, ml_f_b)
    gla_x, ml_x, gg_x, mo_x = prepare_stream(zx, GRID_W, gla_up_w, gla_up_b, ml_conv_w, ml_conv_b, ml_i_b, ml_f_b)
    gla_init = jnp.zeros((bsz, GLA_HEADS, GLA_DK, GLA_DV), jnp.float32)
    ml_init = (jnp.zeros((bsz, ML_HEADS, ML_DH, ML_DH), jnp.float32),
               jnp.zeros((bsz, ML_HEADS, ML_DH), jnp.float32),
               jnp.zeros((bsz, ML_HEADS), jnp.float32))
    gla_hc, gla_hx = bidir(gla_chunked, gla_c, gla_x, gla_init)
    ml_hc, ml_hx = bidir(mlstm_chunked, ml_c, ml_x, ml_init)
    x = x + g1x * mixer_output(gla_hx, ml_hx, gg_x, mo_x, gla_norm_g, ml_norm_g, w_out, x.dtype)

    x = x + g2x * hier_moe(modulate(rmsnorm(x, norm2_g), sh2x, sc2x), rg_w, rg_b, re_w, re_b, e_w_in, e_w_out)

    if update_ctx:
        ctx = ctx + g1c * mixer_output(gla_hc, ml_hc, gg_c, mo_c, gla_norm_g, ml_norm_g, w_out, ctx.dtype)
        ctx = ctx + g2c * hier_moe(modulate(rmsnorm(ctx, norm2_g), sh2c, sc2c), rg_w, rg_b, re_w, re_b, e_w_in, e_w_out)
    return x, ctx


def setup_inputs(seed: int = 0) -> dict:
    key = jax.random.key(seed)
    ks = jax.random.split(key, 26)
    nrm = lambda k, shape, s: jax.random.normal(k, shape, jnp.float32) * s
    L = DEPTH
    return {
        "x": nrm(ks[0], (BATCH, SEQ, D_MODEL), 1.0),
        "c": nrm(ks[1], (BATCH, D_MODEL), 1.0),
        "ctx": nrm(ks[2], (BATCH, CTX_LEN, D_MODEL), 1.0),
        "c_ctx": nrm(ks[3], (D_MODEL,), 1.0),
        "ada_w": nrm(ks[4], (L, D_MODEL, N_MOD * D_MODEL), D_MODEL ** -0.5),
        "ada_b": nrm(ks[5], (L, N_MOD * D_MODEL), 0.02),
        "norm1_g": 1.0 + nrm(ks[6], (L, D_MODEL), 0.02),
        "w_in": nrm(ks[7], (L, D_MODEL, IN_W), D_MODEL ** -0.5),
        "gla_up_w": nrm(ks[8], (L, 2, GLA_LR, GLA_QK_W), GLA_LR ** -0.5),
        "gla_up_b": nrm(ks[9], (L, 2, GLA_QK_W), 0.1),
        "gla_norm_g": 1.0 + nrm(ks[10], (L, GLA_V_W), 0.02),
        "ml_conv_w": nrm(ks[11], (L, CONV_K, CONV_K, 1, 2 * ML_W), 1.0 / CONV_K),
        "ml_conv_b": nrm(ks[12], (L, 2 * ML_W), 0.02),
        "ml_i_b": nrm(ks[13], (L, 2, ML_HEADS), 0.1),
        "ml_f_b": 3.0 + nrm(ks[14], (L, 2, ML_HEADS), 0.5),
        "ml_norm_g": 1.0 + nrm(ks[15], (L, ML_W), 0.02),
        "w_out": nrm(ks[16], (L, MIX_W, D_MODEL), MIX_W ** -0.5),
        "norm2_g": 1.0 + nrm(ks[17], (L, D_MODEL), 0.02),
        "router_group_w": nrm(ks[18], (L, D_MODEL, N_GROUPS), D_MODEL ** -0.5),
        "router_group_b": nrm(ks[19], (L, N_GROUPS), 0.01),
        "router_expert_w": nrm(ks[20], (L, D_MODEL, N_EXPERTS), D_MODEL ** -0.5),
        "router_expert_b": nrm(ks[21], (L, N_EXPERTS), 0.01),
        "expert_w_in": nrm(ks[22], (L, N_EXPERTS, D_MODEL, 2 * D_EXPERT), D_MODEL ** -0.5),
        "expert_w_out": nrm(ks[23], (L, N_EXPERTS, D_EXPERT, D_MODEL), D_EXPERT ** -0.5),
        "final_norm_g": 1.0 + nrm(ks[24], (D_MODEL,), 0.02),
    }


def reference(x, c, ctx, c_ctx, ada_w, ada_b, norm1_g, w_in, gla_up_w, gla_up_b, gla_norm_g,
              ml_conv_w, ml_conv_b, ml_i_b, ml_f_b, ml_norm_g, w_out, norm2_g,
              router_group_w, router_group_b, router_expert_w, router_expert_b,
              expert_w_in, expert_w_out, final_norm_g):
    for layer in range(DEPTH):
        x, ctx = hybrid_layer(
            x, ctx, c, c_ctx, ada_w[layer], ada_b[layer], norm1_g[layer], w_in[layer],
            gla_up_w[layer], gla_up_b[layer], gla_norm_g[layer],
            ml_conv_w[layer], ml_conv_b[layer], ml_i_b[layer], ml_f_b[layer], ml_norm_g[layer],
            w_out[layer], norm2_g[layer],
            router_group_w[layer], router_group_b[layer], router_expert_w[layer], router_expert_b[layer],
            expert_w_in[layer], expert_w_out[layer], update_ctx=(layer < DEPTH - 1))
    return rmsnorm(x, final_norm_g)
```

```cpp
#include <hip/hip_runtime.h>
#include <hip/hip_cooperative_groups.h>
#include <cstdio>
namespace cg = cooperative_groups;

#ifndef N_LAUNCH_MODE
#define N_LAUNCH_MODE 0
#endif

#define LAS __attribute__((address_space(3)))
typedef unsigned short bf16_t;
typedef short bf16x8 __attribute__((ext_vector_type(8)));
typedef float f32x4 __attribute__((ext_vector_type(4)));
typedef float f32x16 __attribute__((ext_vector_type(16)));
typedef unsigned u32x2 __attribute__((ext_vector_type(2)));
typedef unsigned u32x4 __attribute__((ext_vector_type(4)));

constexpr int D = 1024, NB = 4, SEQ = 4096, CTXL = 256;
constexpr int MX = NB * SEQ, MC = NB * CTXL, MT = MX + MC;
constexpr int INW = 3632, ZLD = 3584, NPADW = 3840;
constexpr int NCH = 68;
constexpr int NSTATE = NB * 4 * NCH;
constexpr float EPS = 1e-6f;
constexpr int NTHR = 512;
constexpr int LDS_BYTES = 160 * 1024;

constexpr size_t MiB = 1u << 20;
constexpr size_t WS_CTL = 0;
constexpr size_t WS_MOD = 1 * MiB;
constexpr size_t WS_ROUTE = 2 * MiB;
constexpr size_t WS_GDEC = 3 * MiB;
constexpr size_t WS_MN = 4 * MiB;
constexpr size_t WS_MSC = 6 * MiB;
constexpr size_t WS_GATES = 7 * MiB;
constexpr size_t WS_WINT = 11 * MiB;
constexpr size_t WS_WOUTT = 19 * MiB;
constexpr size_t WS_E1T = 21 * MiB;
constexpr size_t WS_E2T = 85 * MiB;
constexpr size_t WS_A = 117 * MiB;
constexpr size_t WS_Z = 151 * MiB;
constexpr size_t WS_MQ = 270 * MiB;
constexpr size_t WS_MK = 287 * MiB;
constexpr size_t WS_UG = 304 * MiB;
constexpr size_t WS_UM = 338 * MiB;
constexpr size_t WS_END = 406 * MiB;
constexpr int CW_CNT = 64;

struct P { const float* in[25]; float* out; unsigned char* ws; int ph_lo, ph_hi; };

__device__ __forceinline__ unsigned f2bf(float f) { unsigned u = __float_as_uint(f); return (u + 0x7fffu + ((u >> 16) & 1u)) >> 16; }
__device__ __forceinline__ unsigned pk2(float lo, float hi) { return f2bf(lo) | (f2bf(hi) << 16); }
__device__ __forceinline__ float bf2f(unsigned b) { return __uint_as_float(b << 16); }
__device__ __forceinline__ float bflo(unsigned w) { return __uint_as_float(w << 16); }
__device__ __forceinline__ float bfhi(unsigned w) { return __uint_as_float(w & 0xffff0000u); }
__device__ __forceinline__ float wave_sum(float v) {
#pragma unroll
    for (int o = 32; o >= 1; o >>= 1) v += __shfl_xor(v, o);
    return v;
}
__device__ __forceinline__ float siluf(float x) { return x / (1.f + __expf(-x)); }
__device__ __forceinline__ float sigmf(float x) { return 1.f / (1.f + __expf(-x)); }
__device__ __forceinline__ float logsigf(float x) { return fminf(x, 0.f) - __logf(1.f + __expf(-fabsf(x))); }

__device__ __forceinline__ bf16x8 ldfrag(const LAS bf16_t* T, int ld, int row0, int k0, int lane) {
    return *(const LAS bf16x8*)(T + (row0 + (lane & 31)) * ld + k0 + 8 * (lane >> 5));
}
#define MFMA32(a, b, c) __builtin_amdgcn_mfma_f32_32x32x16_bf16((a), (b), (c), 0, 0, 0)
__device__ __forceinline__ int crow(int r, int lane) { return (r & 3) + 8 * (r >> 2) + 4 * (lane >> 5); }

namespace pg8 {
constexpr int BM = 256, BK = 64, HALF = 128, HTB = HALF * BK * 2, STAGE_BYTES = 8 * HTB;
__device__ __forceinline__ int lds_byte(int r, int c) { const int st = (r >> 4) * 2 + (c >> 5), rr = r & 15, cc = c & 31, ob = rr * 64 + cc * 2; return st * 1024 + (ob ^ (((ob >> 9) & 1) << 5)); }
__device__ __forceinline__ void stage_rc(int b, int& R, int& C) { const int st = b / 1024, sb = b % 1024, swz = sb ^ (((sb >> 9) & 1) << 5); R = (st >> 1) * 16 + swz / 64; C = (st & 1) * 32 + (swz % 64) / 2; }
__device__ __forceinline__ int perm32(int rho) { const int n = rho >> 4, i = rho & 15; return 8 * (i >> 2) + 4 * n + (i & 3); }
struct Unit { int pm, pn; const char* a; const char* b; };

template <class Epi, class Sched>
__device__ __forceinline__ void gemm_phase(LAS unsigned char* lds, const int K, const Sched& S, const Epi& E) {
    const int tid = threadIdx.x, wid = __builtin_amdgcn_readfirstlane(tid >> 6), lane = tid & 63, wr = wid >> 2, wc = wid & 3, fr = lane & 15, fq = lane >> 4;
    const int nt = K / BK;
    unsigned voffA[2], voffB[2];
#pragma unroll
    for (int i = 0; i < 2; ++i) { int R, C; stage_rc(tid * 16 + i * 8192, R, C); const int Rb = Epi::PERM ? ((R & ~31) + perm32(R & 31)) : R;
        voffA[i] = (unsigned)(R * K + C) * 2u; voffB[i] = (unsigned)(Rb * K + C) * 2u; }
    const size_t kstep = (size_t)(BK * 2);
    const size_t hstep = (size_t)HALF * K * 2;
    const unsigned ldsw = (unsigned)wid * 1024u;
    const int aoff = lds_byte(wr * 64 + fr, fq * 8), boff = lds_byte(wc * 32 + fr, fq * 8);
#define PG8_SA(b, h) (((b) * 2 + (h)) * HTB)
#define PG8_SB(b, h) ((4 + (b) * 2 + (h)) * HTB)
#define PG8_STAGE(bufoff, gbase, voff) do { _Pragma("unroll") for (int _i = 0; _i < 2; ++_i) \
        __builtin_amdgcn_global_load_lds((const unsigned*)((const char*)(gbase) + (voff)[_i]), (LAS unsigned*)(lds + (bufoff) + ldsw + _i * 8192), 16, 0, 0); } while (0)
#define PG8_LDA(dst, b, h) do { _Pragma("unroll") for (int m = 0; m < 4; ++m) _Pragma("unroll") for (int k = 0; k < 2; ++k) dst[m][k] = *(const LAS bf16x8*)(lds + PG8_SA(b, h) + aoff + m * 2048 + k * 1024); } while (0)
#define PG8_LDB(dst, b, h) do { _Pragma("unroll") for (int n = 0; n < 2; ++n) _Pragma("unroll") for (int k = 0; k < 2; ++k) dst[n][k] = *(const LAS bf16x8*)(lds + PG8_SB(b, h) + boff + n * 2048 + k * 1024); } while (0)
#define PG8_MMA(ai, bj, At, Bt) do { __builtin_amdgcn_s_setprio(1); _Pragma("unroll") for (int m = 0; m < 4; ++m) _Pragma("unroll") for (int n = 0; n < 2; ++n) _Pragma("unroll") for (int k = 0; k < 2; ++k) \
        acc[ai][bj][m][n] = __builtin_amdgcn_mfma_f32_16x16x32_bf16(Bt[n][k], At[m][k], acc[ai][bj][m][n], 0, 0, 0); __builtin_amdgcn_s_setprio(0); } while (0)
#define PG8_WAIT_V(n) asm volatile("s_waitcnt vmcnt(" #n ")" ::: "memory")
#define PG8_WAIT_L(n) asm volatile("s_waitcnt lgkmcnt(" #n ")" ::: "memory")
#define PG8_BAR __builtin_amdgcn_s_barrier()
#define PG8_SCHED __builtin_amdgcn_sched_barrier(0)
    Unit cur, nxt; int ui = 0;
    if (!S.next(0, cur)) return;
    f32x4 acc[2][2][4][2];
#pragma unroll
    for (int a = 0; a < 2; ++a)
#pragma unroll
        for (int b = 0; b < 2; ++b)
#pragma unroll
            for (int m = 0; m < 4; ++m)
#pragma unroll
                for (int n = 0; n < 2; ++n) acc[a][b][m][n] = (f32x4){0.f, 0.f, 0.f, 0.f};
    bf16x8 At[4][2], B0[2][2], B1[2][2];
    const char* cA = cur.a; const char* cB = cur.b;
    PG8_STAGE(PG8_SB(0, 0), cB, voffB); PG8_STAGE(PG8_SA(0, 0), cA, voffA); PG8_STAGE(PG8_SB(0, 1), cB + hstep, voffB); PG8_STAGE(PG8_SA(0, 1), cA + hstep, voffA);
    if (wr == 1) PG8_BAR;
    PG8_WAIT_V(4); PG8_BAR;
    PG8_STAGE(PG8_SB(1, 0), cB + kstep, voffB); PG8_STAGE(PG8_SA(1, 0), cA + kstep, voffA); PG8_STAGE(PG8_SB(1, 1), cB + hstep + kstep, voffB);
    PG8_WAIT_V(6); PG8_BAR;
    for (;;) {
        const bool has_next = S.next(ui + 1, nxt);
        const char* nA = has_next ? nxt.a : cA; const char* nB = has_next ? nxt.b : cB;
        for (int t = 0; t < nt; t += 2) {
            const bool last = (t == nt - 2);
            const char* a1 = cA + (size_t)(t + 1) * kstep;
            const char* a2 = last ? nA : cA + (size_t)(t + 2) * kstep; const char* b2 = last ? nB : cB + (size_t)(t + 2) * kstep;
            const char* a3 = a2 + kstep; const char* b3 = b2 + kstep;
            PG8_LDB(B0, 0, 0); PG8_SCHED; PG8_LDA(At, 0, 0); PG8_STAGE(PG8_SA(1, 1), a1 + hstep, voffA);
            PG8_WAIT_L(8); PG8_BAR; PG8_WAIT_L(0); PG8_MMA(0, 0, At, B0); PG8_BAR; PG8_SCHED;
            PG8_LDB(B1, 0, 1); PG8_STAGE(PG8_SB(0, 0), b2, voffB);
            PG8_BAR; PG8_WAIT_L(0); PG8_MMA(0, 1, At, B1); PG8_BAR;
            PG8_LDA(At, 0, 1); PG8_STAGE(PG8_SA(0, 0), a2, voffA);
            PG8_BAR; PG8_WAIT_L(0); PG8_MMA(1, 0, At, B0); PG8_BAR; PG8_SCHED;
            PG8_STAGE(PG8_SB(0, 1), b2 + hstep, voffB);
            PG8_WAIT_V(6); PG8_BAR; PG8_MMA(1, 1, At, B1); PG8_BAR;
            PG8_LDB(B0, 1, 0); PG8_SCHED; PG8_LDA(At, 1, 0); PG8_STAGE(PG8_SA(0, 1), a2 + hstep, voffA);
            PG8_WAIT_L(8); PG8_BAR; PG8_WAIT_L(0); PG8_MMA(0, 0, At, B0); PG8_BAR; PG8_SCHED;
            PG8_LDB(B1, 1, 1); PG8_STAGE(PG8_SB(1, 0), b3, voffB);
            PG8_BAR; PG8_WAIT_L(0); PG8_MMA(0, 1, At, B1); PG8_BAR;
            PG8_LDA(At, 1, 1); PG8_STAGE(PG8_SA(1, 0), a3, voffA);
            PG8_BAR; PG8_WAIT_L(0); PG8_MMA(1, 0, At, B0); PG8_BAR; PG8_SCHED;
            PG8_STAGE(PG8_SB(1, 1), b3 + hstep, voffB);
            PG8_WAIT_V(6); PG8_BAR; PG8_MMA(1, 1, At, B1); PG8_BAR;
        }
        E(acc, cur, wr, wc, fr, fq);
        if (!has_next) break;
#pragma unroll
        for (int a = 0; a < 2; ++a)
#pragma unroll
            for (int b = 0; b < 2; ++b)
#pragma unroll
                for (int m = 0; m < 4; ++m)
#pragma unroll
                    for (int n = 0; n < 2; ++n) acc[a][b][m][n] = (f32x4){0.f, 0.f, 0.f, 0.f};
        cur = nxt; cA = nA; cB = nB; ++ui;
    }
    PG8_WAIT_V(0);
    if (wr == 0) PG8_BAR;
    PG8_BAR;
#undef PG8_SA
#undef PG8_SB
#undef PG8_STAGE
#undef PG8_LDA
#undef PG8_LDB
#undef PG8_MMA
#undef PG8_WAIT_V
#undef PG8_WAIT_L
#undef PG8_BAR
#undef PG8_SCHED
}

struct SchedDense {
    int nM, nN, nwg, G, c, K; const char* A; const char* Bt;
    __device__ __forceinline__ bool next(int i, Unit& u) const {
        const long L = (long)i * G + c; if (L >= nwg) return false;
        int wgid = (int)L; { const int q = nwg / 8, r = nwg % 8, xcd = wgid % 8, off = wgid / 8; wgid = (xcd < r ? xcd * (q + 1) : r * (q + 1) + (xcd - r) * q) + off; }
        const int nig = 8 * nN, gid = wgid / nig, fm = gid * 8, gsz = (nM - fm) < 8 ? (nM - fm) : 8;
        u.pm = fm + ((wgid % nig) % gsz); u.pn = (wgid % nig) / gsz;
        u.a = A + (size_t)u.pm * 256 * K * 2; u.b = Bt + (size_t)u.pn * 256 * K * 2; return true;
    }
};
struct SchedMoE {
    int ntiles, G, c, K; const LAS int* tex; const char* A; const char* Bt; size_t bstride;
    __device__ __forceinline__ bool next(int i, Unit& u) const {
        const int L = i * G + c; const int rt = L >> 2; if (rt >= ntiles) return false;
        u.pm = rt; u.pn = L & 3; const int e = tex[rt];
        u.a = A + (size_t)rt * 256 * K * 2; u.b = Bt + (size_t)e * bstride + (size_t)u.pn * 256 * K * 2; return true;
    }
};
}

typedef const f32x4 (&AccRef)[2][2][4][2];
struct EpiZ {
    static constexpr bool PERM = true; bf16_t* Z; float* G;
    __device__ __forceinline__ void operator()(AccRef acc, const pg8::Unit& u, int wr, int wc, int fr, int fq) const {
        const int row0 = u.pm * 256 + wr * 64 + fr;
        if (u.pn < 14) {
            const int col0 = u.pn * 256 + wc * 32 + 8 * fq;
#pragma unroll
            for (int ai = 0; ai < 2; ++ai)
#pragma unroll
                for (int m = 0; m < 4; ++m) { bf16_t* rowp = Z + (size_t)(row0 + ai * 128 + m * 16) * ZLD + col0;
#pragma unroll
                    for (int bj = 0; bj < 2; ++bj) { const f32x4 v0 = acc[ai][bj][m][0], v1 = acc[ai][bj][m][1];
                        u32x4 o; o.x = pk2(v0[0], v0[1]); o.y = pk2(v0[2], v0[3]); o.z = pk2(v1[0], v1[1]); o.w = pk2(v1[2], v1[3]);
                        *(u32x4*)(rowp + bj * 128) = o; } }
        } else {
            const int c0 = wc * 32 + 8 * fq;
            if (c0 < 48) {
#pragma unroll
                for (int ai = 0; ai < 2; ++ai)
#pragma unroll
                    for (int m = 0; m < 4; ++m) { float* rowp = G + (size_t)(row0 + ai * 128 + m * 16) * 48 + c0;
                        *(f32x4*)rowp = acc[ai][0][m][0]; *(f32x4*)(rowp + 4) = acc[ai][0][m][1]; }
            }
        }
    }
};
struct EpiX1 {
    static constexpr bool PERM = false; const float* x; const float* mod; float* out;
    __device__ __forceinline__ void operator()(AccRef acc, const pg8::Unit& u, int wr, int wc, int fr, int fq) const {
        const int row0 = u.pm * 256 + wr * 64 + fr, col0 = u.pn * 256 + wc * 32 + 4 * fq;
        const float* g1 = mod + (size_t)(u.pm >> 4) * 6144 + 2048;
        f32x4 gv[2][2];
#pragma unroll
        for (int bj = 0; bj < 2; ++bj)
#pragma unroll
            for (int n = 0; n < 2; ++n) gv[bj][n] = *(const f32x4*)(g1 + col0 + bj * 128 + n * 16);
#pragma unroll
        for (int ai = 0; ai < 2; ++ai)
#pragma unroll
            for (int m = 0; m < 4; ++m) { const size_t off = (size_t)(row0 + ai * 128 + m * 16) * D + col0;
#pragma unroll
                for (int bj = 0; bj < 2; ++bj)
#pragma unroll
                    for (int n = 0; n < 2; ++n) { const f32x4 xv = *(const f32x4*)(x + off + bj * 128 + n * 16);
                        *(f32x4*)(out + off + bj * 128 + n * 16) = xv + gv[bj][n] * acc[ai][bj][m][n]; } }
    }
};
struct EpiH {
    static constexpr bool PERM = true; bf16_t* H;
    __device__ __forceinline__ void operator()(AccRef acc, const pg8::Unit& u, int wr, int wc, int fr, int fq) const {
        const int row0 = u.pm * 256 + wr * 64 + fr, col0 = u.pn * 128 + wc * 32 + 8 * fq;
#pragma unroll
        for (int ai = 0; ai < 2; ++ai)
#pragma unroll
            for (int m = 0; m < 4; ++m) { bf16_t* rowp = H + (size_t)(row0 + ai * 128 + m * 16) * 512 + col0;
                float h[8];
#pragma unroll
                for (int n = 0; n < 2; ++n)
#pragma unroll
                    for (int j = 0; j < 4; ++j) { const float g = acc[ai][0][m][n][j], up = acc[ai][1][m][n][j]; h[n * 4 + j] = siluf(g) * up; }
                u32x4 o; o.x = pk2(h[0], h[1]); o.y = pk2(h[2], h[3]); o.z = pk2(h[4], h[5]); o.w = pk2(h[6], h[7]);
                *(u32x4*)rowp = o; }
    }
};
struct EpiY {
    static constexpr bool PERM = true; bf16_t* Y;
    __device__ __forceinline__ void operator()(AccRef acc, const pg8::Unit& u, int wr, int wc, int fr, int fq) const {
        const int row0 = u.pm * 256 + wr * 64 + fr, col0 = u.pn * 256 + wc * 32 + 8 * fq;
#pragma unroll
        for (int ai = 0; ai < 2; ++ai)
#pragma unroll
            for (int m = 0; m < 4; ++m) { bf16_t* rowp = Y + (size_t)(row0 + ai * 128 + m * 16) * D + col0;
#pragma unroll
                for (int bj = 0; bj < 2; ++bj) { const f32x4 v0 = acc[ai][bj][m][0], v1 = acc[ai][bj][m][1];
                    u32x4 o; o.x = pk2(v0[0], v0[1]); o.y = pk2(v0[2], v0[3]); o.z = pk2(v1[0], v1[1]); o.w = pk2(v1[2], v1[3]);
                    *(u32x4*)(rowp + bj * 128) = o; } }
    }
};

__device__ __forceinline__ void p0_mod_item(const P& p, LAS unsigned char* lds, int item) {
    LAS float* SV = (LAS float*)lds; LAS float* PS = (LAS float*)(lds + 20480);
    const int tid = threadIdx.x;
    for (int i = tid; i < 5 * 1024; i += NTHR) { const int v = i >> 10, k = i & 1023; const float c = v < 4 ? p.in[1][v * 1024 + k] : p.in[3][k]; SV[i] = c / (1.f + expf(-c)); }
    __syncthreads();
    const int col = tid & 31, kq = tid >> 5, n = item * 32 + col;
    float acc[5] = {0.f, 0.f, 0.f, 0.f, 0.f};
    const float* W = p.in[4] + (size_t)(kq * 64) * 6144 + n;
#pragma unroll 8
    for (int k = 0; k < 64; ++k) { const float w = W[(size_t)k * 6144]; const int kk = kq * 64 + k;
#pragma unroll
        for (int v = 0; v < 5; ++v) acc[v] += SV[v * 1024 + kk] * w; }
#pragma unroll
    for (int v = 0; v < 5; ++v) PS[(kq * 5 + v) * 32 + col] = acc[v];
    __syncthreads();
    if (tid < 160) { const int v = tid >> 5, c = tid & 31; float s = 0.f;
#pragma unroll
        for (int q = 0; q < 16; ++q) s += PS[(q * 5 + v) * 32 + c];
        ((float*)(p.ws + WS_MOD))[v * 6144 + item * 32 + c] = s + p.in[5][item * 32 + c]; }
    __syncthreads();
}
template <class RowMap>
__device__ __forceinline__ void transpose_item(const float* W, int K, int N, bf16_t* WT, LAS float* scr, int kb, int nb, int lane, RowMap rm) {
    const int k0 = 64 * kb, n0 = 32 * nb;
#pragma unroll 8
    for (int i = 0; i < 32; ++i) { const int kk = 2 * i + (lane >> 5), n = n0 + (lane & 31); scr[kk * 33 + (lane & 31)] = n < N ? W[(size_t)(k0 + kk) * N + n] : 0.f; }
    asm volatile("s_waitcnt lgkmcnt(0)" ::: "memory");
    const int c = lane & 7;
#pragma unroll
    for (int j = 0; j < 4; ++j) { const int nl = (lane >> 3) + 8 * j, n = n0 + nl;
        if (n < N) { const LAS float* s = scr + (8 * c) * 33 + nl;
            u32x4 o; o.x = pk2(s[0 * 33], s[1 * 33]); o.y = pk2(s[2 * 33], s[3 * 33]); o.z = pk2(s[4 * 33], s[5 * 33]); o.w = pk2(s[6 * 33], s[7 * 33]);
            *(u32x4*)(WT + (size_t)rm(n) * K + k0 + 8 * c) = o; } }
    asm volatile("s_waitcnt lgkmcnt(0)" ::: "memory");
}
struct RmIn { __device__ __forceinline__ int operator()(int n) const { return n < 1536 ? n : (n < 1568 ? n + 2048 : (n < 3616 ? n - 32 : n)); } };
struct RmId { __device__ __forceinline__ int operator()(int n) const { return n; } };
struct RmE1 { __device__ __forceinline__ int operator()(int n) const { const int half = n >> 9, r = n & 511; return (r >> 7) * 256 + half * 128 + (r & 127); } };

__device__ __forceinline__ void phase0(const P& p, LAS unsigned char* lds) {
    const int tid = threadIdx.x, lane = tid & 63, wave = tid >> 6;
    for (int it = blockIdx.x; it < 192; it += gridDim.x) p0_mod_item(p, lds, it);
    LAS float* scr = (LAS float*)(lds + wave * 16384);
    const int gw = blockIdx.x * 8 + wave, NGW = gridDim.x * 8;
    constexpr int I_IN = 16 * 114, I_OUT = 16 * 32, I_E1 = 32 * 16 * 32, I_E2 = 32 * 8 * 32, NIT = I_IN + I_OUT + I_E1 + I_E2;
    bf16_t* WINT = (bf16_t*)(p.ws + WS_WINT); bf16_t* WOUTT = (bf16_t*)(p.ws + WS_WOUTT); bf16_t* E1T = (bf16_t*)(p.ws + WS_E1T); bf16_t* E2T = (bf16_t*)(p.ws + WS_E2T);
    for (int it = gw; it < NIT; it += NGW) {
        int r = it;
        if (r < I_IN) { transpose_item(p.in[7], 1024, INW, WINT, scr, r / 114, r % 114, lane, RmIn()); continue; } r -= I_IN;
        if (r < I_OUT) { transpose_item(p.in[16], 1024, 1024, WOUTT, scr, r >> 5, r & 31, lane, RmId()); continue; } r -= I_OUT;
        if (r < I_E1) { const int e = r >> 9, q = r & 511; transpose_item(p.in[22] + (size_t)e * 1024 * 1024, 1024, 1024, E1T + (size_t)e * 1024 * 1024, scr, q >> 5, q & 31, lane, RmE1()); continue; } r -= I_E1;
        { const int e = r >> 8, q = r & 255; transpose_item(p.in[23] + (size_t)e * 512 * 1024, 512, 1024, E2T + (size_t)e * 1024 * 512, scr, q >> 5, q & 31, lane, RmId()); }
    }
    for (int i = blockIdx.x * NTHR + tid; i < 208 * 128; i += gridDim.x * NTHR) ((u32x4*)(WINT + (size_t)INW * 1024))[i] = (u32x4){0u, 0u, 0u, 0u};
}

__device__ __forceinline__ void phase1(const P& p) {
    const int tid = threadIdx.x, lane = tid & 63, wave = tid >> 6;
    const float* mod = (const float*)(p.ws + WS_MOD); bf16_t* A = (bf16_t*)(p.ws + WS_A);
    const int gw = blockIdx.x * 8 + wave, NGW = gridDim.x * 8;
    for (int row = gw; row < MT; row += NGW) {
        const float* src = row < MX ? p.in[0] + (size_t)row * D : p.in[2] + (size_t)(row - MX) * D;
        const float* mv = mod + (size_t)(row < MX ? (row >> 12) : 4) * 6144;
        f32x4 v[4]; float ss = 0.f;
#pragma unroll
        for (int j = 0; j < 4; ++j) { v[j] = *(const f32x4*)(src + 4 * lane + 256 * j); ss += v[j].x * v[j].x + v[j].y * v[j].y + v[j].z * v[j].z + v[j].w * v[j].w; }
        const float rstd = 1.f / sqrtf(wave_sum(ss) * (1.f / D) + EPS);
#pragma unroll
        for (int j = 0; j < 4; ++j) { const int k = 4 * lane + 256 * j;
            const f32x4 g = *(const f32x4*)(p.in[6] + k), sh = *(const f32x4*)(mv + k), sc = *(const f32x4*)(mv + 1024 + k);
            const f32x4 o = (v[j] * rstd * g) * (sc + 1.f) + sh;
            u32x2 w; w.x = pk2(o.x, o.y); w.y = pk2(o.z, o.w);
            *(u32x2*)(A + (size_t)row * D + k) = w; }
    }
}

__device__ __forceinline__ void phase3(const P& p) {
    const bf16_t* Z = (const bf16_t*)(p.ws + WS_Z); bf16_t* MQ = (bf16_t*)(p.ws + WS_MQ); bf16_t* MK = (bf16_t*)(p.ws + WS_MK);
    const int tid = threadIdx.x, cg8 = tid & 127, tl = tid >> 7, ch0 = cg8 * 8;
    float w[9][8], bias[8];
#pragma unroll
    for (int a = 0; a < 9; ++a)
#pragma unroll
        for (int j = 0; j < 8; ++j) w[a][j] = p.in[11][a * 1024 + ch0 + j];
#pragma unroll
    for (int j = 0; j < 8; ++j) bias[j] = p.in[12][ch0 + j];
    const float osc = ch0 >= 512 ? 0.08838834764831845f : 1.f;
    bf16_t* dst = ch0 >= 512 ? MK : MQ;
    for (int it = blockIdx.x; it < 272; it += gridDim.x) {
        int rowbase, y, Hh, Ww, x0;
        if (it < 256) { rowbase = (it >> 6) * 4096; y = it & 63; Hh = 64; Ww = 64; x0 = 0; }
        else { const int ci = it - 256; rowbase = MX + (ci >> 2) * 256; y = 0; Hh = 1; Ww = 256; x0 = (ci & 3) * 64; }
        for (int i = 0; i < 16; ++i) {
            const int x = x0 + tl + 4 * i;
            float acc[8];
#pragma unroll
            for (int j = 0; j < 8; ++j) acc[j] = bias[j];
#pragma unroll
            for (int dy = 0; dy < 3; ++dy) { const int yy = y + dy - 1; if (yy < 0 || yy >= Hh) continue;
#pragma unroll
                for (int dx = 0; dx < 3; ++dx) { const int xx = x + dx - 1; if (xx < 0 || xx >= Ww) continue;
                    const u32x4 v = *(const u32x4*)(Z + (size_t)(rowbase + yy * Ww + xx) * ZLD + 1536 + ch0);
                    acc[0] += w[dy * 3 + dx][0] * bflo(v.x); acc[1] += w[dy * 3 + dx][1] * bfhi(v.x);
                    acc[2] += w[dy * 3 + dx][2] * bflo(v.y); acc[3] += w[dy * 3 + dx][3] * bfhi(v.y);
                    acc[4] += w[dy * 3 + dx][4] * bflo(v.z); acc[5] += w[dy * 3 + dx][5] * bfhi(v.z);
                    acc[6] += w[dy * 3 + dx][6] * bflo(v.w); acc[7] += w[dy * 3 + dx][7] * bfhi(v.w); } }
#pragma unroll
            for (int j = 0; j < 8; ++j) acc[j] = siluf(acc[j]) * osc;
            u32x4 o; o.x = pk2(acc[0], acc[1]); o.y = pk2(acc[2], acc[3]); o.z = pk2(acc[4], acc[5]); o.w = pk2(acc[6], acc[7]);
            *(u32x4*)(dst + (size_t)(rowbase + y * Ww + x) * 512 + (ch0 & 511)) = o;
        }
    }
}

__device__ __forceinline__ int chunk_tok0(int b, int tc) { return tc < 64 ? b * SEQ + tc * 64 : MX + b * CTXL + (tc - 64) * 64; }

__device__ __forceinline__ void load_vt(const bf16_t* Z, int tok0, int col0, LAS bf16_t* VT, int tid) {
#pragma unroll
    for (int i = 0; i < 2; ++i) { const int idx = tid + NTHR * i, t = idx >> 4, c = idx & 15;
        const u32x4 v = *(const u32x4*)(Z + (size_t)(tok0 + t) * ZLD + col0 + c * 8);
        LAS bf16_t* d = VT + (c * 8) * 72 + t;
        d[0 * 72] = (bf16_t)(v.x & 0xffff); d[1 * 72] = (bf16_t)(v.x >> 16); d[2 * 72] = (bf16_t)(v.y & 0xffff); d[3 * 72] = (bf16_t)(v.y >> 16);
        d[4 * 72] = (bf16_t)(v.z & 0xffff); d[5 * 72] = (bf16_t)(v.z >> 16); d[6 * 72] = (bf16_t)(v.w & 0xffff); d[7 * 72] = (bf16_t)(v.w >> 16); }
}

__device__ __forceinline__ void p4_gla(const P& p, LAS unsigned char* lds, int b, int h, int tc) {
    const int tid = threadIdx.x, lane = tid & 63, wave = __builtin_amdgcn_readfirstlane(tid >> 6);
    const bf16_t* Z = (const bf16_t*)(p.ws + WS_Z); const float* GT = (const float*)(p.ws + WS_GATES);
    const int tok0 = chunk_tok0(b, tc), sidx = (b * 4 + h) * NCH + tc;
    LAS bf16_t* VT = (LAS bf16_t*)lds; LAS bf16_t* KT = (LAS bf16_t*)(lds + 18432); LAS float* GLR = (LAS float*)(lds + 36864); LAS float* QS = (LAS float*)(lds + 45056);
    load_vt(Z, tok0, 512 + h * 128, VT, tid);
    { const int t = tid >> 3, c4 = tid & 7; *(LAS f32x4*)(GLR + t * 32 + c4 * 4) = *(const f32x4*)(GT + (size_t)(tok0 + t) * 48 + c4 * 4); }
    __syncthreads();
    const int dir = tid >> 8, tq = (tid >> 6) & 3, d = tid & 63;
    float upw[16];
#pragma unroll
    for (int r = 0; r < 16; ++r) upw[r] = p.in[8][(dir * 16 + r) * 256 + h * 64 + d];
    const float upb = p.in[9][dir * 256 + h * 64 + d];
    float la[16]; float tot = 0.f;
#pragma unroll
    for (int i = 0; i < 16; ++i) { const int t = tq * 16 + i; float lg = upb;
#pragma unroll
        for (int r = 0; r < 16; ++r) lg += GLR[t * 32 + dir * 16 + r] * upw[r];
        la[i] = logsigf(lg) * 0.0625f; tot += la[i]; }
    QS[(dir * 4 + tq) * 64 + d] = tot;
    __syncthreads();
    float before = 0.f, all = 0.f;
#pragma unroll
    for (int q = 0; q < 4; ++q) { const float v = QS[(dir * 4 + q) * 64 + d]; all += v; before += (q < tq) ? v : 0.f; }
    float run = before;
#pragma unroll
    for (int i = 0; i < 16; ++i) { const int t = tq * 16 + i;
        const float kx = bf2f(Z[(size_t)(tok0 + t) * ZLD + 256 + h * 64 + d]);
        float e; if (dir == 0) { run += la[i]; e = all - run; } else { e = run; run += la[i]; }
        KT[(dir * 64 + d) * 72 + t] = (bf16_t)f2bf(kx * __expf(e)); }
    if (tq == 0) ((float*)(p.ws + WS_GDEC))[(sidx * 2 + dir) * 64 + d] = __expf(all);
    __syncthreads();
    const int dw = wave >> 2, vt = wave & 3;
    f32x16 acc0, acc1;
#pragma unroll
    for (int r = 0; r < 16; ++r) { acc0[r] = 0.f; acc1[r] = 0.f; }
#pragma unroll
    for (int ks = 0; ks < 4; ++ks) { const bf16x8 a = ldfrag(VT, 72, vt * 32, ks * 16, lane);
        const bf16x8 b0 = ldfrag(KT + dw * 64 * 72, 72, 0, ks * 16, lane), b1 = ldfrag(KT + dw * 64 * 72, 72, 32, ks * 16, lane);
        acc0 = MFMA32(a, b0, acc0); acc1 = MFMA32(a, b1, acc1); }
    bf16_t* U = (bf16_t*)(p.ws + WS_UG) + (size_t)(sidx * 2 + dw) * 8192;
#pragma unroll
    for (int r = 0; r < 16; ++r) { const int v = vt * 32 + crow(r, lane); U[v * 64 + (lane & 31)] = (bf16_t)f2bf(acc0[r]); U[v * 64 + 32 + (lane & 31)] = (bf16_t)f2bf(acc1[r]); }
    __syncthreads();
}

__device__ __forceinline__ void load_ml_gates(const P& p, int tok0, int h, LAS float* IG, LAS float* LF, int tid) {
    if (tid < 128) { const int dir = tid >> 6, t = tid & 63; const float* g = (const float*)(p.ws + WS_GATES) + (size_t)(tok0 + t) * 48;
        IG[dir * 64 + t] = g[32 + dir * 4 + h] + p.in[13][dir * 4 + h];
        LF[dir * 64 + t] = logsigf(g[40 + dir * 4 + h] + p.in[14][dir * 4 + h]); }
}

__device__ __forceinline__ void p4_ml(const P& p, LAS unsigned char* lds, int b, int h, int tc) {
    const int tid = threadIdx.x, lane = tid & 63, wave = __builtin_amdgcn_readfirstlane(tid >> 6);
    const bf16_t* Z = (const bf16_t*)(p.ws + WS_Z); const bf16_t* MK = (const bf16_t*)(p.ws + WS_MK);
    const int tok0 = chunk_tok0(b, tc), sidx = (b * 4 + h) * NCH + tc;
    LAS bf16_t* VT = (LAS bf16_t*)lds; LAS bf16_t* KT = (LAS bf16_t*)(lds + 18432);
    LAS float* IG = (LAS float*)(lds + 55296); LAS float* LF = IG + 128; LAS float* KW = IG + 256;
    load_vt(Z, tok0, 2560 + h * 128, VT, tid);
    load_ml_gates(p, tok0, h, IG, LF, tid);
    __syncthreads();
    if (tid == 0 || tid == 64) { const int dir = tid >> 6; float tot = 0.f;
        for (int t = 0; t < 64; ++t) tot += LF[dir * 64 + t];
        float run = 0.f, ml = -3.0e38f;
        for (int t = 0; t < 64; ++t) { const float lf = LF[dir * 64 + t]; float g;
            if (dir == 0) { run += lf; g = tot - run + IG[t]; } else { g = run + IG[64 + t]; run += lf; }
            KW[dir * 64 + t] = g; ml = fmaxf(ml, g); }
        for (int t = 0; t < 64; ++t) KW[dir * 64 + t] = __expf(KW[dir * 64 + t] - ml);
        float* sc = (float*)(p.ws + WS_MSC) + (size_t)(sidx * 2 + dir) * 4; sc[0] = tot; sc[1] = ml; }
    __syncthreads();
    { const int dir = tid >> 8, th = (tid >> 7) & 1, d = tid & 127;
#pragma unroll 8
        for (int i = 0; i < 32; ++i) { const int t = th * 32 + i; const float kx = bf2f(MK[(size_t)(tok0 + t) * 512 + h * 128 + d]);
            KT[(dir * 128 + d) * 72 + t] = (bf16_t)f2bf(kx * KW[dir * 64 + t]); } }
    __syncthreads();
    if (tid < 256) { const int dir = tid >> 7, d = tid & 127; float s = 0.f;
        for (int t = 0; t < 64; ++t) s += bf2f(KT[(dir * 128 + d) * 72 + t]);
        ((float*)(p.ws + WS_MN))[(size_t)(sidx * 2 + dir) * 128 + d] = s; }
    const int dw = wave >> 2, vt = wave & 3;
    f32x16 acc[4];
#pragma unroll
    for (int q = 0; q < 4; ++q)
#pragma unroll
        for (int r = 0; r < 16; ++r) acc[q][r] = 0.f;
#pragma unroll
    for (int ks = 0; ks < 4; ++ks) { const bf16x8 a = ldfrag(VT, 72, vt * 32, ks * 16, lane);
#pragma unroll
        for (int q = 0; q < 4; ++q) { const bf16x8 bq = ldfrag(KT + dw * 128 * 72, 72, q * 32, ks * 16, lane); acc[q] = MFMA32(a, bq, acc[q]); } }
    bf16_t* U = (bf16_t*)(p.ws + WS_UM) + (size_t)(sidx * 2 + dw) * 16384;
#pragma unroll
    for (int q = 0; q < 4; ++q)
#pragma unroll
        for (int r = 0; r < 16; ++r) { const int v = vt * 32 + crow(r, lane); U[v * 128 + q * 32 + (lane & 31)] = (bf16_t)f2bf(acc[q][r]); }
    __syncthreads();
}

__device__ __forceinline__ void phase4(const P& p, LAS unsigned char* lds) {
    for (int it = blockIdx.x; it < 2 * NSTATE; it += gridDim.x) {
        const int ty = it / NSTATE, r = it % NSTATE, b = r / (4 * NCH), h = (r / NCH) & 3, tc = r % NCH;
        if (ty == 0) p4_gla(p, lds, b, h, tc); else p4_ml(p, lds, b, h, tc);
    }
}

__device__ __forceinline__ int tc_of(int c, int dir) { return dir == 0 ? (c < 4 ? 64 + c : c - 4) : (c < 4 ? 67 - c : 67 - c); }

__device__ __forceinline__ void phase5(const P& p) {
    const int gtid = blockIdx.x * NTHR + threadIdx.x, nthr = gridDim.x * NTHR;
    for (int task = gtid; task < 32768 + 65536 + 512; task += nthr) {
        if (task < 32768) {
            const int chain = task >> 10, e8 = task & 1023, bh = chain >> 1, dir = chain & 1, d0 = (e8 & 7) * 8;
            bf16_t* UG = (bf16_t*)(p.ws + WS_UG); const float* GD = (const float*)(p.ws + WS_GDEC);
            float s[8];
#pragma unroll
            for (int j = 0; j < 8; ++j) s[j] = 0.f;
            u32x4 ub[4]; f32x4 da[4], db[4];
#pragma unroll
            for (int i = 0; i < 4; ++i) { const int si = (bh * NCH + tc_of(i, dir)) * 2 + dir;
                ub[i] = *(const u32x4*)(UG + (size_t)si * 8192 + e8 * 8); da[i] = *(const f32x4*)(GD + si * 64 + d0); db[i] = *(const f32x4*)(GD + si * 64 + d0 + 4); }
            for (int c0 = 0; c0 < NCH; c0 += 4) {
#pragma unroll
                for (int i = 0; i < 4; ++i) { const int c = c0 + i; const int si = (bh * NCH + tc_of(c, dir)) * 2 + dir;
                    const u32x4 u = ub[i]; const f32x4 a = da[i], bq = db[i];
                    if (c + 4 < NCH) { const int sn = (bh * NCH + tc_of(c + 4, dir)) * 2 + dir;
                        ub[i] = *(const u32x4*)(UG + (size_t)sn * 8192 + e8 * 8); da[i] = *(const f32x4*)(GD + sn * 64 + d0); db[i] = *(const f32x4*)(GD + sn * 64 + d0 + 4); }
                    u32x4 o; o.x = pk2(s[0], s[1]); o.y = pk2(s[2], s[3]); o.z = pk2(s[4], s[5]); o.w = pk2(s[6], s[7]);
                    *(u32x4*)(UG + (size_t)si * 8192 + e8 * 8) = o;
                    s[0] = a.x * s[0] + bflo(u.x); s[1] = a.y * s[1] + bfhi(u.x); s[2] = a.z * s[2] + bflo(u.y); s[3] = a.w * s[3] + bfhi(u.y);
                    s[4] = bq.x * s[4] + bflo(u.z); s[5] = bq.y * s[5] + bfhi(u.z); s[6] = bq.z * s[6] + bflo(u.w); s[7] = bq.w * s[7] + bfhi(u.w); }
            }
        } else if (task < 98304) {
            const int tk = task - 32768, chain = tk >> 11, e8 = tk & 2047, bh = chain >> 1, dir = chain & 1;
            bf16_t* UM = (bf16_t*)(p.ws + WS_UM); float* SC = (float*)(p.ws + WS_MSC);
            float s[8];
#pragma unroll
            for (int j = 0; j < 8; ++j) s[j] = 0.f;
            float m = 0.f;
            u32x4 ub[4]; float ae[4], ml[4];
#pragma unroll
            for (int i = 0; i < 4; ++i) { const int si = (bh * NCH + tc_of(i, dir)) * 2 + dir;
                ub[i] = *(const u32x4*)(UM + (size_t)si * 16384 + e8 * 8); ae[i] = SC[si * 4 + 0]; ml[i] = SC[si * 4 + 1]; }
            for (int c0 = 0; c0 < NCH; c0 += 4) {
#pragma unroll
                for (int i = 0; i < 4; ++i) { const int c = c0 + i; const int si = (bh * NCH + tc_of(c, dir)) * 2 + dir;
                    const u32x4 u = ub[i]; const float aend = ae[i], mloc = ml[i];
                    if (c + 4 < NCH) { const int sn = (bh * NCH + tc_of(c + 4, dir)) * 2 + dir;
                        ub[i] = *(const u32x4*)(UM + (size_t)sn * 16384 + e8 * 8); ae[i] = SC[sn * 4 + 0]; ml[i] = SC[sn * 4 + 1]; }
                    u32x4 o; o.x = pk2(s[0], s[1]); o.y = pk2(s[2], s[3]); o.z = pk2(s[4], s[5]); o.w = pk2(s[6], s[7]);
                    *(u32x4*)(UM + (size_t)si * 16384 + e8 * 8) = o;
                    if (e8 == 0) SC[si * 4 + 2] = m;
                    const float mn = fmaxf(aend + m, mloc), f1 = __expf(aend + m - mn), f2 = __expf(mloc - mn); m = mn;
                    s[0] = f1 * s[0] + f2 * bflo(u.x); s[1] = f1 * s[1] + f2 * bfhi(u.x); s[2] = f1 * s[2] + f2 * bflo(u.y); s[3] = f1 * s[3] + f2 * bfhi(u.y);
                    s[4] = f1 * s[4] + f2 * bflo(u.z); s[5] = f1 * s[5] + f2 * bfhi(u.z); s[6] = f1 * s[6] + f2 * bflo(u.w); s[7] = f1 * s[7] + f2 * bfhi(u.w); }
            }
        } else {
            const int tk = task - 98304, chain = tk >> 4, part = tk & 15, bh = chain >> 1, dir = chain & 1;
            float* MN = (float*)(p.ws + WS_MN); const float* SC = (const float*)(p.ws + WS_MSC);
            f32x4 n0 = {0.f, 0.f, 0.f, 0.f}, n1 = {0.f, 0.f, 0.f, 0.f}; float m = 0.f;
            for (int c = 0; c < NCH; ++c) { const int si = (bh * NCH + tc_of(c, dir)) * 2 + dir;
                float* np = MN + (size_t)si * 128 + part * 8;
                const f32x4 u0 = *(const f32x4*)np, u1 = *(const f32x4*)(np + 4); const float aend = SC[si * 4 + 0], mloc = SC[si * 4 + 1];
                *(f32x4*)np = n0; *(f32x4*)(np + 4) = n1;
                const float mn = fmaxf(aend + m, mloc), f1 = __expf(aend + m - mn), f2 = __expf(mloc - mn); m = mn;
                n0 = n0 * f1 + u0 * f2; n1 = n1 * f1 + u1 * f2; }
        }
    }
}

template <bool SIG>
__device__ __forceinline__ void head_norm_store(const P& p, const LAS float* O, int tok0, int h, int zgate_col, const float* gain, int mixcol, int tid) {
    const bf16_t* Z = (const bf16_t*)(p.ws + WS_Z); bf16_t* MIX = (bf16_t*)(p.ws + WS_A);
    const int t = tid >> 3, seg = tid & 7;
    float o[16]; float ss = 0.f;
#pragma unroll
    for (int j = 0; j < 16; ++j) { o[j] = O[t * 132 + seg * 16 + j]; ss += o[j] * o[j]; }
    ss += __shfl_xor(ss, 1); ss += __shfl_xor(ss, 2); ss += __shfl_xor(ss, 4);
    const float rstd = 1.f / sqrtf(ss * (1.f / 128.f) + EPS);
    const u32x4 g0 = *(const u32x4*)(Z + (size_t)(tok0 + t) * ZLD + zgate_col + h * 128 + seg * 16), g1 = *(const u32x4*)(Z + (size_t)(tok0 + t) * ZLD + zgate_col + h * 128 + seg * 16 + 8);
    float gt[16];
    gt[0] = bflo(g0.x); gt[1] = bfhi(g0.x); gt[2] = bflo(g0.y); gt[3] = bfhi(g0.y); gt[4] = bflo(g0.z); gt[5] = bfhi(g0.z); gt[6] = bflo(g0.w); gt[7] = bfhi(g0.w);
    gt[8] = bflo(g1.x); gt[9] = bfhi(g1.x); gt[10] = bflo(g1.y); gt[11] = bfhi(g1.y); gt[12] = bflo(g1.z); gt[13] = bfhi(g1.z); gt[14] = bflo(g1.w); gt[15] = bfhi(g1.w);
    float r[16];
#pragma unroll
    for (int j = 0; j < 16; ++j) { const float gg = SIG ? sigmf(gt[j]) : siluf(gt[j]); r[j] = o[j] * rstd * gain[h * 128 + seg * 16 + j] * gg; }
    u32x4 w0, w1; w0.x = pk2(r[0], r[1]); w0.y = pk2(r[2], r[3]); w0.z = pk2(r[4], r[5]); w0.w = pk2(r[6], r[7]);
    w1.x = pk2(r[8], r[9]); w1.y = pk2(r[10], r[11]); w1.z = pk2(r[12], r[13]); w1.w = pk2(r[14], r[15]);
    bf16_t* dst = MIX + (size_t)(tok0 + t) * D + mixcol + h * 128 + seg * 16;
    *(u32x4*)dst = w0; *(u32x4*)(dst + 8) = w1;
}

__device__ __forceinline__ void p6_gla(const P& p, LAS unsigned char* lds, int b, int h, int j) {
    const int tid = threadIdx.x, lane = tid & 63, wave = __builtin_amdgcn_readfirstlane(tid >> 6);
    const bf16_t* Z = (const bf16_t*)(p.ws + WS_Z); const float* GT = (const float*)(p.ws + WS_GATES);
    const int tok0 = b * SEQ + j * 64, sidx = (b * 4 + h) * NCH + j;
    LAS bf16_t* QF = (LAS bf16_t*)lds; LAS bf16_t* QB = QF + 64 * 72; LAS bf16_t* KF = QB + 64 * 72; LAS bf16_t* KB = KF + 64 * 72;
    LAS bf16_t* VT = (LAS bf16_t*)(lds + 36864); LAS bf16_t* ST = (LAS bf16_t*)(lds + 55296); LAS bf16_t* PF = (LAS bf16_t*)(lds + 92160); LAS bf16_t* PB = PF + 64 * 72;
    LAS float* GLR = (LAS float*)(lds + 110592); LAS float* QS = (LAS float*)(lds + 118784); LAS float* O = (LAS float*)lds;
    load_vt(Z, tok0, 512 + h * 128, VT, tid);
    { const bf16_t* S = (const bf16_t*)(p.ws + WS_UG) + (size_t)(sidx * 2) * 8192;
#pragma unroll
        for (int i = 0; i < 4; ++i) { const int idx = tid + NTHR * i, row = idx >> 3, c = idx & 7;
            *(LAS u32x4*)(ST + row * 72 + c * 8) = *(const u32x4*)(S + (size_t)row * 64 + c * 8); } }
    { const int t = tid >> 3, c4 = tid & 7; *(LAS f32x4*)(GLR + t * 32 + c4 * 4) = *(const f32x4*)(GT + (size_t)(tok0 + t) * 48 + c4 * 4); }
    __syncthreads();
    const int dir = tid >> 8, tq = (tid >> 6) & 3, d = tid & 63;
    {
        float upw[16];
#pragma unroll
        for (int r = 0; r < 16; ++r) upw[r] = p.in[8][(dir * 16 + r) * 256 + h * 64 + d];
        const float upb = p.in[9][dir * 256 + h * 64 + d];
        float la[16]; float tot = 0.f;
#pragma unroll
        for (int i = 0; i < 16; ++i) { const int t = tq * 16 + i; float lg = upb;
#pragma unroll
            for (int r = 0; r < 16; ++r) lg += GLR[t * 32 + dir * 16 + r] * upw[r];
            la[i] = logsigf(lg) * 0.0625f; tot += la[i]; }
        QS[(dir * 4 + tq) * 64 + d] = tot;
        __syncthreads();
        float before = 0.f, all = 0.f;
#pragma unroll
        for (int q = 0; q < 4; ++q) { const float v = QS[(dir * 4 + q) * 64 + d]; all += v; before += (q < tq) ? v : 0.f; }
        float run = before;
        LAS bf16_t* Qd = dir == 0 ? QF : QB; LAS bf16_t* Kd = dir == 0 ? KF : KB;
#pragma unroll
        for (int i = 0; i < 16; ++i) { const int t = tq * 16 + i;
            const float qx = bf2f(Z[(size_t)(tok0 + t) * ZLD + h * 64 + d]) * 0.125f, kx = bf2f(Z[(size_t)(tok0 + t) * ZLD + 256 + h * 64 + d]);
            float bb; if (dir == 0) { run += la[i]; bb = run; } else { bb = all - run; run += la[i]; }
            const float eb = __expf(bb);
            Qd[t * 72 + d] = (bf16_t)f2bf(qx * eb); Kd[t * 72 + d] = (bf16_t)f2bf(kx / eb); }
    }
    __syncthreads();
    {
        const int dw = wave >> 2, tt = (wave >> 1) & 1, st = wave & 1;
        const LAS bf16_t* Qd = dw == 0 ? QF : QB; const LAS bf16_t* Kd = dw == 0 ? KF : KB; LAS bf16_t* Pd = dw == 0 ? PF : PB;
        f32x16 acc;
#pragma unroll
        for (int r = 0; r < 16; ++r) acc[r] = 0.f;
#pragma unroll
        for (int ks = 0; ks < 4; ++ks) acc = MFMA32(ldfrag(Qd, 72, tt * 32, ks * 16, lane), ldfrag(Kd, 72, st * 32, ks * 16, lane), acc);
        const int s = st * 32 + (lane & 31);
#pragma unroll
        for (int r = 0; r < 16; ++r) { const int t = tt * 32 + crow(r, lane); const bool ok = dw == 0 ? (s <= t) : (s >= t);
            Pd[t * 72 + s] = (bf16_t)f2bf(ok ? acc[r] : 0.f); }
    }
    __syncthreads();
    const int tt = wave >> 2, vt = wave & 3;
    f32x16 acc;
#pragma unroll
    for (int r = 0; r < 16; ++r) acc[r] = 0.f;
#pragma unroll
    for (int ks = 0; ks < 4; ++ks) { const bf16x8 vb = ldfrag(VT, 72, vt * 32, ks * 16, lane);
        acc = MFMA32(ldfrag(PF, 72, tt * 32, ks * 16, lane), vb, acc); acc = MFMA32(ldfrag(PB, 72, tt * 32, ks * 16, lane), vb, acc); }
#pragma unroll
    for (int ks = 0; ks < 4; ++ks) { acc = MFMA32(ldfrag(QF, 72, tt * 32, ks * 16, lane), ldfrag(ST, 72, vt * 32, ks * 16, lane), acc);
        acc = MFMA32(ldfrag(QB, 72, tt * 32, ks * 16, lane), ldfrag(ST + 128 * 72, 72, vt * 32, ks * 16, lane), acc); }
    __syncthreads();
#pragma unroll
    for (int r = 0; r < 16; ++r) O[(tt * 32 + crow(r, lane)) * 132 + vt * 32 + (lane & 31)] = acc[r];
    __syncthreads();
    head_norm_store<false>(p, O, tok0, h, 1024, p.in[10], 0, tid);
    __syncthreads();
}

__device__ __forceinline__ void p6_ml(const P& p, LAS unsigned char* lds, int b, int h, int j) {
    const int tid = threadIdx.x, lane = tid & 63, wave = __builtin_amdgcn_readfirstlane(tid >> 6);
    const bf16_t* Z = (const bf16_t*)(p.ws + WS_Z); const bf16_t* MQ = (const bf16_t*)(p.ws + WS_MQ); const bf16_t* MK = (const bf16_t*)(p.ws + WS_MK);
    const int tok0 = b * SEQ + j * 64, sidx = (b * 4 + h) * NCH + j;
    LAS bf16_t* Q = (LAS bf16_t*)lds; LAS bf16_t* K = (LAS bf16_t*)(lds + 17408); LAS bf16_t* VT = (LAS bf16_t*)(lds + 34816); LAS bf16_t* ST = (LAS bf16_t*)(lds + 53248);
    LAS bf16_t* PF = (LAS bf16_t*)(lds + 122880); LAS bf16_t* PB = PF + 64 * 72; LAS float* SM = (LAS float*)(lds + 141312); LAS float* O = (LAS float*)lds;
    LAS float* IG = SM; LAS float* LF = SM + 128; LAS float* CT = SM + 256; LAS float* RT = SM + 384; LAS float* WT = SM + 512; LAS float* ET = SM + 640;
    LAS float* NV = SM + 768;
    LAS float* INV = SM + 1024;
    LAS float* MS = SM + 1152;
#pragma unroll
    for (int i = 0; i < 2; ++i) { const int idx = tid + NTHR * i, t = idx >> 4, c = idx & 15;
        *(LAS u32x4*)(Q + t * 136 + c * 8) = *(const u32x4*)(MQ + (size_t)(tok0 + t) * 512 + h * 128 + c * 8);
        *(LAS u32x4*)(K + t * 136 + c * 8) = *(const u32x4*)(MK + (size_t)(tok0 + t) * 512 + h * 128 + c * 8); }
    load_vt(Z, tok0, 2560 + h * 128, VT, tid);
    { const bf16_t* S = (const bf16_t*)(p.ws + WS_UM) + (size_t)(sidx * 2) * 16384;
#pragma unroll
        for (int i = 0; i < 8; ++i) { const int idx = tid + NTHR * i, row = idx >> 4, c = idx & 15;
            *(LAS u32x4*)(ST + row * 136 + c * 8) = *(const u32x4*)(S + (size_t)row * 128 + c * 8); } }
    load_ml_gates(p, tok0, h, IG, LF, tid);
    if (tid >= 128 && tid < 384) { const int q = tid - 128; NV[q] = ((const float*)(p.ws + WS_MN))[(size_t)(sidx * 2) * 128 + q]; }
    if (tid >= 384 && tid < 386) { const int dir = tid - 384; MS[dir] = ((const float*)(p.ws + WS_MSC))[(size_t)(sidx * 2 + dir) * 4 + 2]; }
    __syncthreads();
    if (tid == 0) {
        const float ms = MS[0]; float a = 0.f, pm = -3.0e38f;
        for (int t = 0; t < 64; ++t) { a += LF[t]; const float c = IG[t] - a; pm = fmaxf(pm, c); const float mt = a + fmaxf(ms, pm);
            CT[t] = c; RT[t] = a - mt; WT[t] = __expf(a + ms - mt); ET[t] = __expf(-mt); }
    } else if (tid == 64) {
        const float ms = MS[1]; float a = 0.f, pm = -3.0e38f;
        for (int t = 63; t >= 0; --t) { a += LF[64 + t]; const float c = IG[64 + t] - a; pm = fmaxf(pm, c); const float mt = a + fmaxf(ms, pm);
            CT[64 + t] = c; RT[64 + t] = a - mt; WT[64 + t] = __expf(a + ms - mt); ET[64 + t] = __expf(-mt); }
    }
    __syncthreads();
    {
        const int dw = wave >> 2, tt = (wave >> 1) & 1, st = wave & 1; LAS bf16_t* Pd = dw == 0 ? PF : PB;
        f32x16 acc;
#pragma unroll
        for (int r = 0; r < 16; ++r) acc[r] = 0.f;
#pragma unroll
        for (int ks = 0; ks < 8; ++ks) acc = MFMA32(ldfrag(Q, 136, tt * 32, ks * 16, lane), ldfrag(K, 136, st * 32, ks * 16, lane), acc);
        const int s = st * 32 + (lane & 31); const float cs = CT[dw * 64 + s];
#pragma unroll
        for (int r = 0; r < 16; ++r) { const int t = tt * 32 + crow(r, lane); const bool ok = dw == 0 ? (s <= t) : (s >= t);
            const float wgt = __expf(fminf(RT[dw * 64 + t] + cs, 0.f));
            Pd[t * 72 + s] = (bf16_t)f2bf(ok ? acc[r] * wgt : 0.f); }
    }
    __syncthreads();
    {
        const int t = tid >> 3, seg = tid & 7;
        float rs0 = 0.f, rs1 = 0.f, qn0 = 0.f, qn1 = 0.f;
#pragma unroll
        for (int i = 0; i < 8; ++i) { rs0 += bf2f(PF[t * 72 + seg * 8 + i]); rs1 += bf2f(PB[t * 72 + seg * 8 + i]); }
#pragma unroll
        for (int i = 0; i < 16; ++i) { const float qv = bf2f(Q[t * 136 + seg * 16 + i]); qn0 += qv * NV[seg * 16 + i]; qn1 += qv * NV[128 + seg * 16 + i]; }
#pragma unroll
        for (int o = 1; o < 8; o <<= 1) { rs0 += __shfl_xor(rs0, o); rs1 += __shfl_xor(rs1, o); qn0 += __shfl_xor(qn0, o); qn1 += __shfl_xor(qn1, o); }
        if (seg == 0) { const float d0 = rs0 + WT[t] * qn0, d1 = rs1 + WT[64 + t] * qn1;
            INV[t] = 1.f / fmaxf(fabsf(d0), ET[t]); INV[64 + t] = 1.f / fmaxf(fabsf(d1), ET[64 + t]); }
    }
    const int tt = wave >> 2, vt = wave & 3;
    f32x16 apf, apb, aqf, aqb;
#pragma unroll
    for (int r = 0; r < 16; ++r) { apf[r] = 0.f; apb[r] = 0.f; aqf[r] = 0.f; aqb[r] = 0.f; }
#pragma unroll
    for (int ks = 0; ks < 4; ++ks) { const bf16x8 vb = ldfrag(VT, 72, vt * 32, ks * 16, lane);
        apf = MFMA32(ldfrag(PF, 72, tt * 32, ks * 16, lane), vb, apf); apb = MFMA32(ldfrag(PB, 72, tt * 32, ks * 16, lane), vb, apb); }
#pragma unroll
    for (int ks = 0; ks < 8; ++ks) { const bf16x8 qa = ldfrag(Q, 136, tt * 32, ks * 16, lane);
        aqf = MFMA32(qa, ldfrag(ST, 136, vt * 32, ks * 16, lane), aqf); aqb = MFMA32(qa, ldfrag(ST + 128 * 136, 136, vt * 32, ks * 16, lane), aqb); }
    __syncthreads();
#pragma unroll
    for (int r = 0; r < 16; ++r) { const int t = tt * 32 + crow(r, lane);
        const float hv = INV[t] * (apf[r] + WT[t] * aqf[r]) + INV[64 + t] * (apb[r] + WT[64 + t] * aqb[r]);
        O[t * 132 + vt * 32 + (lane & 31)] = hv; }
    __syncthreads();
    head_norm_store<true>(p, O, tok0, h, 3072, p.in[15], 512, tid);
    __syncthreads();
}

__device__ __forceinline__ void phase6(const P& p, LAS unsigned char* lds) {
    for (int it = blockIdx.x; it < 2048; it += gridDim.x) {
        const int ty = it >> 10, r = it & 1023, b = r >> 8, h = (r >> 6) & 3, j = r & 63;
        if (ty == 0) p6_gla(p, lds, b, h, j); else p6_ml(p, lds, b, h, j);
    }
}

__device__ __forceinline__ void phase8(const P& p, LAS unsigned char* lds) {
    const int tid = threadIdx.x, lane = tid & 63, wave = tid >> 6;
    LAS float* RW = (LAS float*)lds;
    for (int i = tid; i < 36 * 1024; i += NTHR) { const int j = i >> 10, k = i & 1023; RW[i] = j < 4 ? p.in[18][k * 4 + j] : p.in[20][k * 32 + (j - 4)]; }
    __syncthreads();
    const float* mod = (const float*)(p.ws + WS_MOD); bf16_t* H2 = (bf16_t*)(p.ws + WS_MQ);
    int* RT = (int*)(p.ws + WS_ROUTE); unsigned* CNT = (unsigned*)(p.ws + WS_CTL) + CW_CNT;
    const int gw = blockIdx.x * 8 + wave, NGW = gridDim.x * 8;
    for (int row = gw; row < MX; row += NGW) {
        const float* src = p.out + (size_t)row * D; const float* mv = mod + (size_t)(row >> 12) * 6144;
        f32x4 v[4]; float ss = 0.f;
#pragma unroll
        for (int j = 0; j < 4; ++j) { v[j] = *(const f32x4*)(src + 4 * lane + 256 * j); ss += v[j].x * v[j].x + v[j].y * v[j].y + v[j].z * v[j].z + v[j].w * v[j].w; }
        const float rstd = 1.f / sqrtf(wave_sum(ss) * (1.f / D) + EPS);
#pragma unroll
        for (int j = 0; j < 4; ++j) { const int k = 4 * lane + 256 * j;
            const f32x4 g = *(const f32x4*)(p.in[17] + k), sh = *(const f32x4*)(mv + 3072 + k), sc = *(const f32x4*)(mv + 4096 + k);
            v[j] = (v[j] * rstd * g) * (sc + 1.f) + sh;
            u32x2 w; w.x = pk2(v[j].x, v[j].y); w.y = pk2(v[j].z, v[j].w);
            *(u32x2*)(H2 + (size_t)row * D + k) = w; }
        LAS float* LG = (LAS float*)(lds + 147456) + wave * 64;
#pragma unroll 2
        for (int q = 0; q < 36; ++q) { float s = 0.f;
#pragma unroll
            for (int j = 0; j < 4; ++j) { const f32x4 w = *(const LAS f32x4*)(RW + q * 1024 + 4 * lane + 256 * j); s += v[j].x * w.x + v[j].y * w.y + v[j].z * w.z + v[j].w * w.w; }
            s = wave_sum(s);
            if (lane == 0) LG[q] = s; }
        asm volatile("s_waitcnt lgkmcnt(0)" ::: "memory");
        float gl[4];
#pragma unroll
        for (int q = 0; q < 4; ++q) gl[q] = LG[q] + p.in[19][q];
        int gi = 0; float gm = gl[0];
#pragma unroll
        for (int q = 1; q < 4; ++q) if (gl[q] > gm) { gm = gl[q]; gi = q; }
        float den = 0.f;
#pragma unroll
        for (int q = 0; q < 4; ++q) den += __expf(gl[q] - gm);
        const float gwt = 1.f / den;
        float el[8];
#pragma unroll
        for (int q = 0; q < 8; ++q) el[q] = LG[4 + gi * 8 + q] + p.in[21][gi * 8 + q];
        int i0 = 0; float v0 = el[0];
#pragma unroll
        for (int q = 1; q < 8; ++q) if (el[q] > v0) { v0 = el[q]; i0 = q; }
        int i1 = -1; float v1 = -3.0e38f;
#pragma unroll
        for (int q = 0; q < 8; ++q) if (q != i0 && el[q] > v1) { v1 = el[q]; i1 = q; }
        const float e1 = __expf(v1 - v0), w0 = gwt / (1.f + e1), w1 = gwt * e1 / (1.f + e1);
        if (lane == 0) { const int ea = gi * 8 + i0, eb = gi * 8 + i1;
            const int ra = (int)atomicAdd(&CNT[ea], 1u), rb = (int)atomicAdd(&CNT[eb], 1u);
            int* r = RT + (size_t)row * 8; r[0] = ea; r[1] = eb; r[2] = ra; r[3] = rb; ((float*)r)[4] = w0; ((float*)r)[5] = w1; }
    }
}

__device__ __forceinline__ int build_tables(const P& p, LAS int* PST, LAS int* TEX) {
    const unsigned* CNT = (const unsigned*)(p.ws + WS_CTL) + CW_CNT;
    if (threadIdx.x == 0) { int acc = 0;
        for (int e = 0; e < 32; ++e) { PST[e] = acc; const int c = (int)__hip_atomic_load(&CNT[e], __ATOMIC_RELAXED, __HIP_MEMORY_SCOPE_AGENT); const int nt = (c + 255) >> 8;
            for (int t = 0; t < nt; ++t) TEX[(acc >> 8) + t] = e;
            acc += nt << 8; }
        PST[32] = acc; }
    __syncthreads();
    return PST[32] >> 8;
}

__device__ __forceinline__ void phase9(const P& p, LAS unsigned char* lds) {
    LAS int* PST = (LAS int*)lds; LAS int* TEX = PST + 64;
    (void)build_tables(p, PST, TEX);
    const int tid = threadIdx.x, lane = tid & 63, wave = tid >> 6;
    const bf16_t* H2 = (const bf16_t*)(p.ws + WS_MQ); bf16_t* XS = (bf16_t*)(p.ws + WS_Z); int* RT = (int*)(p.ws + WS_ROUTE);
    const int gw = blockIdx.x * 8 + wave, NGW = gridDim.x * 8;
    for (int row = gw; row < MX; row += NGW) {
        int* r = RT + (size_t)row * 8;
        const int s0 = PST[r[0]] + r[2], s1 = PST[r[1]] + r[3];
        const u32x4 a = *(const u32x4*)(H2 + (size_t)row * D + lane * 8), bq = *(const u32x4*)(H2 + (size_t)row * D + 512 + lane * 8);
        *(u32x4*)(XS + (size_t)s0 * D + lane * 8) = a; *(u32x4*)(XS + (size_t)s0 * D + 512 + lane * 8) = bq;
        *(u32x4*)(XS + (size_t)s1 * D + lane * 8) = a; *(u32x4*)(XS + (size_t)s1 * D + 512 + lane * 8) = bq;
        if (lane == 0) { r[6] = s0; r[7] = s1; }
    }
}

__device__ __forceinline__ void phase12(const P& p) {
    const int tid = threadIdx.x, lane = tid & 63, wave = tid >> 6;
    const float* mod = (const float*)(p.ws + WS_MOD); const bf16_t* Y = (const bf16_t*)(p.ws + WS_Z); const int* RT = (const int*)(p.ws + WS_ROUTE);
    const int gw = blockIdx.x * 8 + wave, NGW = gridDim.x * 8;
    for (int row = gw; row < MX; row += NGW) {
        const int* r = RT + (size_t)row * 8; const int s0 = r[6], s1 = r[7]; const float w0 = ((const float*)r)[4], w1 = ((const float*)r)[5];
        float* xr = p.out + (size_t)row * D; const float* g2 = mod + (size_t)(row >> 12) * 6144 + 5120;
        f32x4 v[4]; float ss = 0.f;
#pragma unroll
        for (int j = 0; j < 4; ++j) { const int k = 4 * lane + 256 * j;
            const f32x4 x1 = *(const f32x4*)(xr + k), g = *(const f32x4*)(g2 + k);
            const u32x2 ya = *(const u32x2*)(Y + (size_t)s0 * D + k), yb = *(const u32x2*)(Y + (size_t)s1 * D + k);
            f32x4 m; m.x = w0 * bflo(ya.x) + w1 * bflo(yb.x); m.y = w0 * bfhi(ya.x) + w1 * bfhi(yb.x); m.z = w0 * bflo(ya.y) + w1 * bflo(yb.y); m.w = w0 * bfhi(ya.y) + w1 * bfhi(yb.y);
            v[j] = x1 + g * m; ss += v[j].x * v[j].x + v[j].y * v[j].y + v[j].z * v[j].z + v[j].w * v[j].w; }
        const float rstd = 1.f / sqrtf(wave_sum(ss) * (1.f / D) + EPS);
#pragma unroll
        for (int j = 0; j < 4; ++j) { const int k = 4 * lane + 256 * j; const f32x4 g = *(const f32x4*)(p.in[24] + k); *(f32x4*)(xr + k) = v[j] * rstd * g; }
    }
}

constexpr int NPH = 13;
__global__ void __launch_bounds__(NTHR, 2) mega(P p) {
    extern __shared__ __attribute__((aligned(16))) unsigned char lds_raw[];
    LAS unsigned char* lds = (LAS unsigned char*)lds_raw;
    cg::grid_group grid = cg::this_grid();
    const int lo = p.ph_lo, hi = p.ph_hi;
    const int G = gridDim.x, bx = blockIdx.x;
    const int vcu = (G % 8 == 0) ? (bx % 8) * (G / 8) + bx / 8 : bx;
#ifndef PHASE_MASK
#define PHASE_MASK 0x1fff
#endif
#define IN(k) (((PHASE_MASK >> (k)) & 1) && lo <= (k) && (k) < hi)
#define SEAM(k) do { if ((k) + 1 < hi) grid.sync(); } while (0)
    if (IN(0)) { phase0(p, lds); SEAM(0); }
    if (IN(1)) { phase1(p); SEAM(1); }
    if (IN(2)) {
        pg8::SchedDense S; S.nM = MT / 256; S.nN = NPADW / 256; S.nwg = S.nM * S.nN; S.G = G; S.c = bx; S.K = 1024; S.A = (const char*)(p.ws + WS_A); S.Bt = (const char*)(p.ws + WS_WINT);
        EpiZ E; E.Z = (bf16_t*)(p.ws + WS_Z); E.G = (float*)(p.ws + WS_GATES);
        pg8::gemm_phase(lds, 1024, S, E); SEAM(2); }
    if (IN(3)) { phase3(p); SEAM(3); }
    if (IN(4)) { phase4(p, lds); SEAM(4); }
    if (IN(5)) { phase5(p); SEAM(5); }
    if (IN(6)) { phase6(p, lds); SEAM(6); }
    if (IN(7)) {
        pg8::SchedDense S; S.nM = MX / 256; S.nN = 4; S.nwg = S.nM * S.nN; S.G = G; S.c = bx; S.K = 1024; S.A = (const char*)(p.ws + WS_A); S.Bt = (const char*)(p.ws + WS_WOUTT);
        EpiX1 E; E.x = p.in[0]; E.mod = (const float*)(p.ws + WS_MOD); E.out = p.out;
        pg8::gemm_phase(lds, 1024, S, E); SEAM(7); }
    if (IN(8)) { phase8(p, lds); SEAM(8); }
    if (IN(9)) { phase9(p, lds); SEAM(9); }
    if (IN(10)) {
        LAS int* PST = (LAS int*)(lds + pg8::STAGE_BYTES); LAS int* TEX = PST + 64;
        const int ntiles = build_tables(p, PST, TEX);
        pg8::SchedMoE S; S.ntiles = ntiles; S.G = G; S.c = vcu; S.K = 1024; S.tex = TEX; S.A = (const char*)(p.ws + WS_Z); S.Bt = (const char*)(p.ws + WS_E1T); S.bstride = (size_t)1024 * 1024 * 2;
        EpiH E; E.H = (bf16_t*)(p.ws + WS_UM);
        pg8::gemm_phase(lds, 1024, S, E); SEAM(10); }
    if (IN(11)) {
        LAS int* PST = (LAS int*)(lds + pg8::STAGE_BYTES); LAS int* TEX = PST + 64;
        const int ntiles = build_tables(p, PST, TEX);
        pg8::SchedMoE S; S.ntiles = ntiles; S.G = G; S.c = vcu; S.K = 512; S.tex = TEX; S.A = (const char*)(p.ws + WS_UM); S.Bt = (const char*)(p.ws + WS_E2T); S.bstride = (size_t)1024 * 512 * 2;
        EpiY E; E.Y = (bf16_t*)(p.ws + WS_Z);
        pg8::gemm_phase(lds, 512, S, E); SEAM(11); }
    if (IN(12)) { phase12(p); }
#undef IN
#undef SEAM
}

extern "C" void kernel_launch(void* const* d_in, const int* in_sizes, int n_in, void* d_out, int out_size, void* d_ws, size_t ws_size, hipStream_t stream) {
    static int grid = 0;
    if (grid == 0) {
        if (n_in != 25 || out_size != MX * D || ws_size < WS_END) { fprintf(stderr, "kernel_launch: unexpected problem (n_in %d out %d ws %zu)\n", n_in, out_size, ws_size); grid = -1; return; }
        int dev = 0, cus = 0, per_cu = 0;
        hipGetDevice(&dev); hipDeviceGetAttribute(&cus, hipDeviceAttributeMultiprocessorCount, dev);
        if (hipFuncSetAttribute((const void*)mega, hipFuncAttributeMaxDynamicSharedMemorySize, LDS_BYTES) != hipSuccess) { fprintf(stderr, "kernel_launch: hipFuncSetAttribute failed\n"); grid = -1; return; }
        if (hipOccupancyMaxActiveBlocksPerMultiprocessor(&per_cu, (const void*)mega, NTHR, LDS_BYTES) != hipSuccess || per_cu < 1) { fprintf(stderr, "kernel_launch: occupancy query says %d\n", per_cu); per_cu = 1; }
        (void)hipGetLastError();
        grid = cus;
    }
    if (grid < 0) return;
    hipMemsetAsync((char*)d_ws + WS_CTL, 0, 1 * MiB, stream);
    P a{};
    for (int i = 0; i < 25; ++i) a.in[i] = (const float*)d_in[i];
    a.out = (float*)d_out; a.ws = (unsigned char*)d_ws;
#if N_LAUNCH_MODE == 1
    a.ph_lo = 0; a.ph_hi = NPH;
    void* args[] = {&a};
    hipError_t e = hipLaunchCooperativeKernel((const void*)mega, dim3(grid), dim3(NTHR), args, LDS_BYTES, stream);
    if (e != hipSuccess) fprintf(stderr, "cooperative launch failed: %s (grid %d)\n", hipGetErrorString(e), grid);
#else
    for (int ph = 0; ph < NPH; ++ph) { a.ph_lo = ph; a.ph_hi = ph + 1; hipLaunchKernelGGL(mega, dim3(grid), dim3(NTHR), LDS_BYTES, stream, a); }
#endif
}
```

```cpp
#include <hip/hip_runtime.h>
#include <hip/hip_cooperative_groups.h>
#include <cstdio>
namespace cg = cooperative_groups;

#ifndef N_LAUNCH_MODE
#define N_LAUNCH_MODE 1
#endif

#define LAS __attribute__((address_space(3)))
typedef unsigned short bf16_t;
typedef short bf16x8 __attribute__((ext_vector_type(8)));
typedef float f32x4 __attribute__((ext_vector_type(4)));
typedef float f32x16 __attribute__((ext_vector_type(16)));
typedef unsigned u32x2 __attribute__((ext_vector_type(2)));
typedef unsigned u32x4 __attribute__((ext_vector_type(4)));

constexpr int D = 1024, NB = 4, SEQ = 4096, CTXL = 256;
constexpr int MX = NB * SEQ, MC = NB * CTXL, MT = MX + MC;
constexpr int INW = 3632, ZLD = 3584, NPADW = 3840;
constexpr int NCH = 68;
constexpr int NSTATE = NB * 4 * NCH;
constexpr float EPS = 1e-6f;
constexpr int NTHR = 512;
constexpr int LDS_BYTES = 160 * 1024;

constexpr size_t MiB = 1u << 20;
constexpr size_t WS_CTL = 0;
constexpr size_t WS_MOD = 1 * MiB;
constexpr size_t WS_ROUTE = 2 * MiB;
constexpr size_t WS_GDEC = 3 * MiB;
constexpr size_t WS_MN = 4 * MiB;
constexpr size_t WS_MSC = 6 * MiB;
constexpr size_t WS_GATES = 7 * MiB;
constexpr size_t WS_WINT = 11 * MiB;
constexpr size_t WS_WOUTT = 19 * MiB;
constexpr size_t WS_E1T = 21 * MiB;
constexpr size_t WS_E2T = 85 * MiB;
constexpr size_t WS_A = 117 * MiB;
constexpr size_t WS_Z = 151 * MiB;
constexpr size_t WS_MQ = 270 * MiB;
constexpr size_t WS_MK = 287 * MiB;
constexpr size_t WS_UG = 304 * MiB;
constexpr size_t WS_UM = 338 * MiB;
constexpr size_t WS_END = 406 * MiB;
constexpr int CW_CNT = 64;

struct P { const float* in[25]; float* out; unsigned char* ws; int ph_lo, ph_hi; };

__device__ __forceinline__ unsigned f2bf(float f) { unsigned u = __float_as_uint(f); return (u + 0x7fffu + ((u >> 16) & 1u)) >> 16; }
__device__ __forceinline__ unsigned pk2(float lo, float hi) { return f2bf(lo) | (f2bf(hi) << 16); }
__device__ __forceinline__ float bf2f(unsigned b) { return __uint_as_float(b << 16); }
__device__ __forceinline__ float bflo(unsigned w) { return __uint_as_float(w << 16); }
__device__ __forceinline__ float bfhi(unsigned w) { return __uint_as_float(w & 0xffff0000u); }
__device__ __forceinline__ float wave_sum(float v) {
#pragma unroll
    for (int o = 32; o >= 1; o >>= 1) v += __shfl_xor(v, o);
    return v;
}
__device__ __forceinline__ float siluf(float x) { return x / (1.f + __expf(-x)); }
__device__ __forceinline__ float sigmf(float x) { return 1.f / (1.f + __expf(-x)); }
__device__ __forceinline__ float logsigf(float x) { return fminf(x, 0.f) - __logf(1.f + __expf(-fabsf(x))); }

__device__ __forceinline__ bf16x8 ldfrag(const LAS bf16_t* T, int ld, int row0, int k0, int lane) {
    return *(const LAS bf16x8*)(T + (row0 + (lane & 31)) * ld + k0 + 8 * (lane >> 5));
}
#define MFMA32(a, b, c) __builtin_amdgcn_mfma_f32_32x32x16_bf16((a), (b), (c), 0, 0, 0)
__device__ __forceinline__ int crow(int r, int lane) { return (r & 3) + 8 * (r >> 2) + 4 * (lane >> 5); }

namespace pg8 {
constexpr int BM = 256, BK = 64, HALF = 128, HTB = HALF * BK * 2, STAGE_BYTES = 8 * HTB;
__device__ __forceinline__ int lds_byte(int r, int c) { const int st = (r >> 4) * 2 + (c >> 5), rr = r & 15, cc = c & 31, ob = rr * 64 + cc * 2; return st * 1024 + (ob ^ (((ob >> 9) & 1) << 5)); }
__device__ __forceinline__ void stage_rc(int b, int& R, int& C) { const int st = b / 1024, sb = b % 1024, swz = sb ^ (((sb >> 9) & 1) << 5); R = (st >> 1) * 16 + swz / 64; C = (st & 1) * 32 + (swz % 64) / 2; }
__device__ __forceinline__ int perm32(int rho) { const int n = rho >> 4, i = rho & 15; return 8 * (i >> 2) + 4 * n + (i & 3); }
struct Unit { int pm, pn; const char* a; const char* b; };

template <class Epi, class Sched>
__device__ __forceinline__ void gemm_phase(LAS unsigned char* lds, const int K, const Sched& S, const Epi& E) {
    const int tid = threadIdx.x, wid = __builtin_amdgcn_readfirstlane(tid >> 6), lane = tid & 63, wr = wid >> 2, wc = wid & 3, fr = lane & 15, fq = lane >> 4;
    const int nt = K / BK;
    unsigned voffA[2], voffB[2];
#pragma unroll
    for (int i = 0; i < 2; ++i) { int R, C; stage_rc(tid * 16 + i * 8192, R, C); const int Rb = Epi::PERM ? ((R & ~31) + perm32(R & 31)) : R;
        voffA[i] = (unsigned)(R * K + C) * 2u; voffB[i] = (unsigned)(Rb * K + C) * 2u; }
    const size_t kstep = (size_t)(BK * 2);
    const size_t hstep = (size_t)HALF * K * 2;
    const unsigned ldsw = (unsigned)wid * 1024u;
    const int aoff = lds_byte(wr * 64 + fr, fq * 8), boff = lds_byte(wc * 32 + fr, fq * 8);
#define PG8_SA(b, h) (((b) * 2 + (h)) * HTB)
#define PG8_SB(b, h) ((4 + (b) * 2 + (h)) * HTB)
#define PG8_STAGE(bufoff, gbase, voff) do { _Pragma("unroll") for (int _i = 0; _i < 2; ++_i) \
        __builtin_amdgcn_global_load_lds((const unsigned*)((const char*)(gbase) + (voff)[_i]), (LAS unsigned*)(lds + (bufoff) + ldsw + _i * 8192), 16, 0, 0); } while (0)
#define PG8_LDA(dst, b, h) do { _Pragma("unroll") for (int m = 0; m < 4; ++m) _Pragma("unroll") for (int k = 0; k < 2; ++k) dst[m][k] = *(const LAS bf16x8*)(lds + PG8_SA(b, h) + aoff + m * 2048 + k * 1024); } while (0)
#define PG8_LDB(dst, b, h) do { _Pragma("unroll") for (int n = 0; n < 2; ++n) _Pragma("unroll") for (int k = 0; k < 2; ++k) dst[n][k] = *(const LAS bf16x8*)(lds + PG8_SB(b, h) + boff + n * 2048 + k * 1024); } while (0)
#define PG8_MMA(ai, bj, At, Bt) do { __builtin_amdgcn_s_setprio(1); _Pragma("unroll") for (int m = 0; m < 4; ++m) _Pragma("unroll") for (int n = 0; n < 2; ++n) _Pragma("unroll") for (int k = 0; k < 2; ++k) \
        acc[ai][bj][m][n] = __builtin_amdgcn_mfma_f32_16x16x32_bf16(Bt[n][k], At[m][k], acc[ai][bj][m][n], 0, 0, 0); __builtin_amdgcn_s_setprio(0); } while (0)
#define PG8_WAIT_V(n) asm volatile("s_waitcnt vmcnt(" #n ")" ::: "memory")
#define PG8_WAIT_L(n) asm volatile("s_waitcnt lgkmcnt(" #n ")" ::: "memory")
#define PG8_BAR __builtin_amdgcn_s_barrier()
#define PG8_SCHED __builtin_amdgcn_sched_barrier(0)
    Unit cur, nxt; int ui = 0;
    if (!S.next(0, cur)) return;
    f32x4 acc[2][2][4][2];
#pragma unroll
    for (int a = 0; a < 2; ++a)
#pragma unroll
        for (int b = 0; b < 2; ++b)
#pragma unroll
            for (int m = 0; m < 4; ++m)
#pragma unroll
                for (int n = 0; n < 2; ++n) acc[a][b][m][n] = (f32x4){0.f, 0.f, 0.f, 0.f};
    bf16x8 At[4][2], B0[2][2], B1[2][2];
    const char* cA = cur.a; const char* cB = cur.b;
    PG8_STAGE(PG8_SB(0, 0), cB, voffB); PG8_STAGE(PG8_SA(0, 0), cA, voffA); PG8_STAGE(PG8_SB(0, 1), cB + hstep, voffB); PG8_STAGE(PG8_SA(0, 1), cA + hstep, voffA);
    if (wr == 1) PG8_BAR;
    PG8_WAIT_V(4); PG8_BAR;
    PG8_STAGE(PG8_SB(1, 0), cB + kstep, voffB); PG8_STAGE(PG8_SA(1, 0), cA + kstep, voffA); PG8_STAGE(PG8_SB(1, 1), cB + hstep + kstep, voffB);
    PG8_WAIT_V(6); PG8_BAR;
    for (;;) {
        const bool has_next = S.next(ui + 1, nxt);
        const char* nA = has_next ? nxt.a : cA; const char* nB = has_next ? nxt.b : cB;
        for (int t = 0; t < nt; t += 2) {
            const bool last = (t == nt - 2);
            const char* a1 = cA + (size_t)(t + 1) * kstep;
            const char* a2 = last ? nA : cA + (size_t)(t + 2) * kstep; const char* b2 = last ? nB : cB + (size_t)(t + 2) * kstep;
            const char* a3 = a2 + kstep; const char* b3 = b2 + kstep;
            PG8_LDB(B0, 0, 0); PG8_SCHED; PG8_LDA(At, 0, 0); PG8_STAGE(PG8_SA(1, 1), a1 + hstep, voffA);
            PG8_WAIT_L(8); PG8_BAR; PG8_WAIT_L(0); PG8_MMA(0, 0, At, B0); PG8_BAR; PG8_SCHED;
            PG8_LDB(B1, 0, 1); PG8_STAGE(PG8_SB(0, 0), b2, voffB);
            PG8_BAR; PG8_WAIT_L(0); PG8_MMA(0, 1, At, B1); PG8_BAR;
            PG8_LDA(At, 0, 1); PG8_STAGE(PG8_SA(0, 0), a2, voffA);
            PG8_BAR; PG8_WAIT_L(0); PG8_MMA(1, 0, At, B0); PG8_BAR; PG8_SCHED;
            PG8_STAGE(PG8_SB(0, 1), b2 + hstep, voffB);
            PG8_WAIT_V(6); PG8_BAR; PG8_MMA(1, 1, At, B1); PG8_BAR;
            PG8_LDB(B0, 1, 0); PG8_SCHED; PG8_LDA(At, 1, 0); PG8_STAGE(PG8_SA(0, 1), a2 + hstep, voffA);
            PG8_WAIT_L(8); PG8_BAR; PG8_WAIT_L(0); PG8_MMA(0, 0, At, B0); PG8_BAR; PG8_SCHED;
            PG8_LDB(B1, 1, 1); PG8_STAGE(PG8_SB(1, 0), b3, voffB);
            PG8_BAR; PG8_WAIT_L(0); PG8_MMA(0, 1, At, B1); PG8_BAR;
            PG8_LDA(At, 1, 1); PG8_STAGE(PG8_SA(1, 0), a3, voffA);
            PG8_BAR; PG8_WAIT_L(0); PG8_MMA(1, 0, At, B0); PG8_BAR; PG8_SCHED;
            PG8_STAGE(PG8_SB(1, 1), b3 + hstep, voffB);
            PG8_WAIT_V(6); PG8_BAR; PG8_MMA(1, 1, At, B1); PG8_BAR;
        }
        E(acc, cur, wr, wc, fr, fq);
        if (!has_next) break;
#pragma unroll
        for (int a = 0; a < 2; ++a)
#pragma unroll
            for (int b = 0; b < 2; ++b)
#pragma unroll
                for (int m = 0; m < 4; ++m)
#pragma unroll
                    for (int n = 0; n < 2; ++n) acc[a][b][m][n] = (f32x4){0.f, 0.f, 0.f, 0.f};
        cur = nxt; cA = nA; cB = nB; ++ui;
    }
    PG8_WAIT_V(0);
    if (wr == 0) PG8_BAR;
    PG8_BAR;
#undef PG8_SA
#undef PG8_SB
#undef PG8_STAGE
#undef PG8_LDA
#undef PG8_LDB
#undef PG8_MMA
#undef PG8_WAIT_V
#undef PG8_WAIT_L
#undef PG8_BAR
#undef PG8_SCHED
}

struct SchedDense {
    int nM, nN, nwg, G, c, K; const char* A; const char* Bt;
    __device__ __forceinline__ bool next(int i, Unit& u) const {
        const long L = (long)i * G + c; if (L >= nwg) return false;
        int wgid = (int)L; { const int q = nwg / 8, r = nwg % 8, xcd = wgid % 8, off = wgid / 8; wgid = (xcd < r ? xcd * (q + 1) : r * (q + 1) + (xcd - r) * q) + off; }
        const int nig = 8 * nN, gid = wgid / nig, fm = gid * 8, gsz = (nM - fm) < 8 ? (nM - fm) : 8;
        u.pm = fm + ((wgid % nig) % gsz); u.pn = (wgid % nig) / gsz;
        u.a = A + (size_t)u.pm * 256 * K * 2; u.b = Bt + (size_t)u.pn * 256 * K * 2; return true;
    }
};
struct SchedMoE {
    int ntiles, G, c, K; const LAS int* tex; const char* A; const char* Bt; size_t bstride;
    __device__ __forceinline__ bool next(int i, Unit& u) const {
        const int L = i * G + c; const int rt = L >> 2; if (rt >= ntiles) return false;
        u.pm = rt; u.pn = L & 3; const int e = tex[rt];
        u.a = A + (size_t)rt * 256 * K * 2; u.b = Bt + (size_t)e * bstride + (size_t)u.pn * 256 * K * 2; return true;
    }
};
}

typedef const f32x4 (&AccRef)[2][2][4][2];
struct EpiZ {
    static constexpr bool PERM = true; bf16_t* Z; float* G;
    __device__ __forceinline__ void operator()(AccRef acc, const pg8::Unit& u, int wr, int wc, int fr, int fq) const {
        const int row0 = u.pm * 256 + wr * 64 + fr;
        if (u.pn < 14) {
            const int col0 = u.pn * 256 + wc * 32 + 8 * fq;
#pragma unroll
            for (int ai = 0; ai < 2; ++ai)
#pragma unroll
                for (int m = 0; m < 4; ++m) { bf16_t* rowp = Z + (size_t)(row0 + ai * 128 + m * 16) * ZLD + col0;
#pragma unroll
                    for (int bj = 0; bj < 2; ++bj) { const f32x4 v0 = acc[ai][bj][m][0], v1 = acc[ai][bj][m][1];
                        u32x4 o; o.x = pk2(v0[0], v0[1]); o.y = pk2(v0[2], v0[3]); o.z = pk2(v1[0], v1[1]); o.w = pk2(v1[2], v1[3]);
                        *(u32x4*)(rowp + bj * 128) = o; } }
        } else {
            const int c0 = wc * 32 + 8 * fq;
            if (c0 < 48) {
#pragma unroll
                for (int ai = 0; ai < 2; ++ai)
#pragma unroll
                    for (int m = 0; m < 4; ++m) { float* rowp = G + (size_t)(row0 + ai * 128 + m * 16) * 48 + c0;
                        *(f32x4*)rowp = acc[ai][0][m][0]; *(f32x4*)(rowp + 4) = acc[ai][0][m][1]; }
            }
        }
    }
};
struct EpiX1 {
    static constexpr bool PERM = false; const float* x; const float* mod; float* out;
    __device__ __forceinline__ void operator()(AccRef acc, const pg8::Unit& u, int wr, int wc, int fr, int fq) const {
        const int row0 = u.pm * 256 + wr * 64 + fr, col0 = u.pn * 256 + wc * 32 + 4 * fq;
        const float* g1 = mod + (size_t)(u.pm >> 4) * 6144 + 2048;
        f32x4 gv[2][2];
#pragma unroll
        for (int bj = 0; bj < 2; ++bj)
#pragma unroll
            for (int n = 0; n < 2; ++n) gv[bj][n] = *(const f32x4*)(g1 + col0 + bj * 128 + n * 16);
#pragma unroll
        for (int ai = 0; ai < 2; ++ai)
#pragma unroll
            for (int m = 0; m < 4; ++m) { const size_t off = (size_t)(row0 + ai * 128 + m * 16) * D + col0;
#pragma unroll
                for (int bj = 0; bj < 2; ++bj)
#pragma unroll
                    for (int n = 0; n < 2; ++n) { const f32x4 xv = *(const f32x4*)(x + off + bj * 128 + n * 16);
                        *(f32x4*)(out + off + bj * 128 + n * 16) = xv + gv[bj][n] * acc[ai][bj][m][n]; } }
    }
};
struct EpiH {
    static constexpr bool PERM = true; bf16_t* H;
    __device__ __forceinline__ void operator()(AccRef acc, const pg8::Unit& u, int wr, int wc, int fr, int fq) const {
        const int row0 = u.pm * 256 + wr * 64 + fr, col0 = u.pn * 128 + wc * 32 + 8 * fq;
#pragma unroll
        for (int ai = 0; ai < 2; ++ai)
#pragma unroll
            for (int m = 0; m < 4; ++m) { bf16_t* rowp = H + (size_t)(row0 + ai * 128 + m * 16) * 512 + col0;
                float h[8];
#pragma unroll
                for (int n = 0; n < 2; ++n)
#pragma unroll
                    for (int j = 0; j < 4; ++j) { const float g = acc[ai][0][m][n][j], up = acc[ai][1][m][n][j]; h[n * 4 + j] = siluf(g) * up; }
                u32x4 o; o.x = pk2(h[0], h[1]); o.y = pk2(h[2], h[3]); o.z = pk2(h[4], h[5]); o.w = pk2(h[6], h[7]);
                *(u32x4*)rowp = o; }
    }
};
struct EpiY {
    static constexpr bool PERM = true; bf16_t* Y;
    __device__ __forceinline__ void operator()(AccRef acc, const pg8::Unit& u, int wr, int wc, int fr, int fq) const {
        const int row0 = u.pm * 256 + wr * 64 + fr, col0 = u.pn * 256 + wc * 32 + 8 * fq;
#pragma unroll
        for (int ai = 0; ai < 2; ++ai)
#pragma unroll
            for (int m = 0; m < 4; ++m) { bf16_t* rowp = Y + (size_t)(row0 + ai * 128 + m * 16) * D + col0;
#pragma unroll
                for (int bj = 0; bj < 2; ++bj) { const f32x4 v0 = acc[ai][bj][m][0], v1 = acc[ai][bj][m][1];
                    u32x4 o; o.x = pk2(v0[0], v0[1]); o.y = pk2(v0[2], v0[3]); o.z = pk2(v1[0], v1[1]); o.w = pk2(v1[2], v1[3]);
                    *(u32x4*)(rowp + bj * 128) = o; } }
    }
};

__device__ __forceinline__ void p0_mod_item(const P& p, LAS unsigned char* lds, int item) {
    LAS float* SV = (LAS float*)lds; LAS float* PS = (LAS float*)(lds + 20480);
    const int tid = threadIdx.x;
    for (int i = tid; i < 5 * 1024; i += NTHR) { const int v = i >> 10, k = i & 1023; const float c = v < 4 ? p.in[1][v * 1024 + k] : p.in[3][k]; SV[i] = c / (1.f + expf(-c)); }
    __syncthreads();
    const int col = tid & 31, kq = tid >> 5, n = item * 32 + col;
    float acc[5] = {0.f, 0.f, 0.f, 0.f, 0.f};
    const float* W = p.in[4] + (size_t)(kq * 64) * 6144 + n;
#pragma unroll 8
    for (int k = 0; k < 64; ++k) { const float w = W[(size_t)k * 6144]; const int kk = kq * 64 + k;
#pragma unroll
        for (int v = 0; v < 5; ++v) acc[v] += SV[v * 1024 + kk] * w; }
#pragma unroll
    for (int v = 0; v < 5; ++v) PS[(kq * 5 + v) * 32 + col] = acc[v];
    __syncthreads();
    if (tid < 160) { const int v = tid >> 5, c = tid & 31; float s = 0.f;
#pragma unroll
        for (int q = 0; q < 16; ++q) s += PS[(q * 5 + v) * 32 + c];
        ((float*)(p.ws + WS_MOD))[v * 6144 + item * 32 + c] = s + p.in[5][item * 32 + c]; }
    __syncthreads();
}
template <class RowMap>
__device__ __forceinline__ void transpose_item(const float* W, int K, int N, bf16_t* WT, LAS float* scr, int kb, int nb, int lane, RowMap rm) {
    const int k0 = 64 * kb, n0 = 32 * nb;
#pragma unroll 8
    for (int i = 0; i < 32; ++i) { const int kk = 2 * i + (lane >> 5), n = n0 + (lane & 31); scr[kk * 33 + (lane & 31)] = n < N ? W[(size_t)(k0 + kk) * N + n] : 0.f; }
    asm volatile("s_waitcnt lgkmcnt(0)" ::: "memory");
    const int c = lane & 7;
#pragma unroll
    for (int j = 0; j < 4; ++j) { const int nl = (lane >> 3) + 8 * j, n = n0 + nl;
        if (n < N) { const LAS float* s = scr + (8 * c) * 33 + nl;
            u32x4 o; o.x = pk2(s[0 * 33], s[1 * 33]); o.y = pk2(s[2 * 33], s[3 * 33]); o.z = pk2(s[4 * 33], s[5 * 33]); o.w = pk2(s[6 * 33], s[7 * 33]);
            *(u32x4*)(WT + (size_t)rm(n) * K + k0 + 8 * c) = o; } }
    asm volatile("s_waitcnt lgkmcnt(0)" ::: "memory");
}
struct RmIn { __device__ __forceinline__ int operator()(int n) const { return n < 1536 ? n : (n < 1568 ? n + 2048 : (n < 3616 ? n - 32 : n)); } };
struct RmId { __device__ __forceinline__ int operator()(int n) const { return n; } };
struct RmE1 { __device__ __forceinline__ int operator()(int n) const { const int half = n >> 9, r = n & 511; return (r >> 7) * 256 + half * 128 + (r & 127); } };

__device__ __forceinline__ void phase0(const P& p, LAS unsigned char* lds) {
    const int tid = threadIdx.x, lane = tid & 63, wave = tid >> 6;
    for (int it = blockIdx.x; it < 192; it += gridDim.x) p0_mod_item(p, lds, it);
    LAS float* scr = (LAS float*)(lds + wave * 16384);
    const int gw = blockIdx.x * 8 + wave, NGW = gridDim.x * 8;
    constexpr int I_IN = 16 * 114, I_OUT = 16 * 32, I_E1 = 32 * 16 * 32, I_E2 = 32 * 8 * 32, NIT = I_IN + I_OUT + I_E1 + I_E2;
    bf16_t* WINT = (bf16_t*)(p.ws + WS_WINT); bf16_t* WOUTT = (bf16_t*)(p.ws + WS_WOUTT); bf16_t* E1T = (bf16_t*)(p.ws + WS_E1T); bf16_t* E2T = (bf16_t*)(p.ws + WS_E2T);
    for (int it = gw; it < NIT; it += NGW) {
        int r = it;
        if (r < I_IN) { transpose_item(p.in[7], 1024, INW, WINT, scr, r / 114, r % 114, lane, RmIn()); continue; } r -= I_IN;
        if (r < I_OUT) { transpose_item(p.in[16], 1024, 1024, WOUTT, scr, r >> 5, r & 31, lane, RmId()); continue; } r -= I_OUT;
        if (r < I_E1) { const int e = r >> 9, q = r & 511; transpose_item(p.in[22] + (size_t)e * 1024 * 1024, 1024, 1024, E1T + (size_t)e * 1024 * 1024, scr, q >> 5, q & 31, lane, RmE1()); continue; } r -= I_E1;
        { const int e = r >> 8, q = r & 255; transpose_item(p.in[23] + (size_t)e * 512 * 1024, 512, 1024, E2T + (size_t)e * 1024 * 512, scr, q >> 5, q & 31, lane, RmId()); }
    }
    for (int i = blockIdx.x * NTHR + tid; i < 208 * 128; i += gridDim.x * NTHR) ((u32x4*)(WINT + (size_t)INW * 1024))[i] = (u32x4){0u, 0u, 0u, 0u};
}

__device__ __forceinline__ void phase1(const P& p) {
    const int tid = threadIdx.x, lane = tid & 63, wave = tid >> 6;
    const float* mod = (const float*)(p.ws + WS_MOD); bf16_t* A = (bf16_t*)(p.ws + WS_A);
    const int gw = blockIdx.x * 8 + wave, NGW = gridDim.x * 8;
    for (int row = gw; row < MT; row += NGW) {
        const float* src = row < MX ? p.in[0] + (size_t)row * D : p.in[2] + (size_t)(row - MX) * D;
        const float* mv = mod + (size_t)(row < MX ? (row >> 12) : 4) * 6144;
        f32x4 v[4]; float ss = 0.f;
#pragma unroll
        for (int j = 0; j < 4; ++j) { v[j] = *(const f32x4*)(src + 4 * lane + 256 * j); ss += v[j].x * v[j].x + v[j].y * v[j].y + v[j].z * v[j].z + v[j].w * v[j].w; }
        const float rstd = 1.f / sqrtf(wave_sum(ss) * (1.f / D) + EPS);
#pragma unroll
        for (int j = 0; j < 4; ++j) { const int k = 4 * lane + 256 * j;
            const f32x4 g = *(const f32x4*)(p.in[6] + k), sh = *(const f32x4*)(mv + k), sc = *(const f32x4*)(mv + 1024 + k);
            const f32x4 o = (v[j] * rstd * g) * (sc + 1.f) + sh;
            u32x2 w; w.x = pk2(o.x, o.y); w.y = pk2(o.z, o.w);
            *(u32x2*)(A + (size_t)row * D + k) = w; }
    }
}

__device__ __forceinline__ void phase3(const P& p) {
    const bf16_t* Z = (const bf16_t*)(p.ws + WS_Z); bf16_t* MQ = (bf16_t*)(p.ws + WS_MQ); bf16_t* MK = (bf16_t*)(p.ws + WS_MK);
    const int tid = threadIdx.x, cg8 = tid & 127, tl = tid >> 7, ch0 = cg8 * 8;
    float w[9][8], bias[8];
#pragma unroll
    for (int a = 0; a < 9; ++a)
#pragma unroll
        for (int j = 0; j < 8; ++j) w[a][j] = p.in[11][a * 1024 + ch0 + j];
#pragma unroll
    for (int j = 0; j < 8; ++j) bias[j] = p.in[12][ch0 + j];
    const float osc = ch0 >= 512 ? 0.08838834764831845f : 1.f;
    bf16_t* dst = ch0 >= 512 ? MK : MQ;
    for (int it = blockIdx.x; it < 272; it += gridDim.x) {
        int rowbase, y, Hh, Ww, x0;
        if (it < 256) { rowbase = (it >> 6) * 4096; y = it & 63; Hh = 64; Ww = 64; x0 = 0; }
        else { const int ci = it - 256; rowbase = MX + (ci >> 2) * 256; y = 0; Hh = 1; Ww = 256; x0 = (ci & 3) * 64; }
        for (int i = 0; i < 16; ++i) {
            const int x = x0 + tl + 4 * i;
            float acc[8];
#pragma unroll
            for (int j = 0; j < 8; ++j) acc[j] = bias[j];
#pragma unroll
            for (int dy = 0; dy < 3; ++dy) { const int yy = y + dy - 1; if (yy < 0 || yy >= Hh) continue;
#pragma unroll
                for (int dx = 0; dx < 3; ++dx) { const int xx = x + dx - 1; if (xx < 0 || xx >= Ww) continue;
                    const u32x4 v = *(const u32x4*)(Z + (size_t)(rowbase + yy * Ww + xx) * ZLD + 1536 + ch0);
                    acc[0] += w[dy * 3 + dx][0] * bflo(v.x); acc[1] += w[dy * 3 + dx][1] * bfhi(v.x);
                    acc[2] += w[dy * 3 + dx][2] * bflo(v.y); acc[3] += w[dy * 3 + dx][3] * bfhi(v.y);
                    acc[4] += w[dy * 3 + dx][4] * bflo(v.z); acc[5] += w[dy * 3 + dx][5] * bfhi(v.z);
                    acc[6] += w[dy * 3 + dx][6] * bflo(v.w); acc[7] += w[dy * 3 + dx][7] * bfhi(v.w); } }
#pragma unroll
            for (int j = 0; j < 8; ++j) acc[j] = siluf(acc[j]) * osc;
            u32x4 o; o.x = pk2(acc[0], acc[1]); o.y = pk2(acc[2], acc[3]); o.z = pk2(acc[4], acc[5]); o.w = pk2(acc[6], acc[7]);
            *(u32x4*)(dst + (size_t)(rowbase + y * Ww + x) * 512 + (ch0 & 511)) = o;
        }
    }
}

__device__ __forceinline__ int chunk_tok0(int b, int tc) { return tc < 64 ? b * SEQ + tc * 64 : MX + b * CTXL + (tc - 64) * 64; }

__device__ __forceinline__ void load_vt(const bf16_t* Z, int tok0, int col0, LAS bf16_t* VT, int tid) {
#pragma unroll
    for (int i = 0; i < 2; ++i) { const int idx = tid + NTHR * i, t = idx >> 4, c = idx & 15;
        const u32x4 v = *(const u32x4*)(Z + (size_t)(tok0 + t) * ZLD + col0 + c * 8);
        LAS bf16_t* d = VT + (c * 8) * 72 + t;
        d[0 * 72] = (bf16_t)(v.x & 0xffff); d[1 * 72] = (bf16_t)(v.x >> 16); d[2 * 72] = (bf16_t)(v.y & 0xffff); d[3 * 72] = (bf16_t)(v.y >> 16);
        d[4 * 72] = (bf16_t)(v.z & 0xffff); d[5 * 72] = (bf16_t)(v.z >> 16); d[6 * 72] = (bf16_t)(v.w & 0xffff); d[7 * 72] = (bf16_t)(v.w >> 16); }
}

__device__ __forceinline__ void p4_gla(const P& p, LAS unsigned char* lds, int b, int h, int tc) {
    const int tid = threadIdx.x, lane = tid & 63, wave = __builtin_amdgcn_readfirstlane(tid >> 6);
    const bf16_t* Z = (const bf16_t*)(p.ws + WS_Z); const float* GT = (const float*)(p.ws + WS_GATES);
    const int tok0 = chunk_tok0(b, tc), sidx = (b * 4 + h) * NCH + tc;
    LAS bf16_t* VT = (LAS bf16_t*)lds; LAS bf16_t* KT = (LAS bf16_t*)(lds + 18432); LAS float* GLR = (LAS float*)(lds + 36864); LAS float* QS = (LAS float*)(lds + 45056);
    load_vt(Z, tok0, 512 + h * 128, VT, tid);
    { const int t = tid >> 3, c4 = tid & 7; *(LAS f32x4*)(GLR + t * 32 + c4 * 4) = *(const f32x4*)(GT + (size_t)(tok0 + t) * 48 + c4 * 4); }
    __syncthreads();
    const int dir = tid >> 8, tq = (tid >> 6) & 3, d = tid & 63;
    float upw[16];
#pragma unroll
    for (int r = 0; r < 16; ++r) upw[r] = p.in[8][(dir * 16 + r) * 256 + h * 64 + d];
    const float upb = p.in[9][dir * 256 + h * 64 + d];
    float la[16]; float tot = 0.f;
#pragma unroll
    for (int i = 0; i < 16; ++i) { const int t = tq * 16 + i; float lg = upb;
#pragma unroll
        for (int r = 0; r < 16; ++r) lg += GLR[t * 32 + dir * 16 + r] * upw[r];
        la[i] = logsigf(lg) * 0.0625f; tot += la[i]; }
    QS[(dir * 4 + tq) * 64 + d] = tot;
    __syncthreads();
    float before = 0.f, all = 0.f;
#pragma unroll
    for (int q = 0; q < 4; ++q) { const float v = QS[(dir * 4 + q) * 64 + d]; all += v; before += (q < tq) ? v : 0.f; }
    float run = before;
#pragma unroll
    for (int i = 0; i < 16; ++i) { const int t = tq * 16 + i;
        const float kx = bf2f(Z[(size_t)(tok0 + t) * ZLD + 256 + h * 64 + d]);
        float e; if (dir == 0) { run += la[i]; e = all - run; } else { e = run; run += la[i]; }
        KT[(dir * 64 + d) * 72 + t] = (bf16_t)f2bf(kx * __expf(e)); }
    if (tq == 0) ((float*)(p.ws + WS_GDEC))[(sidx * 2 + dir) * 64 + d] = __expf(all);
    __syncthreads();
    const int dw = wave >> 2, vt = wave & 3;
    f32x16 acc0, acc1;
#pragma unroll
    for (int r = 0; r < 16; ++r) { acc0[r] = 0.f; acc1[r] = 0.f; }
#pragma unroll
    for (int ks = 0; ks < 4; ++ks) { const bf16x8 a = ldfrag(VT, 72, vt * 32, ks * 16, lane);
        const bf16x8 b0 = ldfrag(KT + dw * 64 * 72, 72, 0, ks * 16, lane), b1 = ldfrag(KT + dw * 64 * 72, 72, 32, ks * 16, lane);
        acc0 = MFMA32(a, b0, acc0); acc1 = MFMA32(a, b1, acc1); }
    bf16_t* U = (bf16_t*)(p.ws + WS_UG) + (size_t)(sidx * 2 + dw) * 8192;
#pragma unroll
    for (int r = 0; r < 16; ++r) { const int v = vt * 32 + crow(r, lane); U[v * 64 + (lane & 31)] = (bf16_t)f2bf(acc0[r]); U[v * 64 + 32 + (lane & 31)] = (bf16_t)f2bf(acc1[r]); }
    __syncthreads();
}

__device__ __forceinline__ void load_ml_gates(const P& p, int tok0, int h, LAS float* IG, LAS float* LF, int tid) {
    if (tid < 128) { const int dir = tid >> 6, t = tid & 63; const float* g = (const float*)(p.ws + WS_GATES) + (size_t)(tok0 + t) * 48;
        IG[dir * 64 + t] = g[32 + dir * 4 + h] + p.in[13][dir * 4 + h];
        LF[dir * 64 + t] = logsigf(g[40 + dir * 4 + h] + p.in[14][dir * 4 + h]); }
}

__device__ __forceinline__ void p4_ml(const P& p, LAS unsigned char* lds, int b, int h, int tc) {
    const int tid = threadIdx.x, lane = tid & 63, wave = __builtin_amdgcn_readfirstlane(tid >> 6);
    const bf16_t* Z = (const bf16_t*)(p.ws + WS_Z); const bf16_t* MK = (const bf16_t*)(p.ws + WS_MK);
    const int tok0 = chunk_tok0(b, tc), sidx = (b * 4 + h) * NCH + tc;
    LAS bf16_t* VT = (LAS bf16_t*)lds; LAS bf16_t* KT = (LAS bf16_t*)(lds + 18432);
    LAS float* IG = (LAS float*)(lds + 55296); LAS float* LF = IG + 128; LAS float* KW = IG + 256;
    load_vt(Z, tok0, 2560 + h * 128, VT, tid);
    load_ml_gates(p, tok0, h, IG, LF, tid);
    __syncthreads();
    if (tid == 0 || tid == 64) { const int dir = tid >> 6; float tot = 0.f;
        for (int t = 0; t < 64; ++t) tot += LF[dir * 64 + t];
        float run = 0.f, ml = -3.0e38f;
        for (int t = 0; t < 64; ++t) { const float lf = LF[dir * 64 + t]; float g;
            if (dir == 0) { run += lf; g = tot - run + IG[t]; } else { g = run + IG[64 + t]; run += lf; }
            KW[dir * 64 + t] = g; ml = fmaxf(ml, g); }
        for (int t = 0; t < 64; ++t) KW[dir * 64 + t] = __expf(KW[dir * 64 + t] - ml);
        float* sc = (float*)(p.ws + WS_MSC) + (size_t)(sidx * 2 + dir) * 4; sc[0] = tot; sc[1] = ml; }
    __syncthreads();
    { const int dir = tid >> 8, th = (tid >> 7) & 1, d = tid & 127;
#pragma unroll 8
        for (int i = 0; i < 32; ++i) { const int t = th * 32 + i; const float kx = bf2f(MK[(size_t)(tok0 + t) * 512 + h * 128 + d]);
            KT[(dir * 128 + d) * 72 + t] = (bf16_t)f2bf(kx * KW[dir * 64 + t]); } }
    __syncthreads();
    if (tid < 256) { const int dir = tid >> 7, d = tid & 127; float s = 0.f;
        for (int t = 0; t < 64; ++t) s += bf2f(KT[(dir * 128 + d) * 72 + t]);
        ((float*)(p.ws + WS_MN))[(size_t)(sidx * 2 + dir) * 128 + d] = s; }
    const int dw = wave >> 2, vt = wave & 3;
    f32x16 acc[4];
#pragma unroll
    for (int q = 0; q < 4; ++q)
#pragma unroll
        for (int r = 0; r < 16; ++r) acc[q][r] = 0.f;
#pragma unroll
    for (int ks = 0; ks < 4; ++ks) { const bf16x8 a = ldfrag(VT, 72, vt * 32, ks * 16, lane);
#pragma unroll
        for (int q = 0; q < 4; ++q) { const bf16x8 bq = ldfrag(KT + dw * 128 * 72, 72, q * 32, ks * 16, lane); acc[q] = MFMA32(a, bq, acc[q]); } }
    bf16_t* U = (bf16_t*)(p.ws + WS_UM) + (size_t)(sidx * 2 + dw) * 16384;
#pragma unroll
    for (int q = 0; q < 4; ++q)
#pragma unroll
        for (int r = 0; r < 16; ++r) { const int v = vt * 32 + crow(r, lane); U[v * 128 + q * 32 + (lane & 31)] = (bf16_t)f2bf(acc[q][r]); }
    __syncthreads();
}

__device__ __forceinline__ void phase4(const P& p, LAS unsigned char* lds) {
    for (int it = blockIdx.x; it < 2 * NSTATE; it += gridDim.x) {
        const int ty = it / NSTATE, r = it % NSTATE, b = r / (4 * NCH), h = (r / NCH) & 3, tc = r % NCH;
        if (ty == 0) p4_gla(p, lds, b, h, tc); else p4_ml(p, lds, b, h, tc);
    }
}

__device__ __forceinline__ int tc_of(int c, int dir) { return dir == 0 ? (c < 4 ? 64 + c : c - 4) : (c < 4 ? 67 - c : 67 - c); }

__device__ __forceinline__ void phase5(const P& p) {
    const int gtid = blockIdx.x * NTHR + threadIdx.x, nthr = gridDim.x * NTHR;
    for (int task = gtid; task < 32768 + 65536 + 512; task += nthr) {
        if (task < 32768) {
            const int chain = task >> 10, e8 = task & 1023, bh = chain >> 1, dir = chain & 1, d0 = (e8 & 7) * 8;
            bf16_t* UG = (bf16_t*)(p.ws + WS_UG); const float* GD = (const float*)(p.ws + WS_GDEC);
            float s[8];
#pragma unroll
            for (int j = 0; j < 8; ++j) s[j] = 0.f;
            u32x4 ub[4]; f32x4 da[4], db[4];
#pragma unroll
            for (int i = 0; i < 4; ++i) { const int si = (bh * NCH + tc_of(i, dir)) * 2 + dir;
                ub[i] = *(const u32x4*)(UG + (size_t)si * 8192 + e8 * 8); da[i] = *(const f32x4*)(GD + si * 64 + d0); db[i] = *(const f32x4*)(GD + si * 64 + d0 + 4); }
            for (int c0 = 0; c0 < NCH; c0 += 4) {
#pragma unroll
                for (int i = 0; i < 4; ++i) { const int c = c0 + i; const int si = (bh * NCH + tc_of(c, dir)) * 2 + dir;
                    const u32x4 u = ub[i]; const f32x4 a = da[i], bq = db[i];
                    if (c + 4 < NCH) { const int sn = (bh * NCH + tc_of(c + 4, dir)) * 2 + dir;
                        ub[i] = *(const u32x4*)(UG + (size_t)sn * 8192 + e8 * 8); da[i] = *(const f32x4*)(GD + sn * 64 + d0); db[i] = *(const f32x4*)(GD + sn * 64 + d0 + 4); }
                    u32x4 o; o.x = pk2(s[0], s[1]); o.y = pk2(s[2], s[3]); o.z = pk2(s[4], s[5]); o.w = pk2(s[6], s[7]);
                    *(u32x4*)(UG + (size_t)si * 8192 + e8 * 8) = o;
                    s[0] = a.x * s[0] + bflo(u.x); s[1] = a.y * s[1] + bfhi(u.x); s[2] = a.z * s[2] + bflo(u.y); s[3] = a.w * s[3] + bfhi(u.y);
                    s[4] = bq.x * s[4] + bflo(u.z); s[5] = bq.y * s[5] + bfhi(u.z); s[6] = bq.z * s[6] + bflo(u.w); s[7] = bq.w * s[7] + bfhi(u.w); }
            }
        } else if (task < 98304) {
            const int tk = task - 32768, chain = tk >> 11, e8 = tk & 2047, bh = chain >> 1, dir = chain & 1;
            bf16_t* UM = (bf16_t*)(p.ws + WS_UM); float* SC = (float*)(p.ws + WS_MSC);
            float s[8];
#pragma unroll
            for (int j = 0; j < 8; ++j) s[j] = 0.f;
            float m = 0.f;
            u32x4 ub[4]; float ae[4], ml[4];
#pragma unroll
            for (int i = 0; i < 4; ++i) { const int si = (bh * NCH + tc_of(i, dir)) * 2 + dir;
                ub[i] = *(const u32x4*)(UM + (size_t)si * 16384 + e8 * 8); ae[i] = SC[si * 4 + 0]; ml[i] = SC[si * 4 + 1]; }
            for (int c0 = 0; c0 < NCH; c0 += 4) {
#pragma unroll
                for (int i = 0; i < 4; ++i) { const int c = c0 + i; const int si = (bh * NCH + tc_of(c, dir)) * 2 + dir;
                    const u32x4 u = ub[i]; const float aend = ae[i], mloc = ml[i];
                    if (c + 4 < NCH) { const int sn = (bh * NCH + tc_of(c + 4, dir)) * 2 + dir;
                        ub[i] = *(const u32x4*)(UM + (size_t)sn * 16384 + e8 * 8); ae[i] = SC[sn * 4 + 0]; ml[i] = SC[sn * 4 + 1]; }
                    u32x4 o; o.x = pk2(s[0], s[1]); o.y = pk2(s[2], s[3]); o.z = pk2(s[4], s[5]); o.w = pk2(s[6], s[7]);
                    *(u32x4*)(UM + (size_t)si * 16384 + e8 * 8) = o;
                    if (e8 == 0) SC[si * 4 + 2] = m;
                    const float mn = fmaxf(aend + m, mloc), f1 = __expf(aend + m - mn), f2 = __expf(mloc - mn); m = mn;
                    s[0] = f1 * s[0] + f2 * bflo(u.x); s[1] = f1 * s[1] + f2 * bfhi(u.x); s[2] = f1 * s[2] + f2 * bflo(u.y); s[3] = f1 * s[3] + f2 * bfhi(u.y);
                    s[4] = f1 * s[4] + f2 * bflo(u.z); s[5] = f1 * s[5] + f2 * bfhi(u.z); s[6] = f1 * s[6] + f2 * bflo(u.w); s[7] = f1 * s[7] + f2 * bfhi(u.w); }
            }
        } else {
            const int tk = task - 98304, chain = tk >> 4, part = tk & 15, bh = chain >> 1, dir = chain & 1;
            float* MN = (float*)(p.ws + WS_MN); const float* SC = (const float*)(p.ws + WS_MSC);
            f32x4 n0 = {0.f, 0.f, 0.f, 0.f}, n1 = {0.f, 0.f, 0.f, 0.f}; float m = 0.f;
            for (int c = 0; c < NCH; ++c) { const int si = (bh * NCH + tc_of(c, dir)) * 2 + dir;
                float* np = MN + (size_t)si * 128 + part * 8;
                const f32x4 u0 = *(const f32x4*)np, u1 = *(const f32x4*)(np + 4); const float aend = SC[si * 4 + 0], mloc = SC[si * 4 + 1];
                *(f32x4*)np = n0; *(f32x4*)(np + 4) = n1;
                const float mn = fmaxf(aend + m, mloc), f1 = __expf(aend + m - mn), f2 = __expf(mloc - mn); m = mn;
                n0 = n0 * f1 + u0 * f2; n1 = n1 * f1 + u1 * f2; }
        }
    }
}

template <bool SIG>
__device__ __forceinline__ void head_norm_store(const P& p, const LAS float* O, int tok0, int h, int zgate_col, const float* gain, int mixcol, int tid) {
    const bf16_t* Z = (const bf16_t*)(p.ws + WS_Z); bf16_t* MIX = (bf16_t*)(p.ws + WS_A);
    const int t = tid >> 3, seg = tid & 7;
    float o[16]; float ss = 0.f;
#pragma unroll
    for (int j = 0; j < 16; ++j) { o[j] = O[t * 132 + seg * 16 + j]; ss += o[j] * o[j]; }
    ss += __shfl_xor(ss, 1); ss += __shfl_xor(ss, 2); ss += __shfl_xor(ss, 4);
    const float rstd = 1.f / sqrtf(ss * (1.f / 128.f) + EPS);
    const u32x4 g0 = *(const u32x4*)(Z + (size_t)(tok0 + t) * ZLD + zgate_col + h * 128 + seg * 16), g1 = *(const u32x4*)(Z + (size_t)(tok0 + t) * ZLD + zgate_col + h * 128 + seg * 16 + 8);
    float gt[16];
    gt[0] = bflo(g0.x); gt[1] = bfhi(g0.x); gt[2] = bflo(g0.y); gt[3] = bfhi(g0.y); gt[4] = bflo(g0.z); gt[5] = bfhi(g0.z); gt[6] = bflo(g0.w); gt[7] = bfhi(g0.w);
    gt[8] = bflo(g1.x); gt[9] = bfhi(g1.x); gt[10] = bflo(g1.y); gt[11] = bfhi(g1.y); gt[12] = bflo(g1.z); gt[13] = bfhi(g1.z); gt[14] = bflo(g1.w); gt[15] = bfhi(g1.w);
    float r[16];
#pragma unroll
    for (int j = 0; j < 16; ++j) { const float gg = SIG ? sigmf(gt[j]) : siluf(gt[j]); r[j] = o[j] * rstd * gain[h * 128 + seg * 16 + j] * gg; }
    u32x4 w0, w1; w0.x = pk2(r[0], r[1]); w0.y = pk2(r[2], r[3]); w0.z = pk2(r[4], r[5]); w0.w = pk2(r[6], r[7]);
    w1.x = pk2(r[8], r[9]); w1.y = pk2(r[10], r[11]); w1.z = pk2(r[12], r[13]); w1.w = pk2(r[14], r[15]);
    bf16_t* dst = MIX + (size_t)(tok0 + t) * D + mixcol + h * 128 + seg * 16;
    *(u32x4*)dst = w0; *(u32x4*)(dst + 8) = w1;
}

__device__ __forceinline__ void p6_gla(const P& p, LAS unsigned char* lds, int b, int h, int j) {
    const int tid = threadIdx.x, lane = tid & 63, wave = __builtin_amdgcn_readfirstlane(tid >> 6);
    const bf16_t* Z = (const bf16_t*)(p.ws + WS_Z); const float* GT = (const float*)(p.ws + WS_GATES);
    const int tok0 = b * SEQ + j * 64, sidx = (b * 4 + h) * NCH + j;
    LAS bf16_t* QF = (LAS bf16_t*)lds; LAS bf16_t* QB = QF + 64 * 72; LAS bf16_t* KF = QB + 64 * 72; LAS bf16_t* KB = KF + 64 * 72;
    LAS bf16_t* VT = (LAS bf16_t*)(lds + 36864); LAS bf16_t* ST = (LAS bf16_t*)(lds + 55296); LAS bf16_t* PF = (LAS bf16_t*)(lds + 92160); LAS bf16_t* PB = PF + 64 * 72;
    LAS float* GLR = (LAS float*)(lds + 110592); LAS float* QS = (LAS float*)(lds + 118784); LAS float* O = (LAS float*)lds;
    load_vt(Z, tok0, 512 + h * 128, VT, tid);
    { const bf16_t* S = (const bf16_t*)(p.ws + WS_UG) + (size_t)(sidx * 2) * 8192;
#pragma unroll
        for (int i = 0; i < 4; ++i) { const int idx = tid + NTHR * i, row = idx >> 3, c = idx & 7;
            *(LAS u32x4*)(ST + row * 72 + c * 8) = *(const u32x4*)(S + (size_t)row * 64 + c * 8); } }
    { const int t = tid >> 3, c4 = tid & 7; *(LAS f32x4*)(GLR + t * 32 + c4 * 4) = *(const f32x4*)(GT + (size_t)(tok0 + t) * 48 + c4 * 4); }
    __syncthreads();
    const int dir = tid >> 8, tq = (tid >> 6) & 3, d = tid & 63;
    {
        float upw[16];
#pragma unroll
        for (int r = 0; r < 16; ++r) upw[r] = p.in[8][(dir * 16 + r) * 256 + h * 64 + d];
        const float upb = p.in[9][dir * 256 + h * 64 + d];
        float la[16]; float tot = 0.f;
#pragma unroll
        for (int i = 0; i < 16; ++i) { const int t = tq * 16 + i; float lg = upb;
#pragma unroll
            for (int r = 0; r < 16; ++r) lg += GLR[t * 32 + dir * 16 + r] * upw[r];
            la[i] = logsigf(lg) * 0.0625f; tot += la[i]; }
        QS[(dir * 4 + tq) * 64 + d] = tot;
        __syncthreads();
        float before = 0.f, all = 0.f;
#pragma unroll
        for (int q = 0; q < 4; ++q) { const float v = QS[(dir * 4 + q) * 64 + d]; all += v; before += (q < tq) ? v : 0.f; }
        float run = before;
        LAS bf16_t* Qd = dir == 0 ? QF : QB; LAS bf16_t* Kd = dir == 0 ? KF : KB;
#pragma unroll
        for (int i = 0; i < 16; ++i) { const int t = tq * 16 + i;
            const float qx = bf2f(Z[(size_t)(tok0 + t) * ZLD + h * 64 + d]) * 0.125f, kx = bf2f(Z[(size_t)(tok0 + t) * ZLD + 256 + h * 64 + d]);
            float bb; if (dir == 0) { run += la[i]; bb = run; } else { bb = all - run; run += la[i]; }
            const float eb = __expf(bb);
            Qd[t * 72 + d] = (bf16_t)f2bf(qx * eb); Kd[t * 72 + d] = (bf16_t)f2bf(kx / eb); }
    }
    __syncthreads();
    {
        const int dw = wave >> 2, tt = (wave >> 1) & 1, st = wave & 1;
        const LAS bf16_t* Qd = dw == 0 ? QF : QB; const LAS bf16_t* Kd = dw == 0 ? KF : KB; LAS bf16_t* Pd = dw == 0 ? PF : PB;
        f32x16 acc;
#pragma unroll
        for (int r = 0; r < 16; ++r) acc[r] = 0.f;
#pragma unroll
        for (int ks = 0; ks < 4; ++ks) acc = MFMA32(ldfrag(Qd, 72, tt * 32, ks * 16, lane), ldfrag(Kd, 72, st * 32, ks * 16, lane), acc);
        const int s = st * 32 + (lane & 31);
#pragma unroll
        for (int r = 0; r < 16; ++r) { const int t = tt * 32 + crow(r, lane); const bool ok = dw == 0 ? (s <= t) : (s >= t);
            Pd[t * 72 + s] = (bf16_t)f2bf(ok ? acc[r] : 0.f); }
    }
    __syncthreads();
    const int tt = wave >> 2, vt = wave & 3;
    f32x16 acc;
#pragma unroll
    for (int r = 0; r < 16; ++r) acc[r] = 0.f;
#pragma unroll
    for (int ks = 0; ks < 4; ++ks) { const bf16x8 vb = ldfrag(VT, 72, vt * 32, ks * 16, lane);
        acc = MFMA32(ldfrag(PF, 72, tt * 32, ks * 16, lane), vb, acc); acc = MFMA32(ldfrag(PB, 72, tt * 32, ks * 16, lane), vb, acc); }
#pragma unroll
    for (int ks = 0; ks < 4; ++ks) { acc = MFMA32(ldfrag(QF, 72, tt * 32, ks * 16, lane), ldfrag(ST, 72, vt * 32, ks * 16, lane), acc);
        acc = MFMA32(ldfrag(QB, 72, tt * 32, ks * 16, lane), ldfrag(ST + 128 * 72, 72, vt * 32, ks * 16, lane), acc); }
    __syncthreads();
#pragma unroll
    for (int r = 0; r < 16; ++r) O[(tt * 32 + crow(r, lane)) * 132 + vt * 32 + (lane & 31)] = acc[r];
    __syncthreads();
    head_norm_store<false>(p, O, tok0, h, 1024, p.in[10], 0, tid);
    __syncthreads();
}

__device__ __forceinline__ void p6_ml(const P& p, LAS unsigned char* lds, int b, int h, int j) {
    const int tid = threadIdx.x, lane = tid & 63, wave = __builtin_amdgcn_readfirstlane(tid >> 6);
    const bf16_t* Z = (const bf16_t*)(p.ws + WS_Z); const bf16_t* MQ = (const bf16_t*)(p.ws + WS_MQ); const bf16_t* MK = (const bf16_t*)(p.ws + WS_MK);
    const int tok0 = b * SEQ + j * 64, sidx = (b * 4 + h) * NCH + j;
    LAS bf16_t* Q = (LAS bf16_t*)lds; LAS bf16_t* K = (LAS bf16_t*)(lds + 17408); LAS bf16_t* VT = (LAS bf16_t*)(lds + 34816); LAS bf16_t* ST = (LAS bf16_t*)(lds + 53248);
    LAS bf16_t* PF = (LAS bf16_t*)(lds + 122880); LAS bf16_t* PB = PF + 64 * 72; LAS float* SM = (LAS float*)(lds + 141312); LAS float* O = (LAS float*)lds;
    LAS float* IG = SM; LAS float* LF = SM + 128; LAS float* CT = SM + 256; LAS float* RT = SM + 384; LAS float* WT = SM + 512; LAS float* ET = SM + 640;
    LAS float* NV = SM + 768;
    LAS float* INV = SM + 1024;
    LAS float* MS = SM + 1152;
#pragma unroll
    for (int i = 0; i < 2; ++i) { const int idx = tid + NTHR * i, t = idx >> 4, c = idx & 15;
        *(LAS u32x4*)(Q + t * 136 + c * 8) = *(const u32x4*)(MQ + (size_t)(tok0 + t) * 512 + h * 128 + c * 8);
        *(LAS u32x4*)(K + t * 136 + c * 8) = *(const u32x4*)(MK + (size_t)(tok0 + t) * 512 + h * 128 + c * 8); }
    load_vt(Z, tok0, 2560 + h * 128, VT, tid);
    { const bf16_t* S = (const bf16_t*)(p.ws + WS_UM) + (size_t)(sidx * 2) * 16384;
#pragma unroll
        for (int i = 0; i < 8; ++i) { const int idx = tid + NTHR * i, row = idx >> 4, c = idx & 15;
            *(LAS u32x4*)(ST + row * 136 + c * 8) = *(const u32x4*)(S + (size_t)row * 128 + c * 8); } }
    load_ml_gates(p, tok0, h, IG, LF, tid);
    if (tid >= 128 && tid < 384) { const int q = tid - 128; NV[q] = ((const float*)(p.ws + WS_MN))[(size_t)(sidx * 2) * 128 + q]; }
    if (tid >= 384 && tid < 386) { const int dir = tid - 384; MS[dir] = ((const float*)(p.ws + WS_MSC))[(size_t)(sidx * 2 + dir) * 4 + 2]; }
    __syncthreads();
    if (tid == 0) {
        const float ms = MS[0]; float a = 0.f, pm = -3.0e38f;
        for (int t = 0; t < 64; ++t) { a += LF[t]; const float c = IG[t] - a; pm = fmaxf(pm, c); const float mt = a + fmaxf(ms, pm);
            CT[t] = c; RT[t] = a - mt; WT[t] = __expf(a + ms - mt); ET[t] = __expf(-mt); }
    } else if (tid == 64) {
        const float ms = MS[1]; float a = 0.f, pm = -3.0e38f;
        for (int t = 63; t >= 0; --t) { a += LF[64 + t]; const float c = IG[64 + t] - a; pm = fmaxf(pm, c); const float mt = a + fmaxf(ms, pm);
            CT[64 + t] = c; RT[64 + t] = a - mt; WT[64 + t] = __expf(a + ms - mt); ET[64 + t] = __expf(-mt); }
    }
    __syncthreads();
    {
        const int dw = wave >> 2, tt = (wave >> 1) & 1, st = wave & 1; LAS bf16_t* Pd = dw == 0 ? PF : PB;
        f32x16 acc;
#pragma unroll
        for (int r = 0; r < 16; ++r) acc[r] = 0.f;
#pragma unroll
        for (int ks = 0; ks < 8; ++ks) acc = MFMA32(ldfrag(Q, 136, tt * 32, ks * 16, lane), ldfrag(K, 136, st * 32, ks * 16, lane), acc);
        const int s = st * 32 + (lane & 31); const float cs = CT[dw * 64 + s];
#pragma unroll
        for (int r = 0; r < 16; ++r) { const int t = tt * 32 + crow(r, lane); const bool ok = dw == 0 ? (s <= t) : (s >= t);
            const float wgt = __expf(fminf(RT[dw * 64 + t] + cs, 0.f));
            Pd[t * 72 + s] = (bf16_t)f2bf(ok ? acc[r] * wgt : 0.f); }
    }
    __syncthreads();
    {
        const int t = tid >> 3, seg = tid & 7;
        float rs0 = 0.f, rs1 = 0.f, qn0 = 0.f, qn1 = 0.f;
#pragma unroll
        for (int i = 0; i < 8; ++i) { rs0 += bf2f(PF[t * 72 + seg * 8 + i]); rs1 += bf2f(PB[t * 72 + seg * 8 + i]); }
#pragma unroll
        for (int i = 0; i < 16; ++i) { const float qv = bf2f(Q[t * 136 + seg * 16 + i]); qn0 += qv * NV[seg * 16 + i]; qn1 += qv * NV[128 + seg * 16 + i]; }
#pragma unroll
        for (int o = 1; o < 8; o <<= 1) { rs0 += __shfl_xor(rs0, o); rs1 += __shfl_xor(rs1, o); qn0 += __shfl_xor(qn0, o); qn1 += __shfl_xor(qn1, o); }
        if (seg == 0) { const float d0 = rs0 + WT[t] * qn0, d1 = rs1 + WT[64 + t] * qn1;
            INV[t] = 1.f / fmaxf(fabsf(d0), ET[t]); INV[64 + t] = 1.f / fmaxf(fabsf(d1), ET[64 + t]); }
    }
    const int tt = wave >> 2, vt = wave & 3;
    f32x16 apf, apb, aqf, aqb;
#pragma unroll
    for (int r = 0; r < 16; ++r) { apf[r] = 0.f; apb[r] = 0.f; aqf[r] = 0.f; aqb[r] = 0.f; }
#pragma unroll
    for (int ks = 0; ks < 4; ++ks) { const bf16x8 vb = ldfrag(VT, 72, vt * 32, ks * 16, lane);
        apf = MFMA32(ldfrag(PF, 72, tt * 32, ks * 16, lane), vb, apf); apb = MFMA32(ldfrag(PB, 72, tt * 32, ks * 16, lane), vb, apb); }
#pragma unroll
    for (int ks = 0; ks < 8; ++ks) { const bf16x8 qa = ldfrag(Q, 136, tt * 32, ks * 16, lane);
        aqf = MFMA32(qa, ldfrag(ST, 136, vt * 32, ks * 16, lane), aqf); aqb = MFMA32(qa, ldfrag(ST + 128 * 136, 136, vt * 32, ks * 16, lane), aqb); }
    __syncthreads();
#pragma unroll
    for (int r = 0; r < 16; ++r) { const int t = tt * 32 + crow(r, lane);
        const float hv = INV[t] * (apf[r] + WT[t] * aqf[r]) + INV[64 + t] * (apb[r] + WT[64 + t] * aqb[r]);
        O[t * 132 + vt * 32 + (lane & 31)] = hv; }
    __syncthreads();
    head_norm_store<true>(p, O, tok0, h, 3072, p.in[15], 512, tid);
    __syncthreads();
}

__device__ __forceinline__ void phase6(const P& p, LAS unsigned char* lds) {
    for (int it = blockIdx.x; it < 2048; it += gridDim.x) {
        const int ty = it >> 10, r = it & 1023, b = r >> 8, h = (r >> 6) & 3, j = r & 63;
        if (ty == 0) p6_gla(p, lds, b, h, j); else p6_ml(p, lds, b, h, j);
    }
}

__device__ __forceinline__ void phase8(const P& p, LAS unsigned char* lds) {
    const int tid = threadIdx.x, lane = tid & 63, wave = tid >> 6;
    LAS float* RW = (LAS float*)lds;
    for (int i = tid; i < 36 * 1024; i += NTHR) { const int j = i >> 10, k = i & 1023; RW[i] = j < 4 ? p.in[18][k * 4 + j] : p.in[20][k * 32 + (j - 4)]; }
    __syncthreads();
    const float* mod = (const float*)(p.ws + WS_MOD); bf16_t* H2 = (bf16_t*)(p.ws + WS_MQ);
    int* RT = (int*)(p.ws + WS_ROUTE); unsigned* CNT = (unsigned*)(p.ws + WS_CTL) + CW_CNT;
    const int gw = blockIdx.x * 8 + wave, NGW = gridDim.x * 8;
    for (int row = gw; row < MX; row += NGW) {
        const float* src = p.out + (size_t)row * D; const float* mv = mod + (size_t)(row >> 12) * 6144;
        f32x4 v[4]; float ss = 0.f;
#pragma unroll
        for (int j = 0; j < 4; ++j) { v[j] = *(const f32x4*)(src + 4 * lane + 256 * j); ss += v[j].x * v[j].x + v[j].y * v[j].y + v[j].z * v[j].z + v[j].w * v[j].w; }
        const float rstd = 1.f / sqrtf(wave_sum(ss) * (1.f / D) + EPS);
#pragma unroll
        for (int j = 0; j < 4; ++j) { const int k = 4 * lane + 256 * j;
            const f32x4 g = *(const f32x4*)(p.in[17] + k), sh = *(const f32x4*)(mv + 3072 + k), sc = *(const f32x4*)(mv + 4096 + k);
            v[j] = (v[j] * rstd * g) * (sc + 1.f) + sh;
            u32x2 w; w.x = pk2(v[j].x, v[j].y); w.y = pk2(v[j].z, v[j].w);
            *(u32x2*)(H2 + (size_t)row * D + k) = w; }
        LAS float* LG = (LAS float*)(lds + 147456) + wave * 64;
#pragma unroll 2
        for (int q = 0; q < 36; ++q) { float s = 0.f;
#pragma unroll
            for (int j = 0; j < 4; ++j) { const f32x4 w = *(const LAS f32x4*)(RW + q * 1024 + 4 * lane + 256 * j); s += v[j].x * w.x + v[j].y * w.y + v[j].z * w.z + v[j].w * w.w; }
            s = wave_sum(s);
            if (lane == 0) LG[q] = s; }
        asm volatile("s_waitcnt lgkmcnt(0)" ::: "memory");
        float gl[4];
#pragma unroll
        for (int q = 0; q < 4; ++q) gl[q] = LG[q] + p.in[19][q];
        int gi = 0; float gm = gl[0];
#pragma unroll
        for (int q = 1; q < 4; ++q) if (gl[q] > gm) { gm = gl[q]; gi = q; }
        float den = 0.f;
#pragma unroll
        for (int q = 0; q < 4; ++q) den += __expf(gl[q] - gm);
        const float gwt = 1.f / den;
        float el[8];
#pragma unroll
        for (int q = 0; q < 8; ++q) el[q] = LG[4 + gi * 8 + q] + p.in[21][gi * 8 + q];
        int i0 = 0; float v0 = el[0];
#pragma unroll
        for (int q = 1; q < 8; ++q) if (el[q] > v0) { v0 = el[q]; i0 = q; }
        int i1 = -1; float v1 = -3.0e38f;
#pragma unroll
        for (int q = 0; q < 8; ++q) if (q != i0 && el[q] > v1) { v1 = el[q]; i1 = q; }
        const float e1 = __expf(v1 - v0), w0 = gwt / (1.f + e1), w1 = gwt * e1 / (1.f + e1);
        if (lane == 0) { const int ea = gi * 8 + i0, eb = gi * 8 + i1;
            const int ra = (int)atomicAdd(&CNT[ea], 1u), rb = (int)atomicAdd(&CNT[eb], 1u);
            int* r = RT + (size_t)row * 8; r[0] = ea; r[1] = eb; r[2] = ra; r[3] = rb; ((float*)r)[4] = w0; ((float*)r)[5] = w1; }
    }
}

__device__ __forceinline__ int build_tables(const P& p, LAS int* PST, LAS int* TEX) {
    const unsigned* CNT = (const unsigned*)(p.ws + WS_CTL) + CW_CNT;
    if (threadIdx.x == 0) { int acc = 0;
        for (int e = 0; e < 32; ++e) { PST[e] = acc; const int c = (int)__hip_atomic_load(&CNT[e], __ATOMIC_RELAXED, __HIP_MEMORY_SCOPE_AGENT); const int nt = (c + 255) >> 8;
            for (int t = 0; t < nt; ++t) TEX[(acc >> 8) + t] = e;
            acc += nt << 8; }
        PST[32] = acc; }
    __syncthreads();
    return PST[32] >> 8;
}

__device__ __forceinline__ void phase9(const P& p, LAS unsigned char* lds) {
    LAS int* PST = (LAS int*)lds; LAS int* TEX = PST + 64;
    (void)build_tables(p, PST, TEX);
    const int tid = threadIdx.x, lane = tid & 63, wave = tid >> 6;
    const bf16_t* H2 = (const bf16_t*)(p.ws + WS_MQ); bf16_t* XS = (bf16_t*)(p.ws + WS_Z); int* RT = (int*)(p.ws + WS_ROUTE);
    const int gw = blockIdx.x * 8 + wave, NGW = gridDim.x * 8;
    for (int row = gw; row < MX; row += NGW) {
        int* r = RT + (size_t)row * 8;
        const int s0 = PST[r[0]] + r[2], s1 = PST[r[1]] + r[3];
        const u32x4 a = *(const u32x4*)(H2 + (size_t)row * D + lane * 8), bq = *(const u32x4*)(H2 + (size_t)row * D + 512 + lane * 8);
        *(u32x4*)(XS + (size_t)s0 * D + lane * 8) = a; *(u32x4*)(XS + (size_t)s0 * D + 512 + lane * 8) = bq;
        *(u32x4*)(XS + (size_t)s1 * D + lane * 8) = a; *(u32x4*)(XS + (size_t)s1 * D + 512 + lane * 8) = bq;
        if (lane == 0) { r[6] = s0; r[7] = s1; }
    }
}

__device__ __forceinline__ void phase12(const P& p) {
    const int tid = threadIdx.x, lane = tid & 63, wave = tid >> 6;
    const float* mod = (const float*)(p.ws + WS_MOD); const bf16_t* Y = (const bf16_t*)(p.ws + WS_Z); const int* RT = (const int*)(p.ws + WS_ROUTE);
    const int gw = blockIdx.x * 8 + wave, NGW = gridDim.x * 8;
    for (int row = gw; row < MX; row += NGW) {
        const int* r = RT + (size_t)row * 8; const int s0 = r[6], s1 = r[7]; const float w0 = ((const float*)r)[4], w1 = ((const float*)r)[5];
        float* xr = p.out + (size_t)row * D; const float* g2 = mod + (size_t)(row >> 12) * 6144 + 5120;
        f32x4 v[4]; float ss = 0.f;
#pragma unroll
        for (int j = 0; j < 4; ++j) { const int k = 4 * lane + 256 * j;
            const f32x4 x1 = *(const f32x4*)(xr + k), g = *(const f32x4*)(g2 + k);
            const u32x2 ya = *(const u32x2*)(Y + (size_t)s0 * D + k), yb = *(const u32x2*)(Y + (size_t)s1 * D + k);
            f32x4 m; m.x = w0 * bflo(ya.x) + w1 * bflo(yb.x); m.y = w0 * bfhi(ya.x) + w1 * bfhi(yb.x); m.z = w0 * bflo(ya.y) + w1 * bflo(yb.y); m.w = w0 * bfhi(ya.y) + w1 * bfhi(yb.y);
            v[j] = x1 + g * m; ss += v[j].x * v[j].x + v[j].y * v[j].y + v[j].z * v[j].z + v[j].w * v[j].w; }
        const float rstd = 1.f / sqrtf(wave_sum(ss) * (1.f / D) + EPS);
#pragma unroll
        for (int j = 0; j < 4; ++j) { const int k = 4 * lane + 256 * j; const f32x4 g = *(const f32x4*)(p.in[24] + k); *(f32x4*)(xr + k) = v[j] * rstd * g; }
    }
}

constexpr int NPH = 13;
__global__ void __launch_bounds__(NTHR, 2) mega(P p) {
    extern __shared__ __attribute__((aligned(16))) unsigned char lds_raw[];
    LAS unsigned char* lds = (LAS unsigned char*)lds_raw;
    cg::grid_group grid = cg::this_grid();
    const int lo = p.ph_lo, hi = p.ph_hi;
    const int G = gridDim.x, bx = blockIdx.x;
    const int vcu = (G % 8 == 0) ? (bx % 8) * (G / 8) + bx / 8 : bx;
#ifndef PHASE_MASK
#define PHASE_MASK 0x1fff
#endif
#define IN(k) (((PHASE_MASK >> (k)) & 1) && lo <= (k) && (k) < hi)
#define SEAM(k) do { if ((k) + 1 < hi) grid.sync(); } while (0)
    if (IN(0)) { phase0(p, lds); SEAM(0); }
    if (IN(1)) { phase1(p); SEAM(1); }
    if (IN(2)) {
        pg8::SchedDense S; S.nM = MT / 256; S.nN = NPADW / 256; S.nwg = S.nM * S.nN; S.G = G; S.c = bx; S.K = 1024; S.A = (const char*)(p.ws + WS_A); S.Bt = (const char*)(p.ws + WS_WINT);
        EpiZ E; E.Z = (bf16_t*)(p.ws + WS_Z); E.G = (float*)(p.ws + WS_GATES);
        pg8::gemm_phase(lds, 1024, S, E); SEAM(2); }
    if (IN(3)) { phase3(p); SEAM(3); }
    if (IN(4)) { phase4(p, lds); SEAM(4); }
    if (IN(5)) { phase5(p); SEAM(5); }
    if (IN(6)) { phase6(p, lds); SEAM(6); }
    if (IN(7)) {
        pg8::SchedDense S; S.nM = MX / 256; S.nN = 4; S.nwg = S.nM * S.nN; S.G = G; S.c = bx; S.K = 1024; S.A = (const char*)(p.ws + WS_A); S.Bt = (const char*)(p.ws + WS_WOUTT);
        EpiX1 E; E.x = p.in[0]; E.mod = (const float*)(p.ws + WS_MOD); E.out = p.out;
        pg8::gemm_phase(lds, 1024, S, E); SEAM(7); }
    if (IN(8)) { phase8(p, lds); SEAM(8); }
    if (IN(9)) { phase9(p, lds); SEAM(9); }
    if (IN(10)) {
        LAS int* PST = (LAS int*)(lds + pg8::STAGE_BYTES); LAS int* TEX = PST + 64;
        const int ntiles = build_tables(p, PST, TEX);
        pg8::SchedMoE S; S.ntiles = ntiles; S.G = G; S.c = vcu; S.K = 1024; S.tex = TEX; S.A = (const char*)(p.ws + WS_Z); S.Bt = (const char*)(p.ws + WS_E1T); S.bstride = (size_t)1024 * 1024 * 2;
        EpiH E; E.H = (bf16_t*)(p.ws + WS_UM);
        pg8::gemm_phase(lds, 1024, S, E); SEAM(10); }
    if (IN(11)) {
        LAS int* PST = (LAS int*)(lds + pg8::STAGE_BYTES); LAS int* TEX = PST + 64;
        const int ntiles = build_tables(p, PST, TEX);
        pg8::SchedMoE S; S.ntiles = ntiles; S.G = G; S.c = vcu; S.K = 512; S.tex = TEX; S.A = (const char*)(p.ws + WS_UM); S.Bt = (const char*)(p.ws + WS_E2T); S.bstride = (size_t)1024 * 512 * 2;
        EpiY E; E.Y = (bf16_t*)(p.ws + WS_Z);
        pg8::gemm_phase(lds, 512, S, E); SEAM(11); }
    if (IN(12)) { phase12(p); }
#undef IN
#undef SEAM
}

extern "C" void kernel_launch(void* const* d_in, const int* in_sizes, int n_in, void* d_out, int out_size, void* d_ws, size_t ws_size, hipStream_t stream) {
    static int grid = 0;
    if (grid == 0) {
        if (n_in != 25 || out_size != MX * D || ws_size < WS_END) { fprintf(stderr, "kernel_launch: unexpected problem (n_in %d out %d ws %zu)\n", n_in, out_size, ws_size); grid = -1; return; }
        int dev = 0, cus = 0, per_cu = 0;
        hipGetDevice(&dev); hipDeviceGetAttribute(&cus, hipDeviceAttributeMultiprocessorCount, dev);
        if (hipFuncSetAttribute((const void*)mega, hipFuncAttributeMaxDynamicSharedMemorySize, LDS_BYTES) != hipSuccess) { fprintf(stderr, "kernel_launch: hipFuncSetAttribute failed\n"); grid = -1; return; }
        if (hipOccupancyMaxActiveBlocksPerMultiprocessor(&per_cu, (const void*)mega, NTHR, LDS_BYTES) != hipSuccess || per_cu < 1) { fprintf(stderr, "kernel_launch: occupancy query says %d\n", per_cu); per_cu = 1; }
        (void)hipGetLastError();
        grid = cus;
    }
    if (grid < 0) return;
    hipMemsetAsync((char*)d_ws + WS_CTL, 0, 1 * MiB, stream);
    P a{};
    for (int i = 0; i < 25; ++i) a.in[i] = (const float*)d_in[i];
    a.out = (float*)d_out; a.ws = (unsigned char*)d_ws;
#if N_LAUNCH_MODE == 1
    a.ph_lo = 0; a.ph_hi = NPH;
    void* args[] = {&a};
    hipError_t e = hipLaunchCooperativeKernel((const void*)mega, dim3(grid), dim3(NTHR), args, LDS_BYTES, stream);
    if (e != hipSuccess) fprintf(stderr, "cooperative launch failed: %s (grid %d)\n", hipGetErrorString(e), grid);
#else
    for (int ph = 0; ph < NPH; ++ph) { a.ph_lo = ph; a.ph_hi = ph + 1; hipLaunchKernelGGL(mega, dim3(grid), dim3(NTHR), LDS_BYTES, stream, a); }
#endif
}
```

```cpp
#include <hip/hip_runtime.h>
#include <hip/hip_cooperative_groups.h>
#include <cstdio>
namespace cg = cooperative_groups;

#ifndef N_LAUNCH_MODE
#define N_LAUNCH_MODE 1
#endif

#ifndef REP_MASK
#define REP_MASK 0
#endif
#ifndef EXTRA_SYNCS
#define EXTRA_SYNCS 0
#endif
#define LAS __attribute__((address_space(3)))
typedef unsigned short bf16_t;
typedef short bf16x8 __attribute__((ext_vector_type(8)));
typedef float f32x4 __attribute__((ext_vector_type(4)));
typedef float f32x16 __attribute__((ext_vector_type(16)));
typedef unsigned u32x2 __attribute__((ext_vector_type(2)));
typedef unsigned u32x4 __attribute__((ext_vector_type(4)));

constexpr int D = 1024, NB = 4, SEQ = 4096, CTXL = 256;
constexpr int MX = NB * SEQ, MC = NB * CTXL, MT = MX + MC;
constexpr int INW = 3632, ZLD = 3584, NPADW = 3840;
constexpr int NCH = 68;
constexpr int NSTATE = NB * 4 * NCH;
constexpr float EPS = 1e-6f;
constexpr int NTHR = 512;
constexpr int LDS_BYTES = 160 * 1024;

constexpr size_t MiB = 1u << 20;
constexpr size_t WS_CTL = 0;
constexpr size_t WS_MOD = 1 * MiB;
constexpr size_t WS_ROUTE = 2 * MiB;
constexpr size_t WS_GDEC = 3 * MiB;
constexpr size_t WS_MN = 4 * MiB;
constexpr size_t WS_MSC = 6 * MiB;
constexpr size_t WS_GATES = 7 * MiB;
constexpr size_t WS_WINT = 11 * MiB;
constexpr size_t WS_WOUTT = 19 * MiB;
constexpr size_t WS_E1T = 21 * MiB;
constexpr size_t WS_E2T = 85 * MiB;
constexpr size_t WS_A = 117 * MiB;
constexpr size_t WS_Z = 151 * MiB;
constexpr size_t WS_MQ = 270 * MiB;
constexpr size_t WS_MK = 287 * MiB;
constexpr size_t WS_UG = 304 * MiB;
constexpr size_t WS_UM = 338 * MiB;
constexpr size_t WS_END = 406 * MiB;
constexpr int CW_CNT = 64;
constexpr int CW_BAR = 4096;
constexpr int LDS_XB = LDS_BYTES - 64;

struct P { const float* in[25]; float* out; unsigned char* ws; int ph_lo, ph_hi; };

__device__ __forceinline__ unsigned f2bf(float f) { unsigned u = __float_as_uint(f); return (u + 0x7fffu + ((u >> 16) & 1u)) >> 16; }
__device__ __forceinline__ unsigned pk2(float lo, float hi) { return f2bf(lo) | (f2bf(hi) << 16); }
__device__ __forceinline__ float bf2f(unsigned b) { return __uint_as_float(b << 16); }
__device__ __forceinline__ float bflo(unsigned w) { return __uint_as_float(w << 16); }
__device__ __forceinline__ float bfhi(unsigned w) { return __uint_as_float(w & 0xffff0000u); }
__device__ __forceinline__ float wave_sum(float v) {
#pragma unroll
    for (int o = 32; o >= 1; o >>= 1) v += __shfl_xor(v, o);
    return v;
}
__device__ __forceinline__ float siluf(float x) { return x / (1.f + __expf(-x)); }
__device__ __forceinline__ float sigmf(float x) { return 1.f / (1.f + __expf(-x)); }
__device__ __forceinline__ float logsigf(float x) { return fminf(x, 0.f) - __logf(1.f + __expf(-fabsf(x))); }

__device__ __forceinline__ bf16x8 ldfrag(const LAS bf16_t* T, int ld, int row0, int k0, int lane) {
    return *(const LAS bf16x8*)(T + (row0 + (lane & 31)) * ld + k0 + 8 * (lane >> 5));
}
#define MFMA32(a, b, c) __builtin_amdgcn_mfma_f32_32x32x16_bf16((a), (b), (c), 0, 0, 0)
__device__ __forceinline__ int crow(int r, int lane) { return (r & 3) + 8 * (r >> 2) + 4 * (lane >> 5); }


#define XB_TMO      128
#define XB_XCNT(j)  (256  + 64 * (j))
#define XB_XSUB(j)  (1280 + 64 * (j))
#define XB_XGEN(j)  (2304 + 64 * (j))
#define XB_TOP      3328
#define XB_TOPGEN   3392
#define XCD_BAR_WORDS 3456
#define XB_SPIN_CAP (1u << 22)
__device__ __forceinline__ unsigned xb_ld(unsigned* p)              { return __hip_atomic_load(p, __ATOMIC_RELAXED, __HIP_MEMORY_SCOPE_AGENT); }
__device__ __forceinline__ unsigned xb_add(unsigned* p, unsigned v) { return __hip_atomic_fetch_add(p, v, __ATOMIC_RELAXED, __HIP_MEMORY_SCOPE_AGENT); }
__device__ __forceinline__ unsigned xb_xcc_id() { return (unsigned)__builtin_amdgcn_s_getreg((3 << 11) | 20) & 0xFu; }
#define XB_SPIN(cond, bar) do { unsigned _sp = 0; while (cond) { __builtin_amdgcn_s_sleep(1); \
    if ((++_sp & 255u) == 0u) { if (xb_ld(&(bar)[XB_TMO])) break; if (_sp > XB_SPIN_CAP) { atomicAdd(&(bar)[XB_TMO], 1u); break; } } } } while (0)
struct XcdBarrier { unsigned* bar; unsigned x; volatile LAS unsigned* st; };
__device__ __forceinline__ XcdBarrier xcd_barrier_post(unsigned* bar, volatile LAS unsigned* st) {
    XcdBarrier b; b.bar = bar; b.x = xb_xcc_id(); b.st = st;
    if (threadIdx.x == 0) (void)xb_add(&bar[XB_XCNT(b.x)], 1u);
    return b;
}
__device__ __forceinline__ void xcd_barrier_complete(unsigned* bar, unsigned x, unsigned& nloc, unsigned& nx) {
    const unsigned G = gridDim.x * gridDim.y * gridDim.z;
    unsigned sum, cnt, mine, sp = 0u;
    for (;;) {
        sum = 0u; cnt = 0u; mine = 0u;
#pragma unroll
        for (unsigned j = 0; j < 16; ++j) { const unsigned c = xb_ld(&bar[XB_XCNT(j)]); sum += c; cnt += (c > 0u) ? 1u : 0u; mine = (j == x) ? c : mine; }
        if (sum == G) break;
        __builtin_amdgcn_s_sleep(1);
        if ((++sp & 255u) == 0u) { if (xb_ld(&bar[XB_TMO])) break; if (sp > XB_SPIN_CAP) { atomicAdd(&bar[XB_TMO], 1u); break; } }
    }
    nloc = mine > 0u ? mine : 1u; nx = cnt > 0u ? cnt : 1u;
}
__device__ __forceinline__ void xcd_barrier(const XcdBarrier& b) {
    asm volatile("s_waitcnt vmcnt(0)" ::: "memory");
    __syncthreads();
    if (threadIdx.x == 0) {
        unsigned* bar = b.bar;
        __builtin_amdgcn_s_waitcnt(0);
        unsigned nloc = b.st[0], nx = b.st[1];
        if (nloc == 0u) { xcd_barrier_complete(bar, b.x, nloc, nx); b.st[0] = nloc; b.st[1] = nx; }
        const unsigned old = xb_add(&bar[XB_XSUB(b.x)], 1u);
        const unsigned gen = old / nloc;
        if (old + 1u == (gen + 1u) * nloc) {
            __builtin_amdgcn_fence(__ATOMIC_RELEASE, "agent");
            asm volatile("s_waitcnt vmcnt(0)" ::: "memory");
            const unsigned og = xb_add(&bar[XB_TOP], 1u);
            const unsigned tg = og / nx;
            if (og + 1u == (tg + 1u) * nx) xb_add(&bar[XB_TOPGEN], 1u);
            else XB_SPIN(xb_ld(&bar[XB_TOPGEN]) == tg, bar);
            __builtin_amdgcn_fence(__ATOMIC_ACQUIRE, "agent");
            xb_add(&bar[XB_XGEN(b.x)], 1u);
            asm volatile("s_waitcnt vmcnt(0)" ::: "memory");
        } else {
            XB_SPIN(xb_ld(&bar[XB_XGEN(b.x)]) == gen, bar);
            __builtin_amdgcn_fence(__ATOMIC_ACQUIRE, "agent");
            asm volatile("s_waitcnt vmcnt(0)" ::: "memory");
        }
    }
    __syncthreads();
}

namespace pg8 {
constexpr int BM = 256, BK = 64, HALF = 128, HTB = HALF * BK * 2, STAGE_BYTES = 8 * HTB;
__device__ __forceinline__ int lds_byte(int r, int c) { const int st = (r >> 4) * 2 + (c >> 5), rr = r & 15, cc = c & 31, ob = rr * 64 + cc * 2; return st * 1024 + (ob ^ (((ob >> 9) & 1) << 5)); }
__device__ __forceinline__ void stage_rc(int b, int& R, int& C) { const int st = b / 1024, sb = b % 1024, swz = sb ^ (((sb >> 9) & 1) << 5); R = (st >> 1) * 16 + swz / 64; C = (st & 1) * 32 + (swz % 64) / 2; }
__device__ __forceinline__ int perm32(int rho) { const int n = rho >> 4, i = rho & 15; return 8 * (i >> 2) + 4 * n + (i & 3); }
struct Unit { int pm, pn; const char* a; const char* b; };

template <class Epi, class Sched>
__device__ __forceinline__ void gemm_phase(LAS unsigned char* lds, const int K, const Sched& S, const Epi& E) {
    const int tid = threadIdx.x, wid = __builtin_amdgcn_readfirstlane(tid >> 6), lane = tid & 63, wr = wid >> 2, wc = wid & 3, fr = lane & 15, fq = lane >> 4;
    const int nt = K / BK;
    unsigned voffA[2], voffB[2];
#pragma unroll
    for (int i = 0; i < 2; ++i) { int R, C; stage_rc(tid * 16 + i * 8192, R, C); const int Rb = Epi::PERM ? ((R & ~31) + perm32(R & 31)) : R;
        voffA[i] = (unsigned)(R * K + C) * 2u; voffB[i] = (unsigned)(Rb * K + C) * 2u; }
    const size_t kstep = (size_t)(BK * 2);
    const size_t hstep = (size_t)HALF * K * 2;
    const unsigned ldsw = (unsigned)wid * 1024u;
    const int aoff = lds_byte(wr * 64 + fr, fq * 8), boff = lds_byte(wc * 32 + fr, fq * 8);
#define PG8_SA(b, h) (((b) * 2 + (h)) * HTB)
#define PG8_SB(b, h) ((4 + (b) * 2 + (h)) * HTB)
#define PG8_STAGE(bufoff, gbase, voff) do { _Pragma("unroll") for (int _i = 0; _i < 2; ++_i) \
        __builtin_amdgcn_global_load_lds((const unsigned*)((const char*)(gbase) + (voff)[_i]), (LAS unsigned*)(lds + (bufoff) + ldsw + _i * 8192), 16, 0, 0); } while (0)
#define PG8_LDA(dst, b, h) do { _Pragma("unroll") for (int m = 0; m < 4; ++m) _Pragma("unroll") for (int k = 0; k < 2; ++k) dst[m][k] = *(const LAS bf16x8*)(lds + PG8_SA(b, h) + aoff + m * 2048 + k * 1024); } while (0)
#define PG8_LDB(dst, b, h) do { _Pragma("unroll") for (int n = 0; n < 2; ++n) _Pragma("unroll") for (int k = 0; k < 2; ++k) dst[n][k] = *(const LAS bf16x8*)(lds + PG8_SB(b, h) + boff + n * 2048 + k * 1024); } while (0)
#define PG8_MMA(ai, bj, At, Bt) do { __builtin_amdgcn_s_setprio(1); _Pragma("unroll") for (int m = 0; m < 4; ++m) _Pragma("unroll") for (int n = 0; n < 2; ++n) _Pragma("unroll") for (int k = 0; k < 2; ++k) \
        acc[ai][bj][m][n] = __builtin_amdgcn_mfma_f32_16x16x32_bf16(Bt[n][k], At[m][k], acc[ai][bj][m][n], 0, 0, 0); __builtin_amdgcn_s_setprio(0); } while (0)
#define PG8_WAIT_V(n) asm volatile("s_waitcnt vmcnt(" #n ")" ::: "memory")
#define PG8_WAIT_L(n) asm volatile("s_waitcnt lgkmcnt(" #n ")" ::: "memory")
#define PG8_BAR __builtin_amdgcn_s_barrier()
#define PG8_SCHED __builtin_amdgcn_sched_barrier(0)
    Unit cur, nxt; int ui = 0;
    if (!S.next(0, cur)) return;
    f32x4 acc[2][2][4][2];
#pragma unroll
    for (int a = 0; a < 2; ++a)
#pragma unroll
        for (int b = 0; b < 2; ++b)
#pragma unroll
            for (int m = 0; m < 4; ++m)
#pragma unroll
                for (int n = 0; n < 2; ++n) acc[a][b][m][n] = (f32x4){0.f, 0.f, 0.f, 0.f};
    bf16x8 At[4][2], B0[2][2], B1[2][2];
    const char* cA = cur.a; const char* cB = cur.b;
    PG8_STAGE(PG8_SB(0, 0), cB, voffB); PG8_STAGE(PG8_SA(0, 0), cA, voffA); PG8_STAGE(PG8_SB(0, 1), cB + hstep, voffB); PG8_STAGE(PG8_SA(0, 1), cA + hstep, voffA);
    if (wr == 1) PG8_BAR;
    PG8_WAIT_V(4); PG8_BAR;
    PG8_STAGE(PG8_SB(1, 0), cB + kstep, voffB); PG8_STAGE(PG8_SA(1, 0), cA + kstep, voffA); PG8_STAGE(PG8_SB(1, 1), cB + hstep + kstep, voffB);
    PG8_WAIT_V(6); PG8_BAR;
    for (;;) {
        const bool has_next = S.next(ui + 1, nxt);
        const char* nA = has_next ? nxt.a : cA; const char* nB = has_next ? nxt.b : cB;
        for (int t = 0; t < nt; t += 2) {
            const bool last = (t == nt - 2);
            const char* a1 = cA + (size_t)(t + 1) * kstep;
            const char* a2 = last ? nA : cA + (size_t)(t + 2) * kstep; const char* b2 = last ? nB : cB + (size_t)(t + 2) * kstep;
            const char* a3 = a2 + kstep; const char* b3 = b2 + kstep;
            PG8_LDB(B0, 0, 0); PG8_SCHED; PG8_LDA(At, 0, 0); PG8_STAGE(PG8_SA(1, 1), a1 + hstep, voffA);
            PG8_WAIT_L(8); PG8_BAR; PG8_WAIT_L(0); PG8_MMA(0, 0, At, B0); PG8_BAR; PG8_SCHED;
            PG8_LDB(B1, 0, 1); PG8_STAGE(PG8_SB(0, 0), b2, voffB);
            PG8_BAR; PG8_WAIT_L(0); PG8_MMA(0, 1, At, B1); PG8_BAR;
            PG8_LDA(At, 0, 1); PG8_STAGE(PG8_SA(0, 0), a2, voffA);
            PG8_BAR; PG8_WAIT_L(0); PG8_MMA(1, 0, At, B0); PG8_BAR; PG8_SCHED;
            PG8_STAGE(PG8_SB(0, 1), b2 + hstep, voffB);
            PG8_WAIT_V(6); PG8_BAR; PG8_MMA(1, 1, At, B1); PG8_BAR;
            PG8_LDB(B0, 1, 0); PG8_SCHED; PG8_LDA(At, 1, 0); PG8_STAGE(PG8_SA(0, 1), a2 + hstep, voffA);
            PG8_WAIT_L(8); PG8_BAR; PG8_WAIT_L(0); PG8_MMA(0, 0, At, B0); PG8_BAR; PG8_SCHED;
            PG8_LDB(B1, 1, 1); PG8_STAGE(PG8_SB(1, 0), b3, voffB);
            PG8_BAR; PG8_WAIT_L(0); PG8_MMA(0, 1, At, B1); PG8_BAR;
            PG8_LDA(At, 1, 1); PG8_STAGE(PG8_SA(1, 0), a3, voffA);
            PG8_BAR; PG8_WAIT_L(0); PG8_MMA(1, 0, At, B0); PG8_BAR; PG8_SCHED;
            PG8_STAGE(PG8_SB(1, 1), b3 + hstep, voffB);
            PG8_WAIT_V(6); PG8_BAR; PG8_MMA(1, 1, At, B1); PG8_BAR;
        }
        E(acc, cur, wr, wc, fr, fq);
        if (!has_next) break;
#pragma unroll
        for (int a = 0; a < 2; ++a)
#pragma unroll
            for (int b = 0; b < 2; ++b)
#pragma unroll
                for (int m = 0; m < 4; ++m)
#pragma unroll
                    for (int n = 0; n < 2; ++n) acc[a][b][m][n] = (f32x4){0.f, 0.f, 0.f, 0.f};
        cur = nxt; cA = nA; cB = nB; ++ui;
    }
    PG8_WAIT_V(0);
    if (wr == 0) PG8_BAR;
    PG8_BAR;
#undef PG8_SA
#undef PG8_SB
#undef PG8_STAGE
#undef PG8_LDA
#undef PG8_LDB
#undef PG8_MMA
#undef PG8_WAIT_V
#undef PG8_WAIT_L
#undef PG8_BAR
#undef PG8_SCHED
}

struct SchedDense {
    int nM, nN, nwg, G, c, K; const char* A; const char* Bt;
    __device__ __forceinline__ bool next(int i, Unit& u) const {
        const long L = (long)i * G + c; if (L >= nwg) return false;
        int wgid = (int)L; { const int q = nwg / 8, r = nwg % 8, xcd = wgid % 8, off = wgid / 8; wgid = (xcd < r ? xcd * (q + 1) : r * (q + 1) + (xcd - r) * q) + off; }
        const int nig = 8 * nN, gid = wgid / nig, fm = gid * 8, gsz = (nM - fm) < 8 ? (nM - fm) : 8;
        u.pm = fm + ((wgid % nig) % gsz); u.pn = (wgid % nig) / gsz;
        u.a = A + (size_t)u.pm * 256 * K * 2; u.b = Bt + (size_t)u.pn * 256 * K * 2; return true;
    }
};
struct SchedMoE {
    int ntiles, G, c, K; const LAS int* tex; const char* A; const char* Bt; size_t bstride;
    __device__ __forceinline__ bool next(int i, Unit& u) const {
        const int L = i * G + c; const int rt = L >> 2; if (rt >= ntiles) return false;
        u.pm = rt; u.pn = L & 3; const int e = tex[rt];
        u.a = A + (size_t)rt * 256 * K * 2; u.b = Bt + (size_t)e * bstride + (size_t)u.pn * 256 * K * 2; return true;
    }
};
}

typedef const f32x4 (&AccRef)[2][2][4][2];
struct EpiZ {
    static constexpr bool PERM = true; bf16_t* Z; float* G;
    __device__ __forceinline__ void operator()(AccRef acc, const pg8::Unit& u, int wr, int wc, int fr, int fq) const {
        const int row0 = u.pm * 256 + wr * 64 + fr;
        if (u.pn < 14) {
            const int col0 = u.pn * 256 + wc * 32 + 8 * fq;
#pragma unroll
            for (int ai = 0; ai < 2; ++ai)
#pragma unroll
                for (int m = 0; m < 4; ++m) { bf16_t* rowp = Z + (size_t)(row0 + ai * 128 + m * 16) * ZLD + col0;
#pragma unroll
                    for (int bj = 0; bj < 2; ++bj) { const f32x4 v0 = acc[ai][bj][m][0], v1 = acc[ai][bj][m][1];
                        u32x4 o; o.x = pk2(v0[0], v0[1]); o.y = pk2(v0[2], v0[3]); o.z = pk2(v1[0], v1[1]); o.w = pk2(v1[2], v1[3]);
                        *(u32x4*)(rowp + bj * 128) = o; } }
        } else {
            const int c0 = wc * 32 + 8 * fq;
            if (c0 < 48) {
#pragma unroll
                for (int ai = 0; ai < 2; ++ai)
#pragma unroll
                    for (int m = 0; m < 4; ++m) { float* rowp = G + (size_t)(row0 + ai * 128 + m * 16) * 48 + c0;
                        *(f32x4*)rowp = acc[ai][0][m][0]; *(f32x4*)(rowp + 4) = acc[ai][0][m][1]; }
            }
        }
    }
};
struct EpiX1 {
    static constexpr bool PERM = false; const float* x; const float* mod; float* out;
    __device__ __forceinline__ void operator()(AccRef acc, const pg8::Unit& u, int wr, int wc, int fr, int fq) const {
        const int row0 = u.pm * 256 + wr * 64 + fr, col0 = u.pn * 256 + wc * 32 + 4 * fq;
        const float* g1 = mod + (size_t)(u.pm >> 4) * 6144 + 2048;
        f32x4 gv[2][2];
#pragma unroll
        for (int bj = 0; bj < 2; ++bj)
#pragma unroll
            for (int n = 0; n < 2; ++n) gv[bj][n] = *(const f32x4*)(g1 + col0 + bj * 128 + n * 16);
#pragma unroll
        for (int ai = 0; ai < 2; ++ai)
#pragma unroll
            for (int m = 0; m < 4; ++m) { const size_t off = (size_t)(row0 + ai * 128 + m * 16) * D + col0;
#pragma unroll
                for (int bj = 0; bj < 2; ++bj)
#pragma unroll
                    for (int n = 0; n < 2; ++n) { const f32x4 xv = *(const f32x4*)(x + off + bj * 128 + n * 16);
                        *(f32x4*)(out + off + bj * 128 + n * 16) = xv + gv[bj][n] * acc[ai][bj][m][n]; } }
    }
};
struct EpiH {
    static constexpr bool PERM = true; bf16_t* H;
    __device__ __forceinline__ void operator()(AccRef acc, const pg8::Unit& u, int wr, int wc, int fr, int fq) const {
        const int row0 = u.pm * 256 + wr * 64 + fr, col0 = u.pn * 128 + wc * 32 + 8 * fq;
#pragma unroll
        for (int ai = 0; ai < 2; ++ai)
#pragma unroll
            for (int m = 0; m < 4; ++m) { bf16_t* rowp = H + (size_t)(row0 + ai * 128 + m * 16) * 512 + col0;
                float h[8];
#pragma unroll
                for (int n = 0; n < 2; ++n)
#pragma unroll
                    for (int j = 0; j < 4; ++j) { const float g = acc[ai][0][m][n][j], up = acc[ai][1][m][n][j]; h[n * 4 + j] = siluf(g) * up; }
                u32x4 o; o.x = pk2(h[0], h[1]); o.y = pk2(h[2], h[3]); o.z = pk2(h[4], h[5]); o.w = pk2(h[6], h[7]);
                *(u32x4*)rowp = o; }
    }
};
struct EpiY {
    static constexpr bool PERM = true; bf16_t* Y;
    __device__ __forceinline__ void operator()(AccRef acc, const pg8::Unit& u, int wr, int wc, int fr, int fq) const {
        const int row0 = u.pm * 256 + wr * 64 + fr, col0 = u.pn * 256 + wc * 32 + 8 * fq;
#pragma unroll
        for (int ai = 0; ai < 2; ++ai)
#pragma unroll
            for (int m = 0; m < 4; ++m) { bf16_t* rowp = Y + (size_t)(row0 + ai * 128 + m * 16) * D + col0;
#pragma unroll
                for (int bj = 0; bj < 2; ++bj) { const f32x4 v0 = acc[ai][bj][m][0], v1 = acc[ai][bj][m][1];
                    u32x4 o; o.x = pk2(v0[0], v0[1]); o.y = pk2(v0[2], v0[3]); o.z = pk2(v1[0], v1[1]); o.w = pk2(v1[2], v1[3]);
                    *(u32x4*)(rowp + bj * 128) = o; } }
    }
};

__device__ __forceinline__ void p0_mod_item(const P& p, LAS unsigned char* lds, int item) {
    LAS float* SV = (LAS float*)lds; LAS float* PS = (LAS float*)(lds + 20480);
    const int tid = threadIdx.x;
    for (int i = tid; i < 5 * 1024; i += NTHR) { const int v = i >> 10, k = i & 1023; const float c = v < 4 ? p.in[1][v * 1024 + k] : p.in[3][k]; SV[i] = c / (1.f + expf(-c)); }
    __syncthreads();
    const int col = tid & 31, kq = tid >> 5, n = item * 32 + col;
    float acc[5] = {0.f, 0.f, 0.f, 0.f, 0.f};
    const float* W = p.in[4] + (size_t)(kq * 64) * 6144 + n;
#pragma unroll 8
    for (int k = 0; k < 64; ++k) { const float w = W[(size_t)k * 6144]; const int kk = kq * 64 + k;
#pragma unroll
        for (int v = 0; v < 5; ++v) acc[v] += SV[v * 1024 + kk] * w; }
#pragma unroll
    for (int v = 0; v < 5; ++v) PS[(kq * 5 + v) * 32 + col] = acc[v];
    __syncthreads();
    if (tid < 160) { const int v = tid >> 5, c = tid & 31; float s = 0.f;
#pragma unroll
        for (int q = 0; q < 16; ++q) s += PS[(q * 5 + v) * 32 + c];
        ((float*)(p.ws + WS_MOD))[v * 6144 + item * 32 + c] = s + p.in[5][item * 32 + c]; }
    __syncthreads();
}
template <class RowMap>
__device__ __forceinline__ void transpose_item(const float* W, int K, int N, bf16_t* WT, LAS float* scr, int kb, int nb, int lane, RowMap rm) {
    const int k0 = 64 * kb, n0 = 32 * nb;
#pragma unroll 8
    for (int i = 0; i < 32; ++i) { const int kk = 2 * i + (lane >> 5), n = n0 + (lane & 31); scr[kk * 33 + (lane & 31)] = n < N ? W[(size_t)(k0 + kk) * N + n] : 0.f; }
    asm volatile("s_waitcnt lgkmcnt(0)" ::: "memory");
    const int c = lane & 7;
#pragma unroll
    for (int j = 0; j < 4; ++j) { const int nl = (lane >> 3) + 8 * j, n = n0 + nl;
        if (n < N) { const LAS float* s = scr + (8 * c) * 33 + nl;
            u32x4 o; o.x = pk2(s[0 * 33], s[1 * 33]); o.y = pk2(s[2 * 33], s[3 * 33]); o.z = pk2(s[4 * 33], s[5 * 33]); o.w = pk2(s[6 * 33], s[7 * 33]);
            *(u32x4*)(WT + (size_t)rm(n) * K + k0 + 8 * c) = o; } }
    asm volatile("s_waitcnt lgkmcnt(0)" ::: "memory");
}
struct RmIn { __device__ __forceinline__ int operator()(int n) const { return n < 1536 ? n : (n < 1568 ? n + 2048 : (n < 3616 ? n - 32 : n)); } };
struct RmId { __device__ __forceinline__ int operator()(int n) const { return n; } };
struct RmE1 { __device__ __forceinline__ int operator()(int n) const { const int half = n >> 9, r = n & 511; return (r >> 7) * 256 + half * 128 + (r & 127); } };

__device__ __forceinline__ void phase0(const P& p, LAS unsigned char* lds) {
    const int tid = threadIdx.x, lane = tid & 63, wave = tid >> 6;
    for (int it = blockIdx.x; it < 192; it += gridDim.x) p0_mod_item(p, lds, it);
    LAS float* scr = (LAS float*)(lds + wave * 16384);
    const int gw = blockIdx.x * 8 + wave, NGW = gridDim.x * 8;
    constexpr int I_IN = 16 * 114, I_OUT = 16 * 32, I_E1 = 32 * 16 * 32, I_E2 = 32 * 8 * 32, NIT = I_IN + I_OUT + I_E1 + I_E2;
    bf16_t* WINT = (bf16_t*)(p.ws + WS_WINT); bf16_t* WOUTT = (bf16_t*)(p.ws + WS_WOUTT); bf16_t* E1T = (bf16_t*)(p.ws + WS_E1T); bf16_t* E2T = (bf16_t*)(p.ws + WS_E2T);
    for (int it = gw; it < NIT; it += NGW) {
        int r = it;
        if (r < I_IN) { transpose_item(p.in[7], 1024, INW, WINT, scr, r / 114, r % 114, lane, RmIn()); continue; } r -= I_IN;
        if (r < I_OUT) { transpose_item(p.in[16], 1024, 1024, WOUTT, scr, r >> 5, r & 31, lane, RmId()); continue; } r -= I_OUT;
        if (r < I_E1) { const int e = r >> 9, q = r & 511; transpose_item(p.in[22] + (size_t)e * 1024 * 1024, 1024, 1024, E1T + (size_t)e * 1024 * 1024, scr, q >> 5, q & 31, lane, RmE1()); continue; } r -= I_E1;
        { const int e = r >> 8, q = r & 255; transpose_item(p.in[23] + (size_t)e * 512 * 1024, 512, 1024, E2T + (size_t)e * 1024 * 512, scr, q >> 5, q & 31, lane, RmId()); }
    }
    for (int i = blockIdx.x * NTHR + tid; i < 208 * 128; i += gridDim.x * NTHR) ((u32x4*)(WINT + (size_t)INW * 1024))[i] = (u32x4){0u, 0u, 0u, 0u};
}

__device__ __forceinline__ void phase1(const P& p) {
    const int tid = threadIdx.x, lane = tid & 63, wave = tid >> 6;
    const float* mod = (const float*)(p.ws + WS_MOD); bf16_t* A = (bf16_t*)(p.ws + WS_A);
    const int gw = blockIdx.x * 8 + wave, NGW = gridDim.x * 8;
    for (int row = gw; row < MT; row += NGW) {
        const float* src = row < MX ? p.in[0] + (size_t)row * D : p.in[2] + (size_t)(row - MX) * D;
        const float* mv = mod + (size_t)(row < MX ? (row >> 12) : 4) * 6144;
        f32x4 v[4]; float ss = 0.f;
#pragma unroll
        for (int j = 0; j < 4; ++j) { v[j] = *(const f32x4*)(src + 4 * lane + 256 * j); ss += v[j].x * v[j].x + v[j].y * v[j].y + v[j].z * v[j].z + v[j].w * v[j].w; }
        const float rstd = 1.f / sqrtf(wave_sum(ss) * (1.f / D) + EPS);
#pragma unroll
        for (int j = 0; j < 4; ++j) { const int k = 4 * lane + 256 * j;
            const f32x4 g = *(const f32x4*)(p.in[6] + k), sh = *(const f32x4*)(mv + k), sc = *(const f32x4*)(mv + 1024 + k);
            const f32x4 o = (v[j] * rstd * g) * (sc + 1.f) + sh;
            u32x2 w; w.x = pk2(o.x, o.y); w.y = pk2(o.z, o.w);
            *(u32x2*)(A + (size_t)row * D + k) = w; }
    }
}

__device__ __forceinline__ void phase3(const P& p) {
    const bf16_t* Z = (const bf16_t*)(p.ws + WS_Z); bf16_t* MQ = (bf16_t*)(p.ws + WS_MQ); bf16_t* MK = (bf16_t*)(p.ws + WS_MK);
    const int tid = threadIdx.x, cg8 = tid & 127, tl = tid >> 7, ch0 = cg8 * 8;
    float w[9][8], bias[8];
#pragma unroll
    for (int a = 0; a < 9; ++a)
#pragma unroll
        for (int j = 0; j < 8; ++j) w[a][j] = p.in[11][a * 1024 + ch0 + j];
#pragma unroll
    for (int j = 0; j < 8; ++j) bias[j] = p.in[12][ch0 + j];
    const float osc = ch0 >= 512 ? 0.08838834764831845f : 1.f;
    bf16_t* dst = ch0 >= 512 ? MK : MQ;
    for (int it = blockIdx.x; it < 272; it += gridDim.x) {
        int rowbase, y, Hh, Ww, x0;
        if (it < 256) { rowbase = (it >> 6) * 4096; y = it & 63; Hh = 64; Ww = 64; x0 = 0; }
        else { const int ci = it - 256; rowbase = MX + (ci >> 2) * 256; y = 0; Hh = 1; Ww = 256; x0 = (ci & 3) * 64; }
        for (int i = 0; i < 16; ++i) {
            const int x = x0 + tl + 4 * i;
            float acc[8];
#pragma unroll
            for (int j = 0; j < 8; ++j) acc[j] = bias[j];
#pragma unroll
            for (int dy = 0; dy < 3; ++dy) { const int yy = y + dy - 1; if (yy < 0 || yy >= Hh) continue;
#pragma unroll
                for (int dx = 0; dx < 3; ++dx) { const int xx = x + dx - 1; if (xx < 0 || xx >= Ww) continue;
                    const u32x4 v = *(const u32x4*)(Z + (size_t)(rowbase + yy * Ww + xx) * ZLD + 1536 + ch0);
                    acc[0] += w[dy * 3 + dx][0] * bflo(v.x); acc[1] += w[dy * 3 + dx][1] * bfhi(v.x);
                    acc[2] += w[dy * 3 + dx][2] * bflo(v.y); acc[3] += w[dy * 3 + dx][3] * bfhi(v.y);
                    acc[4] += w[dy * 3 + dx][4] * bflo(v.z); acc[5] += w[dy * 3 + dx][5] * bfhi(v.z);
                    acc[6] += w[dy * 3 + dx][6] * bflo(v.w); acc[7] += w[dy * 3 + dx][7] * bfhi(v.w); } }
#pragma unroll
            for (int j = 0; j < 8; ++j) acc[j] = siluf(acc[j]) * osc;
            u32x4 o; o.x = pk2(acc[0], acc[1]); o.y = pk2(acc[2], acc[3]); o.z = pk2(acc[4], acc[5]); o.w = pk2(acc[6], acc[7]);
            *(u32x4*)(dst + (size_t)(rowbase + y * Ww + x) * 512 + (ch0 & 511)) = o;
        }
    }
}

__device__ __forceinline__ int chunk_tok0(int b, int tc) { return tc < 64 ? b * SEQ + tc * 64 : MX + b * CTXL + (tc - 64) * 64; }

__device__ __forceinline__ void load_vt(const bf16_t* Z, int tok0, int col0, LAS bf16_t* VT, int tid) {
#pragma unroll
    for (int i = 0; i < 2; ++i) { const int idx = tid + NTHR * i, t = idx >> 4, c = idx & 15;
        const u32x4 v = *(const u32x4*)(Z + (size_t)(tok0 + t) * ZLD + col0 + c * 8);
        LAS bf16_t* d = VT + (c * 8) * 72 + t;
        d[0 * 72] = (bf16_t)(v.x & 0xffff); d[1 * 72] = (bf16_t)(v.x >> 16); d[2 * 72] = (bf16_t)(v.y & 0xffff); d[3 * 72] = (bf16_t)(v.y >> 16);
        d[4 * 72] = (bf16_t)(v.z & 0xffff); d[5 * 72] = (bf16_t)(v.z >> 16); d[6 * 72] = (bf16_t)(v.w & 0xffff); d[7 * 72] = (bf16_t)(v.w >> 16); }
}

__device__ __forceinline__ void p4_gla(const P& p, LAS unsigned char* lds, int b, int h, int tc) {
    const int tid = threadIdx.x, lane = tid & 63, wave = __builtin_amdgcn_readfirstlane(tid >> 6);
    const bf16_t* Z = (const bf16_t*)(p.ws + WS_Z); const float* GT = (const float*)(p.ws + WS_GATES);
    const int tok0 = chunk_tok0(b, tc), sidx = (b * 4 + h) * NCH + tc;
    LAS bf16_t* VT = (LAS bf16_t*)lds; LAS bf16_t* KT = (LAS bf16_t*)(lds + 18432); LAS float* GLR = (LAS float*)(lds + 36864); LAS float* QS = (LAS float*)(lds + 45056);
    load_vt(Z, tok0, 512 + h * 128, VT, tid);
    { const int t = tid >> 3, c4 = tid & 7; *(LAS f32x4*)(GLR + t * 32 + c4 * 4) = *(const f32x4*)(GT + (size_t)(tok0 + t) * 48 + c4 * 4); }
    __syncthreads();
    const int dir = tid >> 8, tq = (tid >> 6) & 3, d = tid & 63;
    float upw[16];
#pragma unroll
    for (int r = 0; r < 16; ++r) upw[r] = p.in[8][(dir * 16 + r) * 256 + h * 64 + d];
    const float upb = p.in[9][dir * 256 + h * 64 + d];
    float la[16]; float tot = 0.f;
#pragma unroll
    for (int i = 0; i < 16; ++i) { const int t = tq * 16 + i; float lg = upb;
#pragma unroll
        for (int r = 0; r < 16; ++r) lg += GLR[t * 32 + dir * 16 + r] * upw[r];
        la[i] = logsigf(lg) * 0.0625f; tot += la[i]; }
    QS[(dir * 4 + tq) * 64 + d] = tot;
    __syncthreads();
    float before = 0.f, all = 0.f;
#pragma unroll
    for (int q = 0; q < 4; ++q) { const float v = QS[(dir * 4 + q) * 64 + d]; all += v; before += (q < tq) ? v : 0.f; }
    float run = before;
#pragma unroll
    for (int i = 0; i < 16; ++i) { const int t = tq * 16 + i;
        const float kx = bf2f(Z[(size_t)(tok0 + t) * ZLD + 256 + h * 64 + d]);
        float e; if (dir == 0) { run += la[i]; e = all - run; } else { e = run; run += la[i]; }
        KT[(dir * 64 + d) * 72 + t] = (bf16_t)f2bf(kx * __expf(e)); }
    if (tq == 0) ((float*)(p.ws + WS_GDEC))[(sidx * 2 + dir) * 64 + d] = __expf(all);
    __syncthreads();
    const int dw = wave >> 2, vt = wave & 3;
    f32x16 acc0, acc1;
#pragma unroll
    for (int r = 0; r < 16; ++r) { acc0[r] = 0.f; acc1[r] = 0.f; }
#pragma unroll
    for (int ks = 0; ks < 4; ++ks) { const bf16x8 a = ldfrag(VT, 72, vt * 32, ks * 16, lane);
        const bf16x8 b0 = ldfrag(KT + dw * 64 * 72, 72, 0, ks * 16, lane), b1 = ldfrag(KT + dw * 64 * 72, 72, 32, ks * 16, lane);
        acc0 = MFMA32(a, b0, acc0); acc1 = MFMA32(a, b1, acc1); }
    bf16_t* U = (bf16_t*)(p.ws + WS_UG) + (size_t)(sidx * 2 + dw) * 8192;
#pragma unroll
    for (int r = 0; r < 16; ++r) { const int v = vt * 32 + crow(r, lane); U[v * 64 + (lane & 31)] = (bf16_t)f2bf(acc0[r]); U[v * 64 + 32 + (lane & 31)] = (bf16_t)f2bf(acc1[r]); }
    __syncthreads();
}

__device__ __forceinline__ void load_ml_gates(const P& p, int tok0, int h, LAS float* IG, LAS float* LF, int tid) {
    if (tid < 128) { const int dir = tid >> 6, t = tid & 63; const float* g = (const float*)(p.ws + WS_GATES) + (size_t)(tok0 + t) * 48;
        IG[dir * 64 + t] = g[32 + dir * 4 + h] + p.in[13][dir * 4 + h];
        LF[dir * 64 + t] = logsigf(g[40 + dir * 4 + h] + p.in[14][dir * 4 + h]); }
}

__device__ __forceinline__ void p4_ml(const P& p, LAS unsigned char* lds, int b, int h, int tc) {
    const int tid = threadIdx.x, lane = tid & 63, wave = __builtin_amdgcn_readfirstlane(tid >> 6);
    const bf16_t* Z = (const bf16_t*)(p.ws + WS_Z); const bf16_t* MK = (const bf16_t*)(p.ws + WS_MK);
    const int tok0 = chunk_tok0(b, tc), sidx = (b * 4 + h) * NCH + tc;
    LAS bf16_t* VT = (LAS bf16_t*)lds; LAS bf16_t* KT = (LAS bf16_t*)(lds + 18432);
    LAS float* IG = (LAS float*)(lds + 55296); LAS float* LF = IG + 128; LAS float* KW = IG + 256;
    load_vt(Z, tok0, 2560 + h * 128, VT, tid);
    load_ml_gates(p, tok0, h, IG, LF, tid);
    __syncthreads();
    if (tid == 0 || tid == 64) { const int dir = tid >> 6; float tot = 0.f;
        for (int t = 0; t < 64; ++t) tot += LF[dir * 64 + t];
        float run = 0.f, ml = -3.0e38f;
        for (int t = 0; t < 64; ++t) { const float lf = LF[dir * 64 + t]; float g;
            if (dir == 0) { run += lf; g = tot - run + IG[t]; } else { g = run + IG[64 + t]; run += lf; }
            KW[dir * 64 + t] = g; ml = fmaxf(ml, g); }
        for (int t = 0; t < 64; ++t) KW[dir * 64 + t] = __expf(KW[dir * 64 + t] - ml);
        float* sc = (float*)(p.ws + WS_MSC) + (size_t)(sidx * 2 + dir) * 4; sc[0] = tot; sc[1] = ml; }
    __syncthreads();
    { const int dir = tid >> 8, th = (tid >> 7) & 1, d = tid & 127;
#pragma unroll 8
        for (int i = 0; i < 32; ++i) { const int t = th * 32 + i; const float kx = bf2f(MK[(size_t)(tok0 + t) * 512 + h * 128 + d]);
            KT[(dir * 128 + d) * 72 + t] = (bf16_t)f2bf(kx * KW[dir * 64 + t]); } }
    __syncthreads();
    if (tid < 256) { const int dir = tid >> 7, d = tid & 127; float s = 0.f;
        for (int t = 0; t < 64; ++t) s += bf2f(KT[(dir * 128 + d) * 72 + t]);
        ((float*)(p.ws + WS_MN))[(size_t)(sidx * 2 + dir) * 128 + d] = s; }
    const int dw = wave >> 2, vt = wave & 3;
    f32x16 acc[4];
#pragma unroll
    for (int q = 0; q < 4; ++q)
#pragma unroll
        for (int r = 0; r < 16; ++r) acc[q][r] = 0.f;
#pragma unroll
    for (int ks = 0; ks < 4; ++ks) { const bf16x8 a = ldfrag(VT, 72, vt * 32, ks * 16, lane);
#pragma unroll
        for (int q = 0; q < 4; ++q) { const bf16x8 bq = ldfrag(KT + dw * 128 * 72, 72, q * 32, ks * 16, lane); acc[q] = MFMA32(a, bq, acc[q]); } }
    bf16_t* U = (bf16_t*)(p.ws + WS_UM) + (size_t)(sidx * 2 + dw) * 16384;
#pragma unroll
    for (int q = 0; q < 4; ++q)
#pragma unroll
        for (int r = 0; r < 16; ++r) { const int v = vt * 32 + crow(r, lane); U[v * 128 + q * 32 + (lane & 31)] = (bf16_t)f2bf(acc[q][r]); }
    __syncthreads();
}

__device__ __forceinline__ void phase4(const P& p, LAS unsigned char* lds) {
    for (int it = blockIdx.x; it < 2 * NSTATE; it += gridDim.x) {
        const int ty = it / NSTATE, r = it % NSTATE, b = r / (4 * NCH), h = (r / NCH) & 3, tc = r % NCH;
        if (ty == 0) p4_gla(p, lds, b, h, tc); else p4_ml(p, lds, b, h, tc);
    }
}

__device__ __forceinline__ int tc_of(int c, int dir) { return dir == 0 ? (c < 4 ? 64 + c : c - 4) : (c < 4 ? 67 - c : 67 - c); }

__device__ __forceinline__ void phase5(const P& p) {
    const int gtid = blockIdx.x * NTHR + threadIdx.x, nthr = gridDim.x * NTHR;
    for (int task = gtid; task < 32768 + 65536 + 512; task += nthr) {
        if (task < 32768) {
            const int chain = task >> 10, e8 = task & 1023, bh = chain >> 1, dir = chain & 1, d0 = (e8 & 7) * 8;
            bf16_t* UG = (bf16_t*)(p.ws + WS_UG); const float* GD = (const float*)(p.ws + WS_GDEC);
            float s[8];
#pragma unroll
            for (int j = 0; j < 8; ++j) s[j] = 0.f;
            u32x4 ub[4]; f32x4 da[4], db[4];
#pragma unroll
            for (int i = 0; i < 4; ++i) { const int si = (bh * NCH + tc_of(i, dir)) * 2 + dir;
                ub[i] = *(const u32x4*)(UG + (size_t)si * 8192 + e8 * 8); da[i] = *(const f32x4*)(GD + si * 64 + d0); db[i] = *(const f32x4*)(GD + si * 64 + d0 + 4); }
            for (int c0 = 0; c0 < NCH; c0 += 4) {
#pragma unroll
                for (int i = 0; i < 4; ++i) { const int c = c0 + i; const int si = (bh * NCH + tc_of(c, dir)) * 2 + dir;
                    const u32x4 u = ub[i]; const f32x4 a = da[i], bq = db[i];
                    if (c + 4 < NCH) { const int sn = (bh * NCH + tc_of(c + 4, dir)) * 2 + dir;
                        ub[i] = *(const u32x4*)(UG + (size_t)sn * 8192 + e8 * 8); da[i] = *(const f32x4*)(GD + sn * 64 + d0); db[i] = *(const f32x4*)(GD + sn * 64 + d0 + 4); }
                    u32x4 o; o.x = pk2(s[0], s[1]); o.y = pk2(s[2], s[3]); o.z = pk2(s[4], s[5]); o.w = pk2(s[6], s[7]);
                    *(u32x4*)(UG + (size_t)si * 8192 + e8 * 8) = o;
                    s[0] = a.x * s[0] + bflo(u.x); s[1] = a.y * s[1] + bfhi(u.x); s[2] = a.z * s[2] + bflo(u.y); s[3] = a.w * s[3] + bfhi(u.y);
                    s[4] = bq.x * s[4] + bflo(u.z); s[5] = bq.y * s[5] + bfhi(u.z); s[6] = bq.z * s[6] + bflo(u.w); s[7] = bq.w * s[7] + bfhi(u.w); }
            }
        } else if (task < 98304) {
            const int tk = task - 32768, chain = tk >> 11, e8 = tk & 2047, bh = chain >> 1, dir = chain & 1;
            bf16_t* UM = (bf16_t*)(p.ws + WS_UM); float* SC = (float*)(p.ws + WS_MSC);
            float s[8];
#pragma unroll
            for (int j = 0; j < 8; ++j) s[j] = 0.f;
            float m = 0.f;
            u32x4 ub[4]; float ae[4], ml[4];
#pragma unroll
            for (int i = 0; i < 4; ++i) { const int si = (bh * NCH + tc_of(i, dir)) * 2 + dir;
                ub[i] = *(const u32x4*)(UM + (size_t)si * 16384 + e8 * 8); ae[i] = SC[si * 4 + 0]; ml[i] = SC[si * 4 + 1]; }
            for (int c0 = 0; c0 < NCH; c0 += 4) {
#pragma unroll
                for (int i = 0; i < 4; ++i) { const int c = c0 + i; const int si = (bh * NCH + tc_of(c, dir)) * 2 + dir;
                    const u32x4 u = ub[i]; const float aend = ae[i], mloc = ml[i];
                    if (c + 4 < NCH) { const int sn = (bh * NCH + tc_of(c + 4, dir)) * 2 + dir;
                        ub[i] = *(const u32x4*)(UM + (size_t)sn * 16384 + e8 * 8); ae[i] = SC[sn * 4 + 0]; ml[i] = SC[sn * 4 + 1]; }
                    u32x4 o; o.x = pk2(s[0], s[1]); o.y = pk2(s[2], s[3]); o.z = pk2(s[4], s[5]); o.w = pk2(s[6], s[7]);
                    *(u32x4*)(UM + (size_t)si * 16384 + e8 * 8) = o;
                    if (e8 == 0) SC[si * 4 + 2] = m;
                    const float mn = fmaxf(aend + m, mloc), f1 = __expf(aend + m - mn), f2 = __expf(mloc - mn); m = mn;
                    s[0] = f1 * s[0] + f2 * bflo(u.x); s[1] = f1 * s[1] + f2 * bfhi(u.x); s[2] = f1 * s[2] + f2 * bflo(u.y); s[3] = f1 * s[3] + f2 * bfhi(u.y);
                    s[4] = f1 * s[4] + f2 * bflo(u.z); s[5] = f1 * s[5] + f2 * bfhi(u.z); s[6] = f1 * s[6] + f2 * bflo(u.w); s[7] = f1 * s[7] + f2 * bfhi(u.w); }
            }
        } else {
            const int tk = task - 98304, chain = tk >> 4, part = tk & 15, bh = chain >> 1, dir = chain & 1;
            float* MN = (float*)(p.ws + WS_MN); const float* SC = (const float*)(p.ws + WS_MSC);
            f32x4 n0 = {0.f, 0.f, 0.f, 0.f}, n1 = {0.f, 0.f, 0.f, 0.f}; float m = 0.f;
            for (int c = 0; c < NCH; ++c) { const int si = (bh * NCH + tc_of(c, dir)) * 2 + dir;
                float* np = MN + (size_t)si * 128 + part * 8;
                const f32x4 u0 = *(const f32x4*)np, u1 = *(const f32x4*)(np + 4); const float aend = SC[si * 4 + 0], mloc = SC[si * 4 + 1];
                *(f32x4*)np = n0; *(f32x4*)(np + 4) = n1;
                const float mn = fmaxf(aend + m, mloc), f1 = __expf(aend + m - mn), f2 = __expf(mloc - mn); m = mn;
                n0 = n0 * f1 + u0 * f2; n1 = n1 * f1 + u1 * f2; }
        }
    }
}

template <bool SIG>
__device__ __forceinline__ void head_norm_store(const P& p, const LAS float* O, int tok0, int h, int zgate_col, const float* gain, int mixcol, int tid) {
    const bf16_t* Z = (const bf16_t*)(p.ws + WS_Z); bf16_t* MIX = (bf16_t*)(p.ws + WS_A);
    const int t = tid >> 3, seg = tid & 7;
    float o[16]; float ss = 0.f;
#pragma unroll
    for (int j = 0; j < 16; ++j) { o[j] = O[t * 132 + seg * 16 + j]; ss += o[j] * o[j]; }
    ss += __shfl_xor(ss, 1); ss += __shfl_xor(ss, 2); ss += __shfl_xor(ss, 4);
    const float rstd = 1.f / sqrtf(ss * (1.f / 128.f) + EPS);
    const u32x4 g0 = *(const u32x4*)(Z + (size_t)(tok0 + t) * ZLD + zgate_col + h * 128 + seg * 16), g1 = *(const u32x4*)(Z + (size_t)(tok0 + t) * ZLD + zgate_col + h * 128 + seg * 16 + 8);
    float gt[16];
    gt[0] = bflo(g0.x); gt[1] = bfhi(g0.x); gt[2] = bflo(g0.y); gt[3] = bfhi(g0.y); gt[4] = bflo(g0.z); gt[5] = bfhi(g0.z); gt[6] = bflo(g0.w); gt[7] = bfhi(g0.w);
    gt[8] = bflo(g1.x); gt[9] = bfhi(g1.x); gt[10] = bflo(g1.y); gt[11] = bfhi(g1.y); gt[12] = bflo(g1.z); gt[13] = bfhi(g1.z); gt[14] = bflo(g1.w); gt[15] = bfhi(g1.w);
    float r[16];
#pragma unroll
    for (int j = 0; j < 16; ++j) { const float gg = SIG ? sigmf(gt[j]) : siluf(gt[j]); r[j] = o[j] * rstd * gain[h * 128 + seg * 16 + j] * gg; }
    u32x4 w0, w1; w0.x = pk2(r[0], r[1]); w0.y = pk2(r[2], r[3]); w0.z = pk2(r[4], r[5]); w0.w = pk2(r[6], r[7]);
    w1.x = pk2(r[8], r[9]); w1.y = pk2(r[10], r[11]); w1.z = pk2(r[12], r[13]); w1.w = pk2(r[14], r[15]);
    bf16_t* dst = MIX + (size_t)(tok0 + t) * D + mixcol + h * 128 + seg * 16;
    *(u32x4*)dst = w0; *(u32x4*)(dst + 8) = w1;
}

__device__ __forceinline__ void p6_gla(const P& p, LAS unsigned char* lds, int b, int h, int j) {
    const int tid = threadIdx.x, lane = tid & 63, wave = __builtin_amdgcn_readfirstlane(tid >> 6);
    const bf16_t* Z = (const bf16_t*)(p.ws + WS_Z); const float* GT = (const float*)(p.ws + WS_GATES);
    const int tok0 = b * SEQ + j * 64, sidx = (b * 4 + h) * NCH + j;
    LAS bf16_t* QF = (LAS bf16_t*)lds; LAS bf16_t* QB = QF + 64 * 72; LAS bf16_t* KF = QB + 64 * 72; LAS bf16_t* KB = KF + 64 * 72;
    LAS bf16_t* VT = (LAS bf16_t*)(lds + 36864); LAS bf16_t* ST = (LAS bf16_t*)(lds + 55296); LAS bf16_t* PF = (LAS bf16_t*)(lds + 92160); LAS bf16_t* PB = PF + 64 * 72;
    LAS float* GLR = (LAS float*)(lds + 110592); LAS float* QS = (LAS float*)(lds + 118784); LAS float* O = (LAS float*)lds;
    load_vt(Z, tok0, 512 + h * 128, VT, tid);
    { const bf16_t* S = (const bf16_t*)(p.ws + WS_UG) + (size_t)(sidx * 2) * 8192;
#pragma unroll
        for (int i = 0; i < 4; ++i) { const int idx = tid + NTHR * i, row = idx >> 3, c = idx & 7;
            *(LAS u32x4*)(ST + row * 72 + c * 8) = *(const u32x4*)(S + (size_t)row * 64 + c * 8); } }
    { const int t = tid >> 3, c4 = tid & 7; *(LAS f32x4*)(GLR + t * 32 + c4 * 4) = *(const f32x4*)(GT + (size_t)(tok0 + t) * 48 + c4 * 4); }
    __syncthreads();
    const int dir = tid >> 8, tq = (tid >> 6) & 3, d = tid & 63;
    {
        float upw[16];
#pragma unroll
        for (int r = 0; r < 16; ++r) upw[r] = p.in[8][(dir * 16 + r) * 256 + h * 64 + d];
        const float upb = p.in[9][dir * 256 + h * 64 + d];
        float la[16]; float tot = 0.f;
#pragma unroll
        for (int i = 0; i < 16; ++i) { const int t = tq * 16 + i; float lg = upb;
#pragma unroll
            for (int r = 0; r < 16; ++r) lg += GLR[t * 32 + dir * 16 + r] * upw[r];
            la[i] = logsigf(lg) * 0.0625f; tot += la[i]; }
        QS[(dir * 4 + tq) * 64 + d] = tot;
        __syncthreads();
        float before = 0.f, all = 0.f;
#pragma unroll
        for (int q = 0; q < 4; ++q) { const float v = QS[(dir * 4 + q) * 64 + d]; all += v; before += (q < tq) ? v : 0.f; }
        float run = before;
        LAS bf16_t* Qd = dir == 0 ? QF : QB; LAS bf16_t* Kd = dir == 0 ? KF : KB;
#pragma unroll
        for (int i = 0; i < 16; ++i) { const int t = tq * 16 + i;
            const float qx = bf2f(Z[(size_t)(tok0 + t) * ZLD + h * 64 + d]) * 0.125f, kx = bf2f(Z[(size_t)(tok0 + t) * ZLD + 256 + h * 64 + d]);
            float bb; if (dir == 0) { run += la[i]; bb = run; } else { bb = all - run; run += la[i]; }
            const float eb = __expf(bb);
            Qd[t * 72 + d] = (bf16_t)f2bf(qx * eb); Kd[t * 72 + d] = (bf16_t)f2bf(kx / eb); }
    }
    __syncthreads();
    {
        const int dw = wave >> 2, tt = (wave >> 1) & 1, st = wave & 1;
        const LAS bf16_t* Qd = dw == 0 ? QF : QB; const LAS bf16_t* Kd = dw == 0 ? KF : KB; LAS bf16_t* Pd = dw == 0 ? PF : PB;
        f32x16 acc;
#pragma unroll
        for (int r = 0; r < 16; ++r) acc[r] = 0.f;
#pragma unroll
        for (int ks = 0; ks < 4; ++ks) acc = MFMA32(ldfrag(Qd, 72, tt * 32, ks * 16, lane), ldfrag(Kd, 72, st * 32, ks * 16, lane), acc);
        const int s = st * 32 + (lane & 31);
#pragma unroll
        for (int r = 0; r < 16; ++r) { const int t = tt * 32 + crow(r, lane); const bool ok = dw == 0 ? (s <= t) : (s >= t);
            Pd[t * 72 + s] = (bf16_t)f2bf(ok ? acc[r] : 0.f); }
    }
    __syncthreads();
    const int tt = wave >> 2, vt = wave & 3;
    f32x16 acc;
#pragma unroll
    for (int r = 0; r < 16; ++r) acc[r] = 0.f;
#pragma unroll
    for (int ks = 0; ks < 4; ++ks) { const bf16x8 vb = ldfrag(VT, 72, vt * 32, ks * 16, lane);
        acc = MFMA32(ldfrag(PF, 72, tt * 32, ks * 16, lane), vb, acc); acc = MFMA32(ldfrag(PB, 72, tt * 32, ks * 16, lane), vb, acc); }
#pragma unroll
    for (int ks = 0; ks < 4; ++ks) { acc = MFMA32(ldfrag(QF, 72, tt * 32, ks * 16, lane), ldfrag(ST, 72, vt * 32, ks * 16, lane), acc);
        acc = MFMA32(ldfrag(QB, 72, tt * 32, ks * 16, lane), ldfrag(ST + 128 * 72, 72, vt * 32, ks * 16, lane), acc); }
    __syncthreads();
#pragma unroll
    for (int r = 0; r < 16; ++r) O[(tt * 32 + crow(r, lane)) * 132 + vt * 32 + (lane & 31)] = acc[r];
    __syncthreads();
    head_norm_store<false>(p, O, tok0, h, 1024, p.in[10], 0, tid);
    __syncthreads();
}

__device__ __forceinline__ void p6_ml(const P& p, LAS unsigned char* lds, int b, int h, int j) {
    const int tid = threadIdx.x, lane = tid & 63, wave = __builtin_amdgcn_readfirstlane(tid >> 6);
    const bf16_t* Z = (const bf16_t*)(p.ws + WS_Z); const bf16_t* MQ = (const bf16_t*)(p.ws + WS_MQ); const bf16_t* MK = (const bf16_t*)(p.ws + WS_MK);
    const int tok0 = b * SEQ + j * 64, sidx = (b * 4 + h) * NCH + j;
    LAS bf16_t* Q = (LAS bf16_t*)lds; LAS bf16_t* K = (LAS bf16_t*)(lds + 17408); LAS bf16_t* VT = (LAS bf16_t*)(lds + 34816); LAS bf16_t* ST = (LAS bf16_t*)(lds + 53248);
    LAS bf16_t* PF = (LAS bf16_t*)(lds + 122880); LAS bf16_t* PB = PF + 64 * 72; LAS float* SM = (LAS float*)(lds + 141312); LAS float* O = (LAS float*)lds;
    LAS float* IG = SM; LAS float* LF = SM + 128; LAS float* CT = SM + 256; LAS float* RT = SM + 384; LAS float* WT = SM + 512; LAS float* ET = SM + 640;
    LAS float* NV = SM + 768;
    LAS float* INV = SM + 1024;
    LAS float* MS = SM + 1152;
#pragma unroll
    for (int i = 0; i < 2; ++i) { const int idx = tid + NTHR * i, t = idx >> 4, c = idx & 15;
        *(LAS u32x4*)(Q + t * 136 + c * 8) = *(const u32x4*)(MQ + (size_t)(tok0 + t) * 512 + h * 128 + c * 8);
        *(LAS u32x4*)(K + t * 136 + c * 8) = *(const u32x4*)(MK + (size_t)(tok0 + t) * 512 + h * 128 + c * 8); }
    load_vt(Z, tok0, 2560 + h * 128, VT, tid);
    { const bf16_t* S = (const bf16_t*)(p.ws + WS_UM) + (size_t)(sidx * 2) * 16384;
#pragma unroll
        for (int i = 0; i < 8; ++i) { const int idx = tid + NTHR * i, row = idx >> 4, c = idx & 15;
            *(LAS u32x4*)(ST + row * 136 + c * 8) = *(const u32x4*)(S + (size_t)row * 128 + c * 8); } }
    load_ml_gates(p, tok0, h, IG, LF, tid);
    if (tid >= 128 && tid < 384) { const int q = tid - 128; NV[q] = ((const float*)(p.ws + WS_MN))[(size_t)(sidx * 2) * 128 + q]; }
    if (tid >= 384 && tid < 386) { const int dir = tid - 384; MS[dir] = ((const float*)(p.ws + WS_MSC))[(size_t)(sidx * 2 + dir) * 4 + 2]; }
    __syncthreads();
    if (tid == 0) {
        const float ms = MS[0]; float a = 0.f, pm = -3.0e38f;
        for (int t = 0; t < 64; ++t) { a += LF[t]; const float c = IG[t] - a; pm = fmaxf(pm, c); const float mt = a + fmaxf(ms, pm);
            CT[t] = c; RT[t] = a - mt; WT[t] = __expf(a + ms - mt); ET[t] = __expf(-mt); }
    } else if (tid == 64) {
        const float ms = MS[1]; float a = 0.f, pm = -3.0e38f;
        for (int t = 63; t >= 0; --t) { a += LF[64 + t]; const float c = IG[64 + t] - a; pm = fmaxf(pm, c); const float mt = a + fmaxf(ms, pm);
            CT[64 + t] = c; RT[64 + t] = a - mt; WT[64 + t] = __expf(a + ms - mt); ET[64 + t] = __expf(-mt); }
    }
    __syncthreads();
    {
        const int dw = wave >> 2, tt = (wave >> 1) & 1, st = wave & 1; LAS bf16_t* Pd = dw == 0 ? PF : PB;
        f32x16 acc;
#pragma unroll
        for (int r = 0; r < 16; ++r) acc[r] = 0.f;
#pragma unroll
        for (int ks = 0; ks < 8; ++ks) acc = MFMA32(ldfrag(Q, 136, tt * 32, ks * 16, lane), ldfrag(K, 136, st * 32, ks * 16, lane), acc);
        const int s = st * 32 + (lane & 31); const float cs = CT[dw * 64 + s];
#pragma unroll
        for (int r = 0; r < 16; ++r) { const int t = tt * 32 + crow(r, lane); const bool ok = dw == 0 ? (s <= t) : (s >= t);
            const float wgt = __expf(fminf(RT[dw * 64 + t] + cs, 0.f));
            Pd[t * 72 + s] = (bf16_t)f2bf(ok ? acc[r] * wgt : 0.f); }
    }
    __syncthreads();
    {
        const int t = tid >> 3, seg = tid & 7;
        float rs0 = 0.f, rs1 = 0.f, qn0 = 0.f, qn1 = 0.f;
#pragma unroll
        for (int i = 0; i < 8; ++i) { rs0 += bf2f(PF[t * 72 + seg * 8 + i]); rs1 += bf2f(PB[t * 72 + seg * 8 + i]); }
#pragma unroll
        for (int i = 0; i < 16; ++i) { const float qv = bf2f(Q[t * 136 + seg * 16 + i]); qn0 += qv * NV[seg * 16 + i]; qn1 += qv * NV[128 + seg * 16 + i]; }
#pragma unroll
        for (int o = 1; o < 8; o <<= 1) { rs0 += __shfl_xor(rs0, o); rs1 += __shfl_xor(rs1, o); qn0 += __shfl_xor(qn0, o); qn1 += __shfl_xor(qn1, o); }
        if (seg == 0) { const float d0 = rs0 + WT[t] * qn0, d1 = rs1 + WT[64 + t] * qn1;
            INV[t] = 1.f / fmaxf(fabsf(d0), ET[t]); INV[64 + t] = 1.f / fmaxf(fabsf(d1), ET[64 + t]); }
    }
    const int tt = wave >> 2, vt = wave & 3;
    f32x16 apf, apb, aqf, aqb;
#pragma unroll
    for (int r = 0; r < 16; ++r) { apf[r] = 0.f; apb[r] = 0.f; aqf[r] = 0.f; aqb[r] = 0.f; }
#pragma unroll
    for (int ks = 0; ks < 4; ++ks) { const bf16x8 vb = ldfrag(VT, 72, vt * 32, ks * 16, lane);
        apf = MFMA32(ldfrag(PF, 72, tt * 32, ks * 16, lane), vb, apf); apb = MFMA32(ldfrag(PB, 72, tt * 32, ks * 16, lane), vb, apb); }
#pragma unroll
    for (int ks = 0; ks < 8; ++ks) { const bf16x8 qa = ldfrag(Q, 136, tt * 32, ks * 16, lane);
        aqf = MFMA32(qa, ldfrag(ST, 136, vt * 32, ks * 16, lane), aqf); aqb = MFMA32(qa, ldfrag(ST + 128 * 136, 136, vt * 32, ks * 16, lane), aqb); }
    __syncthreads();
#pragma unroll
    for (int r = 0; r < 16; ++r) { const int t = tt * 32 + crow(r, lane);
        const float hv = INV[t] * (apf[r] + WT[t] * aqf[r]) + INV[64 + t] * (apb[r] + WT[64 + t] * aqb[r]);
        O[t * 132 + vt * 32 + (lane & 31)] = hv; }
    __syncthreads();
    head_norm_store<true>(p, O, tok0, h, 3072, p.in[15], 512, tid);
    __syncthreads();
}

__device__ __forceinline__ void phase6(const P& p, LAS unsigned char* lds) {
    for (int it = blockIdx.x; it < 2048; it += gridDim.x) {
        const int ty = it >> 10, r = it & 1023, b = r >> 8, h = (r >> 6) & 3, j = r & 63;
        if (ty == 0) p6_gla(p, lds, b, h, j); else p6_ml(p, lds, b, h, j);
    }
}

__device__ __forceinline__ void phase8(const P& p, LAS unsigned char* lds) {
    const int tid = threadIdx.x, lane = tid & 63, wave = tid >> 6;
    LAS bf16_t* RWB = (LAS bf16_t*)lds; LAS float* AB = (LAS float*)(lds + 99072); LAS float* LG = (LAS float*)(lds + 131840) + wave * 768;
    const float* mod = (const float*)(p.ws + WS_MOD);
    for (int k = tid; k < 1024; k += NTHR) {
        const f32x4 g = *(const f32x4*)(p.in[18] + k * 4);
        RWB[0 * 1032 + k] = (bf16_t)f2bf(g.x); RWB[1 * 1032 + k] = (bf16_t)f2bf(g.y); RWB[2 * 1032 + k] = (bf16_t)f2bf(g.z); RWB[3 * 1032 + k] = (bf16_t)f2bf(g.w);
#pragma unroll
        for (int q = 0; q < 8; ++q) { const f32x4 e = *(const f32x4*)(p.in[20] + k * 32 + q * 4);
            RWB[(4 + q * 4 + 0) * 1032 + k] = (bf16_t)f2bf(e.x); RWB[(4 + q * 4 + 1) * 1032 + k] = (bf16_t)f2bf(e.y); RWB[(4 + q * 4 + 2) * 1032 + k] = (bf16_t)f2bf(e.z); RWB[(4 + q * 4 + 3) * 1032 + k] = (bf16_t)f2bf(e.w); }
#pragma unroll
        for (int r = 36; r < 48; ++r) RWB[r * 1032 + k] = (bf16_t)0;
    }
    for (int i = tid; i < 4096; i += NTHR) { const int b = i >> 10, k = i & 1023;
        AB[(b * 2 + 0) * 1024 + k] = p.in[17][k] * (1.f + mod[b * 6144 + 4096 + k]); AB[(b * 2 + 1) * 1024 + k] = mod[b * 6144 + 3072 + k]; }
    __syncthreads();
    bf16_t* H2 = (bf16_t*)(p.ws + WS_MQ);
    int* RT = (int*)(p.ws + WS_ROUTE); unsigned* CNT = (unsigned*)(p.ws + WS_CTL) + CW_CNT;
    const int r16 = lane & 15, kq = lane >> 4;
    for (int grp = blockIdx.x * 8 + wave; grp < MX / 16; grp += gridDim.x * 8) {
        const int row = grp * 16 + r16, b = grp >> 8;
        const float* src = p.out + (size_t)row * D + kq * 8;
        float ss = 0.f;
#pragma unroll 8
        for (int ks = 0; ks < 32; ++ks) { const f32x4 x0 = *(const f32x4*)(src + ks * 32), x1 = *(const f32x4*)(src + ks * 32 + 4);
            ss += x0.x * x0.x + x0.y * x0.y + x0.z * x0.z + x0.w * x0.w + x1.x * x1.x + x1.y * x1.y + x1.z * x1.z + x1.w * x1.w; }
        ss += __shfl_xor(ss, 16); ss += __shfl_xor(ss, 32);
        const float rstd = 1.f / sqrtf(ss * (1.f / D) + EPS);
        const LAS float* al = AB + (b * 2) * 1024 + kq * 8; const LAS float* be = al + 1024;
        f32x4 acc[3];
#pragma unroll
        for (int nt = 0; nt < 3; ++nt) acc[nt] = (f32x4){0.f, 0.f, 0.f, 0.f};
#pragma unroll 4
        for (int ks = 0; ks < 32; ++ks) {
            const f32x4 x0 = *(const f32x4*)(src + ks * 32), x1 = *(const f32x4*)(src + ks * 32 + 4);
            const f32x4 a0 = *(const LAS f32x4*)(al + ks * 32), a1 = *(const LAS f32x4*)(al + ks * 32 + 4), b0 = *(const LAS f32x4*)(be + ks * 32), b1 = *(const LAS f32x4*)(be + ks * 32 + 4);
            const f32x4 h0 = x0 * rstd * a0 + b0, h1 = x1 * rstd * a1 + b1;
            u32x4 hw; hw.x = pk2(h0.x, h0.y); hw.y = pk2(h0.z, h0.w); hw.z = pk2(h1.x, h1.y); hw.w = pk2(h1.z, h1.w);
            *(u32x4*)(H2 + (size_t)row * D + ks * 32 + kq * 8) = hw;
            const bf16x8 af = __builtin_bit_cast(bf16x8, hw);
#pragma unroll
            for (int nt = 0; nt < 3; ++nt) { const bf16x8 bfr = *(const LAS bf16x8*)(RWB + (nt * 16 + r16) * 1032 + ks * 32 + kq * 8);
                acc[nt] = __builtin_amdgcn_mfma_f32_16x16x32_bf16(af, bfr, acc[nt], 0, 0, 0); }
        }
#pragma unroll
        for (int nt = 0; nt < 3; ++nt)
#pragma unroll
            for (int r = 0; r < 4; ++r) LG[(kq * 4 + r) * 48 + nt * 16 + r16] = acc[nt][r];
        asm volatile("s_waitcnt lgkmcnt(0)" ::: "memory");
        if (lane < 16) {
            const LAS float* lg = LG + lane * 48; const int trow = grp * 16 + lane;
            float gl[4];
#pragma unroll
            for (int q = 0; q < 4; ++q) gl[q] = lg[q] + p.in[19][q];
            int gi = 0; float gm = gl[0];
#pragma unroll
            for (int q = 1; q < 4; ++q) if (gl[q] > gm) { gm = gl[q]; gi = q; }
            float den = 0.f;
#pragma unroll
            for (int q = 0; q < 4; ++q) den += __expf(gl[q] - gm);
            const float gwt = 1.f / den;
            float el[8];
#pragma unroll
            for (int q = 0; q < 8; ++q) el[q] = lg[4 + gi * 8 + q] + p.in[21][gi * 8 + q];
            int i0 = 0; float v0 = el[0];
#pragma unroll
            for (int q = 1; q < 8; ++q) if (el[q] > v0) { v0 = el[q]; i0 = q; }
            int i1 = -1; float v1 = -3.0e38f;
#pragma unroll
            for (int q = 0; q < 8; ++q) if (q != i0 && el[q] > v1) { v1 = el[q]; i1 = q; }
            const float e1 = __expf(v1 - v0), w0 = gwt / (1.f + e1), w1 = gwt * e1 / (1.f + e1);
            const int ea = gi * 8 + i0, eb = gi * 8 + i1;
            const int ra = (int)atomicAdd(&CNT[ea], 1u), rb = (int)atomicAdd(&CNT[eb], 1u);
            int* r = RT + (size_t)trow * 8; r[0] = ea; r[1] = eb; r[2] = ra; r[3] = rb; ((float*)r)[4] = w0; ((float*)r)[5] = w1;
        }
        asm volatile("s_waitcnt lgkmcnt(0)" ::: "memory");
    }
}

__device__ __forceinline__ int build_tables(const P& p, LAS int* PST, LAS int* TEX) {
    const unsigned* CNT = (const unsigned*)(p.ws + WS_CTL) + CW_CNT;
    if (threadIdx.x == 0) { int acc = 0;
        for (int e = 0; e < 32; ++e) { PST[e] = acc; const int c = (int)__hip_atomic_load(&CNT[e], __ATOMIC_RELAXED, __HIP_MEMORY_SCOPE_AGENT); const int nt = (c + 255) >> 8;
            for (int t = 0; t < nt; ++t) TEX[(acc >> 8) + t] = e;
            acc += nt << 8; }
        PST[32] = acc; }
    __syncthreads();
    return PST[32] >> 8;
}

__device__ __forceinline__ void phase9(const P& p, LAS unsigned char* lds) {
    LAS int* PST = (LAS int*)lds; LAS int* TEX = PST + 64;
    (void)build_tables(p, PST, TEX);
    const int tid = threadIdx.x, lane = tid & 63, wave = tid >> 6;
    const bf16_t* H2 = (const bf16_t*)(p.ws + WS_MQ); bf16_t* XS = (bf16_t*)(p.ws + WS_Z); int* RT = (int*)(p.ws + WS_ROUTE);
    const int gw = blockIdx.x * 8 + wave, NGW = gridDim.x * 8;
    for (int row = gw; row < MX; row += NGW) {
        int* r = RT + (size_t)row * 8;
        const int s0 = PST[r[0]] + r[2], s1 = PST[r[1]] + r[3];
        const u32x4 a = *(const u32x4*)(H2 + (size_t)row * D + lane * 8), bq = *(const u32x4*)(H2 + (size_t)row * D + 512 + lane * 8);
        *(u32x4*)(XS + (size_t)s0 * D + lane * 8) = a; *(u32x4*)(XS + (size_t)s0 * D + 512 + lane * 8) = bq;
        *(u32x4*)(XS + (size_t)s1 * D + lane * 8) = a; *(u32x4*)(XS + (size_t)s1 * D + 512 + lane * 8) = bq;
        if (lane == 0) { r[6] = s0; r[7] = s1; }
    }
}

__device__ __forceinline__ void phase12(const P& p) {
    const int tid = threadIdx.x, lane = tid & 63, wave = tid >> 6;
    const float* mod = (const float*)(p.ws + WS_MOD); const bf16_t* Y = (const bf16_t*)(p.ws + WS_Z); const int* RT = (const int*)(p.ws + WS_ROUTE);
    const int gw = blockIdx.x * 8 + wave, NGW = gridDim.x * 8;
    for (int row = gw; row < MX; row += NGW) {
        const int* r = RT + (size_t)row * 8; const int s0 = r[6], s1 = r[7]; const float w0 = ((const float*)r)[4], w1 = ((const float*)r)[5];
        float* xr = p.out + (size_t)row * D; const float* g2 = mod + (size_t)(row >> 12) * 6144 + 5120;
        f32x4 v[4]; float ss = 0.f;
#pragma unroll
        for (int j = 0; j < 4; ++j) { const int k = 4 * lane + 256 * j;
            const f32x4 x1 = *(const f32x4*)(xr + k), g = *(const f32x4*)(g2 + k);
            const u32x2 ya = *(const u32x2*)(Y + (size_t)s0 * D + k), yb = *(const u32x2*)(Y + (size_t)s1 * D + k);
            f32x4 m; m.x = w0 * bflo(ya.x) + w1 * bflo(yb.x); m.y = w0 * bfhi(ya.x) + w1 * bfhi(yb.x); m.z = w0 * bflo(ya.y) + w1 * bflo(yb.y); m.w = w0 * bfhi(ya.y) + w1 * bfhi(yb.y);
            v[j] = x1 + g * m; ss += v[j].x * v[j].x + v[j].y * v[j].y + v[j].z * v[j].z + v[j].w * v[j].w; }
        const float rstd = 1.f / sqrtf(wave_sum(ss) * (1.f / D) + EPS);
#pragma unroll
        for (int j = 0; j < 4; ++j) { const int k = 4 * lane + 256 * j; const f32x4 g = *(const f32x4*)(p.in[24] + k); *(f32x4*)(xr + k) = v[j] * rstd * g; }
    }
}

constexpr int NPH = 13;
__global__ void __launch_bounds__(NTHR, 2) mega(P p) {
    extern __shared__ __attribute__((aligned(16))) unsigned char lds_raw[];
    LAS unsigned char* lds = (LAS unsigned char*)lds_raw;
    volatile LAS unsigned* xst = (volatile LAS unsigned*)(lds + LDS_XB);
    if (threadIdx.x < 2) xst[threadIdx.x] = 0u;
    __syncthreads();
    XcdBarrier xb = xcd_barrier_post((unsigned*)(p.ws + WS_CTL) + CW_BAR, xst);
    const int lo = p.ph_lo, hi = p.ph_hi;
    const int G = gridDim.x, bx = blockIdx.x;
    const int vcu = (G % 8 == 0) ? (bx % 8) * (G / 8) + bx / 8 : bx;
#ifndef PHASE_MASK
#define PHASE_MASK 0x1fff
#endif
#define IN(k) (((PHASE_MASK >> (k)) & 1) && lo <= (k) && (k) < hi)
#define SEAM(k) do { if ((k) + 1 < hi) xcd_barrier(xb); } while (0)
#define REPN(k) (1 + ((REP_MASK >> (k)) & 1))
    if (IN(0)) { for (int rep = 0; rep < REPN(0); ++rep) { if (rep) xcd_barrier(xb); phase0(p, lds); } for (int q = 0; q < EXTRA_SYNCS; ++q) xcd_barrier(xb); SEAM(0); }
    if (IN(1)) { for (int rep = 0; rep < REPN(1); ++rep) { if (rep) xcd_barrier(xb); phase1(p); } SEAM(1); }
    if (IN(2)) {
        pg8::SchedDense S; S.nM = MT / 256; S.nN = NPADW / 256; S.nwg = S.nM * S.nN; S.G = G; S.c = bx; S.K = 1024; S.A = (const char*)(p.ws + WS_A); S.Bt = (const char*)(p.ws + WS_WINT);
        EpiZ E; E.Z = (bf16_t*)(p.ws + WS_Z); E.G = (float*)(p.ws + WS_GATES);
        for (int rep = 0; rep < REPN(2); ++rep) { if (rep) xcd_barrier(xb); pg8::gemm_phase(lds, 1024, S, E); } SEAM(2); }
    if (IN(3)) { for (int rep = 0; rep < REPN(3); ++rep) { if (rep) xcd_barrier(xb); phase3(p); } SEAM(3); }
    if (IN(4)) { for (int rep = 0; rep < REPN(4); ++rep) { if (rep) xcd_barrier(xb); phase4(p, lds); } SEAM(4); }
    if (IN(5)) { for (int rep = 0; rep < REPN(5); ++rep) { if (rep) { xcd_barrier(xb); phase4(p, lds); xcd_barrier(xb); } phase5(p); } SEAM(5); }
    if (IN(6)) { for (int rep = 0; rep < REPN(6); ++rep) { if (rep) xcd_barrier(xb); phase6(p, lds); } SEAM(6); }
    if (IN(7)) {
        pg8::SchedDense S; S.nM = MX / 256; S.nN = 4; S.nwg = S.nM * S.nN; S.G = G; S.c = bx; S.K = 1024; S.A = (const char*)(p.ws + WS_A); S.Bt = (const char*)(p.ws + WS_WOUTT);
        EpiX1 E; E.x = p.in[0]; E.mod = (const float*)(p.ws + WS_MOD); E.out = p.out;
        for (int rep = 0; rep < REPN(7); ++rep) { if (rep) xcd_barrier(xb); pg8::gemm_phase(lds, 1024, S, E); } SEAM(7); }
    if (IN(8)) { for (int rep = 0; rep < REPN(8); ++rep) { if (rep) { xcd_barrier(xb); if (bx == 0 && threadIdx.x < 32) ((unsigned*)(p.ws + WS_CTL))[CW_CNT + threadIdx.x] = 0u; xcd_barrier(xb); } phase8(p, lds); } SEAM(8); }
    if (IN(9)) { for (int rep = 0; rep < REPN(9); ++rep) { if (rep) xcd_barrier(xb); phase9(p, lds); } SEAM(9); }
    if (IN(10)) {
        LAS int* PST = (LAS int*)(lds + pg8::STAGE_BYTES); LAS int* TEX = PST + 64;
        const int ntiles = build_tables(p, PST, TEX);
        pg8::SchedMoE S; S.ntiles = ntiles; S.G = G; S.c = vcu; S.K = 1024; S.tex = TEX; S.A = (const char*)(p.ws + WS_Z); S.Bt = (const char*)(p.ws + WS_E1T); S.bstride = (size_t)1024 * 1024 * 2;
        EpiH E; E.H = (bf16_t*)(p.ws + WS_UM);
        for (int rep = 0; rep < REPN(10); ++rep) { if (rep) xcd_barrier(xb); pg8::gemm_phase(lds, 1024, S, E); } SEAM(10); }
    if (IN(11)) {
        LAS int* PST = (LAS int*)(lds + pg8::STAGE_BYTES); LAS int* TEX = PST + 64;
        const int ntiles = build_tables(p, PST, TEX);
        pg8::SchedMoE S; S.ntiles = ntiles; S.G = G; S.c = vcu; S.K = 512; S.tex = TEX; S.A = (const char*)(p.ws + WS_UM); S.Bt = (const char*)(p.ws + WS_E2T); S.bstride = (size_t)1024 * 512 * 2;
        EpiY E; E.Y = (bf16_t*)(p.ws + WS_Z);
        for (int rep = 0; rep < REPN(11); ++rep) { if (rep) xcd_barrier(xb); pg8::gemm_phase(lds, 512, S, E); } SEAM(11); }
    if (IN(12)) { phase12(p); }
#undef IN
#undef SEAM
}

extern "C" void kernel_launch(void* const* d_in, const int* in_sizes, int n_in, void* d_out, int out_size, void* d_ws, size_t ws_size, hipStream_t stream) {
    static int grid = 0;
    if (grid == 0) {
        if (n_in != 25 || out_size != MX * D || ws_size < WS_END) { fprintf(stderr, "kernel_launch: unexpected problem (n_in %d out %d ws %zu)\n", n_in, out_size, ws_size); grid = -1; return; }
        int dev = 0, cus = 0, per_cu = 0;
        hipGetDevice(&dev); hipDeviceGetAttribute(&cus, hipDeviceAttributeMultiprocessorCount, dev);
        if (hipFuncSetAttribute((const void*)mega, hipFuncAttributeMaxDynamicSharedMemorySize, LDS_BYTES) != hipSuccess) { fprintf(stderr, "kernel_launch: hipFuncSetAttribute failed\n"); grid = -1; return; }
        if (hipOccupancyMaxActiveBlocksPerMultiprocessor(&per_cu, (const void*)mega, NTHR, LDS_BYTES) != hipSuccess || per_cu < 1) { fprintf(stderr, "kernel_launch: occupancy query says %d\n", per_cu); per_cu = 1; }
        (void)hipGetLastError();
        grid = cus;
    }
    if (grid < 0) return;
    hipMemsetAsync((char*)d_ws + WS_CTL, 0, 1 * MiB, stream);
    P a{};
    for (int i = 0; i < 25; ++i) a.in[i] = (const float*)d_in[i];
    a.out = (float*)d_out; a.ws = (unsigned char*)d_ws;
#if N_LAUNCH_MODE == 1
    a.ph_lo = 0; a.ph_hi = NPH;
    void* args[] = {&a};
    hipError_t e = hipLaunchCooperativeKernel((const void*)mega, dim3(grid), dim3(NTHR), args, LDS_BYTES, stream);
    if (e != hipSuccess) fprintf(stderr, "cooperative launch failed: %s (grid %d)\n", hipGetErrorString(e), grid);
#else
    for (int ph = 0; ph < NPH; ++ph) { a.ph_lo = ph; a.ph_hi = ph + 1; hipLaunchKernelGGL(mega, dim3(grid), dim3(NTHR), LDS_BYTES, stream, a); }
#endif
}
```

```cpp
#include <hip/hip_runtime.h>
#include <hip/hip_cooperative_groups.h>
#include <cstdio>
namespace cg = cooperative_groups;

#ifndef N_LAUNCH_MODE
#define N_LAUNCH_MODE 1
#endif

#ifndef REP_MASK
#define REP_MASK 0
#endif
#ifndef EXTRA_SYNCS
#define EXTRA_SYNCS 0
#endif
#define LAS __attribute__((address_space(3)))
typedef unsigned short bf16_t;
typedef short bf16x8 __attribute__((ext_vector_type(8)));
typedef float f32x4 __attribute__((ext_vector_type(4)));
typedef float f32x16 __attribute__((ext_vector_type(16)));
typedef unsigned u32x2 __attribute__((ext_vector_type(2)));
typedef unsigned u32x4 __attribute__((ext_vector_type(4)));

constexpr int D = 1024, NB = 4, SEQ = 4096, CTXL = 256;
constexpr int MX = NB * SEQ, MC = NB * CTXL, MT = MX + MC;
constexpr int INW = 3632, ZLD = 3584, NPADW = 3840;
constexpr int NCH = 68;
constexpr int NSTATE = NB * 4 * NCH;
constexpr float EPS = 1e-6f;
constexpr int NTHR = 512;
constexpr int LDS_BYTES = 160 * 1024;

constexpr size_t MiB = 1u << 20;
constexpr size_t WS_CTL = 0;
constexpr size_t WS_MOD = 1 * MiB;
constexpr size_t WS_ROUTE = 2 * MiB;
constexpr size_t WS_GDEC = 3 * MiB;
constexpr size_t WS_MN = 4 * MiB;
constexpr size_t WS_MSC = 6 * MiB;
constexpr size_t WS_GATES = 7 * MiB;
constexpr size_t WS_WINT = 11 * MiB;
constexpr size_t WS_WOUTT = 19 * MiB;
constexpr size_t WS_E1T = 21 * MiB;
constexpr size_t WS_E2T = 85 * MiB;
constexpr size_t WS_A = 117 * MiB;
constexpr size_t WS_Z = 151 * MiB;
constexpr size_t WS_MQ = 270 * MiB;
constexpr size_t WS_MK = 287 * MiB;
constexpr size_t WS_UG = 304 * MiB;
constexpr size_t WS_UM = 338 * MiB;
constexpr size_t WS_PSS = 406 * MiB;
constexpr size_t WS_END = 408 * MiB;
constexpr int CW_CNT = 64;
constexpr int CW_BAR = 4096;
constexpr int LDS_XB = LDS_BYTES - 64;

struct P { const float* in[25]; float* out; unsigned char* ws; int ph_lo, ph_hi; };

__device__ __forceinline__ unsigned f2bf(float f) { unsigned u = __float_as_uint(f); return (u + 0x7fffu + ((u >> 16) & 1u)) >> 16; }
__device__ __forceinline__ unsigned pk2(float lo, float hi) { return f2bf(lo) | (f2bf(hi) << 16); }
__device__ __forceinline__ float bf2f(unsigned b) { return __uint_as_float(b << 16); }
__device__ __forceinline__ float bflo(unsigned w) { return __uint_as_float(w << 16); }
__device__ __forceinline__ float bfhi(unsigned w) { return __uint_as_float(w & 0xffff0000u); }
__device__ __forceinline__ float wave_sum(float v) {
#pragma unroll
    for (int o = 32; o >= 1; o >>= 1) v += __shfl_xor(v, o);
    return v;
}
__device__ __forceinline__ float siluf(float x) { return x / (1.f + __expf(-x)); }
__device__ __forceinline__ float sigmf(float x) { return 1.f / (1.f + __expf(-x)); }
__device__ __forceinline__ float logsigf(float x) { return fminf(x, 0.f) - __logf(1.f + __expf(-fabsf(x))); }


__device__ __forceinline__ float scan_sum_up(float v, int lane) {
#pragma unroll
    for (int o = 1; o < 64; o <<= 1) { const float t = __shfl_up(v, o); v += (lane >= o) ? t : 0.f; }
    return v;
}
__device__ __forceinline__ float scan_sum_down(float v, int lane) {
#pragma unroll
    for (int o = 1; o < 64; o <<= 1) { const float t = __shfl_down(v, o); v += (lane + o < 64) ? t : 0.f; }
    return v;
}
__device__ __forceinline__ float scan_max_up(float v, int lane) {
#pragma unroll
    for (int o = 1; o < 64; o <<= 1) { const float t = __shfl_up(v, o); v = (lane >= o) ? fmaxf(v, t) : v; }
    return v;
}
__device__ __forceinline__ float scan_max_down(float v, int lane) {
#pragma unroll
    for (int o = 1; o < 64; o <<= 1) { const float t = __shfl_down(v, o); v = (lane + o < 64) ? fmaxf(v, t) : v; }
    return v;
}
__device__ __forceinline__ float wave_max(float v) {
#pragma unroll
    for (int o = 32; o >= 1; o >>= 1) v = fmaxf(v, __shfl_xor(v, o));
    return v;
}

__device__ __forceinline__ bf16x8 ldfrag(const LAS bf16_t* T, int ld, int row0, int k0, int lane) {
    return *(const LAS bf16x8*)(T + (row0 + (lane & 31)) * ld + k0 + 8 * (lane >> 5));
}
#define MFMA32(a, b, c) __builtin_amdgcn_mfma_f32_32x32x16_bf16((a), (b), (c), 0, 0, 0)
__device__ __forceinline__ int crow(int r, int lane) { return (r & 3) + 8 * (r >> 2) + 4 * (lane >> 5); }


#define XB_TMO      128
#define XB_XCNT(j)  (256  + 64 * (j))
#define XB_XSUB(j)  (1280 + 64 * (j))
#define XB_XGEN(j)  (2304 + 64 * (j))
#define XB_TOP      3328
#define XB_TOPGEN   3392
#define XCD_BAR_WORDS 3456
#define XB_SPIN_CAP (1u << 22)
__device__ __forceinline__ unsigned xb_ld(unsigned* p)              { return __hip_atomic_load(p, __ATOMIC_RELAXED, __HIP_MEMORY_SCOPE_AGENT); }
__device__ __forceinline__ unsigned xb_add(unsigned* p, unsigned v) { return __hip_atomic_fetch_add(p, v, __ATOMIC_RELAXED, __HIP_MEMORY_SCOPE_AGENT); }
__device__ __forceinline__ unsigned xb_xcc_id() { return (unsigned)__builtin_amdgcn_s_getreg((3 << 11) | 20) & 0xFu; }
#define XB_SPIN(cond, bar) do { unsigned _sp = 0; while (cond) { __builtin_amdgcn_s_sleep(1); \
    if ((++_sp & 255u) == 0u) { if (xb_ld(&(bar)[XB_TMO])) break; if (_sp > XB_SPIN_CAP) { atomicAdd(&(bar)[XB_TMO], 1u); break; } } } } while (0)
struct XcdBarrier { unsigned* bar; unsigned x; volatile LAS unsigned* st; };
__device__ __forceinline__ XcdBarrier xcd_barrier_post(unsigned* bar, volatile LAS unsigned* st) {
    XcdBarrier b; b.bar = bar; b.x = xb_xcc_id(); b.st = st;
    if (threadIdx.x == 0) (void)xb_add(&bar[XB_XCNT(b.x)], 1u);
    return b;
}
__device__ __forceinline__ void xcd_barrier_complete(unsigned* bar, unsigned x, unsigned& nloc, unsigned& nx) {
    const unsigned G = gridDim.x * gridDim.y * gridDim.z;
    unsigned sum, cnt, mine, sp = 0u;
    for (;;) {
        sum = 0u; cnt = 0u; mine = 0u;
#pragma unroll
        for (unsigned j = 0; j < 16; ++j) { const unsigned c = xb_ld(&bar[XB_XCNT(j)]); sum += c; cnt += (c > 0u) ? 1u : 0u; mine = (j == x) ? c : mine; }
        if (sum == G) break;
        __builtin_amdgcn_s_sleep(1);
        if ((++sp & 255u) == 0u) { if (xb_ld(&bar[XB_TMO])) break; if (sp > XB_SPIN_CAP) { atomicAdd(&bar[XB_TMO], 1u); break; } }
    }
    nloc = mine > 0u ? mine : 1u; nx = cnt > 0u ? cnt : 1u;
}
__device__ __forceinline__ void xcd_barrier(const XcdBarrier& b) {
    asm volatile("s_waitcnt vmcnt(0)" ::: "memory");
    __syncthreads();
    if (threadIdx.x == 0) {
        unsigned* bar = b.bar;
        __builtin_amdgcn_s_waitcnt(0);
        unsigned nloc = b.st[0], nx = b.st[1];
        if (nloc == 0u) { xcd_barrier_complete(bar, b.x, nloc, nx); b.st[0] = nloc; b.st[1] = nx; }
        const unsigned old = xb_add(&bar[XB_XSUB(b.x)], 1u);
        const unsigned gen = old / nloc;
        if (old + 1u == (gen + 1u) * nloc) {
            __builtin_amdgcn_fence(__ATOMIC_RELEASE, "agent");
            asm volatile("s_waitcnt vmcnt(0)" ::: "memory");
            const unsigned og = xb_add(&bar[XB_TOP], 1u);
            const unsigned tg = og / nx;
            if (og + 1u == (tg + 1u) * nx) xb_add(&bar[XB_TOPGEN], 1u);
            else XB_SPIN(xb_ld(&bar[XB_TOPGEN]) == tg, bar);
            __builtin_amdgcn_fence(__ATOMIC_ACQUIRE, "agent");
            xb_add(&bar[XB_XGEN(b.x)], 1u);
            asm volatile("s_waitcnt vmcnt(0)" ::: "memory");
        } else {
            XB_SPIN(xb_ld(&bar[XB_XGEN(b.x)]) == gen, bar);
            __builtin_amdgcn_fence(__ATOMIC_ACQUIRE, "agent");
            asm volatile("s_waitcnt vmcnt(0)" ::: "memory");
        }
    }
    __syncthreads();
}

namespace pg8 {
constexpr int BM = 256, BK = 64, HALF = 128, HTB = HALF * BK * 2, STAGE_BYTES = 8 * HTB;
__device__ __forceinline__ int lds_byte(int r, int c) { const int st = (r >> 4) * 2 + (c >> 5), rr = r & 15, cc = c & 31, ob = rr * 64 + cc * 2; return st * 1024 + (ob ^ (((ob >> 9) & 1) << 5)); }
__device__ __forceinline__ void stage_rc(int b, int& R, int& C) { const int st = b / 1024, sb = b % 1024, swz = sb ^ (((sb >> 9) & 1) << 5); R = (st >> 1) * 16 + swz / 64; C = (st & 1) * 32 + (swz % 64) / 2; }
__device__ __forceinline__ int perm32(int rho) { const int n = rho >> 4, i = rho & 15; return 8 * (i >> 2) + 4 * n + (i & 3); }
struct Unit { int pm, pn; const char* a; const char* b; };

template <class Epi, class Sched>
__device__ __forceinline__ void gemm_phase(LAS unsigned char* lds, const int K, const Sched& S, const Epi& E) {
    const int tid = threadIdx.x, wid = __builtin_amdgcn_readfirstlane(tid >> 6), lane = tid & 63, wr = wid >> 2, wc = wid & 3, fr = lane & 15, fq = lane >> 4;
    const int nt = K / BK;
    unsigned voffA[2], voffB[2];
#pragma unroll
    for (int i = 0; i < 2; ++i) { int R, C; stage_rc(tid * 16 + i * 8192, R, C); const int Rb = Epi::PERM ? ((R & ~31) + perm32(R & 31)) : R;
        voffA[i] = (unsigned)(R * K + C) * 2u; voffB[i] = (unsigned)(Rb * K + C) * 2u; }
    const size_t kstep = (size_t)(BK * 2);
    const size_t hstep = (size_t)HALF * K * 2;
    const unsigned ldsw = (unsigned)wid * 1024u;
    const int aoff = lds_byte(wr * 64 + fr, fq * 8), boff = lds_byte(wc * 32 + fr, fq * 8);
#define PG8_SA(b, h) (((b) * 2 + (h)) * HTB)
#define PG8_SB(b, h) ((4 + (b) * 2 + (h)) * HTB)
#define PG8_STAGE(bufoff, gbase, voff) do { _Pragma("unroll") for (int _i = 0; _i < 2; ++_i) \
        __builtin_amdgcn_global_load_lds((const unsigned*)((const char*)(gbase) + (voff)[_i]), (LAS unsigned*)(lds + (bufoff) + ldsw + _i * 8192), 16, 0, 0); } while (0)
#define PG8_LDA(dst, b, h) do { _Pragma("unroll") for (int m = 0; m < 4; ++m) _Pragma("unroll") for (int k = 0; k < 2; ++k) dst[m][k] = *(const LAS bf16x8*)(lds + PG8_SA(b, h) + aoff + m * 2048 + k * 1024); } while (0)
#define PG8_LDB(dst, b, h) do { _Pragma("unroll") for (int n = 0; n < 2; ++n) _Pragma("unroll") for (int k = 0; k < 2; ++k) dst[n][k] = *(const LAS bf16x8*)(lds + PG8_SB(b, h) + boff + n * 2048 + k * 1024); } while (0)
#define PG8_MMA(ai, bj, At, Bt) do { __builtin_amdgcn_s_setprio(1); _Pragma("unroll") for (int m = 0; m < 4; ++m) _Pragma("unroll") for (int n = 0; n < 2; ++n) _Pragma("unroll") for (int k = 0; k < 2; ++k) \
        acc[ai][bj][m][n] = __builtin_amdgcn_mfma_f32_16x16x32_bf16(Bt[n][k], At[m][k], acc[ai][bj][m][n], 0, 0, 0); __builtin_amdgcn_s_setprio(0); } while (0)
#define PG8_WAIT_V(n) asm volatile("s_waitcnt vmcnt(" #n ")" ::: "memory")
#define PG8_WAIT_L(n) asm volatile("s_waitcnt lgkmcnt(" #n ")" ::: "memory")
#define PG8_BAR __builtin_amdgcn_s_barrier()
#define PG8_SCHED __builtin_amdgcn_sched_barrier(0)
    Unit cur, nxt; int ui = 0;
    if (!S.next(0, cur)) return;
    f32x4 acc[2][2][4][2];
#pragma unroll
    for (int a = 0; a < 2; ++a)
#pragma unroll
        for (int b = 0; b < 2; ++b)
#pragma unroll
            for (int m = 0; m < 4; ++m)
#pragma unroll
                for (int n = 0; n < 2; ++n) acc[a][b][m][n] = (f32x4){0.f, 0.f, 0.f, 0.f};
    bf16x8 At[4][2], B0[2][2], B1[2][2];
    const char* cA = cur.a; const char* cB = cur.b;
    PG8_STAGE(PG8_SB(0, 0), cB, voffB); PG8_STAGE(PG8_SA(0, 0), cA, voffA); PG8_STAGE(PG8_SB(0, 1), cB + hstep, voffB); PG8_STAGE(PG8_SA(0, 1), cA + hstep, voffA);
    if (wr == 1) PG8_BAR;
    PG8_WAIT_V(4); PG8_BAR;
    PG8_STAGE(PG8_SB(1, 0), cB + kstep, voffB); PG8_STAGE(PG8_SA(1, 0), cA + kstep, voffA); PG8_STAGE(PG8_SB(1, 1), cB + hstep + kstep, voffB);
    PG8_WAIT_V(6); PG8_BAR;
    for (;;) {
        const bool has_next = S.next(ui + 1, nxt);
        const char* nA = has_next ? nxt.a : cA; const char* nB = has_next ? nxt.b : cB;
        for (int t = 0; t < nt; t += 2) {
            const bool last = (t == nt - 2);
            const char* a1 = cA + (size_t)(t + 1) * kstep;
            const char* a2 = last ? nA : cA + (size_t)(t + 2) * kstep; const char* b2 = last ? nB : cB + (size_t)(t + 2) * kstep;
            const char* a3 = a2 + kstep; const char* b3 = b2 + kstep;
            PG8_LDB(B0, 0, 0); PG8_SCHED; PG8_LDA(At, 0, 0); PG8_STAGE(PG8_SA(1, 1), a1 + hstep, voffA);
            PG8_WAIT_L(8); PG8_BAR; PG8_WAIT_L(0); PG8_MMA(0, 0, At, B0); PG8_BAR; PG8_SCHED;
            PG8_LDB(B1, 0, 1); PG8_STAGE(PG8_SB(0, 0), b2, voffB);
            PG8_BAR; PG8_WAIT_L(0); PG8_MMA(0, 1, At, B1); PG8_BAR;
            PG8_LDA(At, 0, 1); PG8_STAGE(PG8_SA(0, 0), a2, voffA);
            PG8_BAR; PG8_WAIT_L(0); PG8_MMA(1, 0, At, B0); PG8_BAR; PG8_SCHED;
            PG8_STAGE(PG8_SB(0, 1), b2 + hstep, voffB);
            PG8_WAIT_V(6); PG8_BAR; PG8_MMA(1, 1, At, B1); PG8_BAR;
            PG8_LDB(B0, 1, 0); PG8_SCHED; PG8_LDA(At, 1, 0); PG8_STAGE(PG8_SA(0, 1), a2 + hstep, voffA);
            PG8_WAIT_L(8); PG8_BAR; PG8_WAIT_L(0); PG8_MMA(0, 0, At, B0); PG8_BAR; PG8_SCHED;
            PG8_LDB(B1, 1, 1); PG8_STAGE(PG8_SB(1, 0), b3, voffB);
            PG8_BAR; PG8_WAIT_L(0); PG8_MMA(0, 1, At, B1); PG8_BAR;
            PG8_LDA(At, 1, 1); PG8_STAGE(PG8_SA(1, 0), a3, voffA);
            PG8_BAR; PG8_WAIT_L(0); PG8_MMA(1, 0, At, B0); PG8_BAR; PG8_SCHED;
            PG8_STAGE(PG8_SB(1, 1), b3 + hstep, voffB);
            PG8_WAIT_V(6); PG8_BAR; PG8_MMA(1, 1, At, B1); PG8_BAR;
        }
        E(acc, cur, wr, wc, fr, fq);
        if (!has_next) break;
#pragma unroll
        for (int a = 0; a < 2; ++a)
#pragma unroll
            for (int b = 0; b < 2; ++b)
#pragma unroll
                for (int m = 0; m < 4; ++m)
#pragma unroll
                    for (int n = 0; n < 2; ++n) acc[a][b][m][n] = (f32x4){0.f, 0.f, 0.f, 0.f};
        cur = nxt; cA = nA; cB = nB; ++ui;
    }
    PG8_WAIT_V(0);
    if (wr == 0) PG8_BAR;
    PG8_BAR;
#undef PG8_SA
#undef PG8_SB
#undef PG8_STAGE
#undef PG8_LDA
#undef PG8_LDB
#undef PG8_MMA
#undef PG8_WAIT_V
#undef PG8_WAIT_L
#undef PG8_BAR
#undef PG8_SCHED
}

struct SchedDense {
    int nM, nN, nwg, G, c, K; const char* A; const char* Bt;
    __device__ __forceinline__ bool next(int i, Unit& u) const {
        const long L = (long)i * G + c; if (L >= nwg) return false;
        int wgid = (int)L; { const int q = nwg / 8, r = nwg % 8, xcd = wgid % 8, off = wgid / 8; wgid = (xcd < r ? xcd * (q + 1) : r * (q + 1) + (xcd - r) * q) + off; }
        const int nig = 8 * nN, gid = wgid / nig, fm = gid * 8, gsz = (nM - fm) < 8 ? (nM - fm) : 8;
        u.pm = fm + ((wgid % nig) % gsz); u.pn = (wgid % nig) / gsz;
        u.a = A + (size_t)u.pm * 256 * K * 2; u.b = Bt + (size_t)u.pn * 256 * K * 2; return true;
    }
};
struct SchedMoE {
    int ntiles, G, c, K; const LAS int* tex; const char* A; const char* Bt; size_t bstride;
    __device__ __forceinline__ bool next(int i, Unit& u) const {
        const int L = i * G + c; const int rt = L >> 2; if (rt >= ntiles) return false;
        u.pm = rt; u.pn = L & 3; const int e = tex[rt];
        u.a = A + (size_t)rt * 256 * K * 2; u.b = Bt + (size_t)e * bstride + (size_t)u.pn * 256 * K * 2; return true;
    }
};
}

typedef const f32x4 (&AccRef)[2][2][4][2];
struct EpiZ {
    static constexpr bool PERM = true; bf16_t* Z; float* G;
    __device__ __forceinline__ void operator()(AccRef acc, const pg8::Unit& u, int wr, int wc, int fr, int fq) const {
        const int row0 = u.pm * 256 + wr * 64 + fr;
        if (u.pn < 14) {
            const int col0 = u.pn * 256 + wc * 32 + 8 * fq;
#pragma unroll
            for (int ai = 0; ai < 2; ++ai)
#pragma unroll
                for (int m = 0; m < 4; ++m) { bf16_t* rowp = Z + (size_t)(row0 + ai * 128 + m * 16) * ZLD + col0;
#pragma unroll
                    for (int bj = 0; bj < 2; ++bj) { const f32x4 v0 = acc[ai][bj][m][0], v1 = acc[ai][bj][m][1];
                        u32x4 o; o.x = pk2(v0[0], v0[1]); o.y = pk2(v0[2], v0[3]); o.z = pk2(v1[0], v1[1]); o.w = pk2(v1[2], v1[3]);
                        *(u32x4*)(rowp + bj * 128) = o; } }
        } else {
            const int c0 = wc * 32 + 8 * fq;
            if (c0 < 48) {
#pragma unroll
                for (int ai = 0; ai < 2; ++ai)
#pragma unroll
                    for (int m = 0; m < 4; ++m) { float* rowp = G + (size_t)(row0 + ai * 128 + m * 16) * 48 + c0;
                        *(f32x4*)rowp = acc[ai][0][m][0]; *(f32x4*)(rowp + 4) = acc[ai][0][m][1]; }
            }
        }
    }
};
struct EpiX1 {
    static constexpr bool PERM = false; const float* x; const float* mod; float* out; float* pss;
    __device__ __forceinline__ void operator()(AccRef acc, const pg8::Unit& u, int wr, int wc, int fr, int fq) const {
        const int row0 = u.pm * 256 + wr * 64 + fr, col0 = u.pn * 256 + wc * 32 + 4 * fq;
        const float* g1 = mod + (size_t)(u.pm >> 4) * 6144 + 2048;
        f32x4 gv[2][2];
#pragma unroll
        for (int bj = 0; bj < 2; ++bj)
#pragma unroll
            for (int n = 0; n < 2; ++n) gv[bj][n] = *(const f32x4*)(g1 + col0 + bj * 128 + n * 16);
#pragma unroll
        for (int ai = 0; ai < 2; ++ai)
#pragma unroll
            for (int m = 0; m < 4; ++m) { const int row = row0 + ai * 128 + m * 16; const size_t off = (size_t)row * D + col0; float ss = 0.f;
#pragma unroll
                for (int bj = 0; bj < 2; ++bj)
#pragma unroll
                    for (int n = 0; n < 2; ++n) { const f32x4 xv = *(const f32x4*)(x + off + bj * 128 + n * 16);
                        const f32x4 o = xv + gv[bj][n] * acc[ai][bj][m][n];
                        ss += o.x * o.x + o.y * o.y + o.z * o.z + o.w * o.w;
                        *(f32x4*)(out + off + bj * 128 + n * 16) = o; }
                ss += __shfl_xor(ss, 16); ss += __shfl_xor(ss, 32);
                if (fq == 0) pss[(size_t)row * 16 + u.pn * 4 + wc] = ss; }
    }
};
struct EpiH {
    static constexpr bool PERM = true; bf16_t* H;
    __device__ __forceinline__ void operator()(AccRef acc, const pg8::Unit& u, int wr, int wc, int fr, int fq) const {
        const int row0 = u.pm * 256 + wr * 64 + fr, col0 = u.pn * 128 + wc * 32 + 8 * fq;
#pragma unroll
        for (int ai = 0; ai < 2; ++ai)
#pragma unroll
            for (int m = 0; m < 4; ++m) { bf16_t* rowp = H + (size_t)(row0 + ai * 128 + m * 16) * 512 + col0;
                float h[8];
#pragma unroll
                for (int n = 0; n < 2; ++n)
#pragma unroll
                    for (int j = 0; j < 4; ++j) { const float g = acc[ai][0][m][n][j], up = acc[ai][1][m][n][j]; h[n * 4 + j] = siluf(g) * up; }
                u32x4 o; o.x = pk2(h[0], h[1]); o.y = pk2(h[2], h[3]); o.z = pk2(h[4], h[5]); o.w = pk2(h[6], h[7]);
                *(u32x4*)rowp = o; }
    }
};
struct EpiY {
    static constexpr bool PERM = true; bf16_t* Y;
    __device__ __forceinline__ void operator()(AccRef acc, const pg8::Unit& u, int wr, int wc, int fr, int fq) const {
        const int row0 = u.pm * 256 + wr * 64 + fr, col0 = u.pn * 256 + wc * 32 + 8 * fq;
#pragma unroll
        for (int ai = 0; ai < 2; ++ai)
#pragma unroll
            for (int m = 0; m < 4; ++m) { bf16_t* rowp = Y + (size_t)(row0 + ai * 128 + m * 16) * D + col0;
#pragma unroll
                for (int bj = 0; bj < 2; ++bj) { const f32x4 v0 = acc[ai][bj][m][0], v1 = acc[ai][bj][m][1];
                    u32x4 o; o.x = pk2(v0[0], v0[1]); o.y = pk2(v0[2], v0[3]); o.z = pk2(v1[0], v1[1]); o.w = pk2(v1[2], v1[3]);
                    *(u32x4*)(rowp + bj * 128) = o; } }
    }
};

__device__ __forceinline__ void p0_mod_item(const P& p, LAS unsigned char* lds, int item) {
    LAS float* SV = (LAS float*)lds; LAS float* PS = (LAS float*)(lds + 20480);
    const int tid = threadIdx.x;
    for (int i = tid; i < 5 * 1024; i += NTHR) { const int v = i >> 10, k = i & 1023; const float c = v < 4 ? p.in[1][v * 1024 + k] : p.in[3][k]; SV[i] = c / (1.f + expf(-c)); }
    __syncthreads();
    const int col = tid & 31, kq = tid >> 5, n = item * 32 + col;
    float acc[5] = {0.f, 0.f, 0.f, 0.f, 0.f};
    const float* W = p.in[4] + (size_t)(kq * 64) * 6144 + n;
#pragma unroll 8
    for (int k = 0; k < 64; ++k) { const float w = W[(size_t)k * 6144]; const int kk = kq * 64 + k;
#pragma unroll
        for (int v = 0; v < 5; ++v) acc[v] += SV[v * 1024 + kk] * w; }
#pragma unroll
    for (int v = 0; v < 5; ++v) PS[(kq * 5 + v) * 32 + col] = acc[v];
    __syncthreads();
    if (tid < 160) { const int v = tid >> 5, c = tid & 31; float s = 0.f;
#pragma unroll
        for (int q = 0; q < 16; ++q) s += PS[(q * 5 + v) * 32 + c];
        ((float*)(p.ws + WS_MOD))[v * 6144 + item * 32 + c] = s + p.in[5][item * 32 + c]; }
    __syncthreads();
}
template <class RowMap>
__device__ __forceinline__ void transpose_item(const float* W, int K, int N, bf16_t* WT, LAS float* scr, int kb, int nb, int lane, RowMap rm) {
    const int k0 = 64 * kb, n0 = 32 * nb;
#pragma unroll 8
    for (int i = 0; i < 32; ++i) { const int kk = 2 * i + (lane >> 5), n = n0 + (lane & 31); scr[kk * 33 + (lane & 31)] = n < N ? W[(size_t)(k0 + kk) * N + n] : 0.f; }
    asm volatile("s_waitcnt lgkmcnt(0)" ::: "memory");
    const int c = lane & 7;
#pragma unroll
    for (int j = 0; j < 4; ++j) { const int nl = (lane >> 3) + 8 * j, n = n0 + nl;
        if (n < N) { const LAS float* s = scr + (8 * c) * 33 + nl;
            u32x4 o; o.x = pk2(s[0 * 33], s[1 * 33]); o.y = pk2(s[2 * 33], s[3 * 33]); o.z = pk2(s[4 * 33], s[5 * 33]); o.w = pk2(s[6 * 33], s[7 * 33]);
            *(u32x4*)(WT + (size_t)rm(n) * K + k0 + 8 * c) = o; } }
    asm volatile("s_waitcnt lgkmcnt(0)" ::: "memory");
}
struct RmIn { __device__ __forceinline__ int operator()(int n) const { return n < 1536 ? n : (n < 1568 ? n + 2048 : (n < 3616 ? n - 32 : n)); } };
struct RmId { __device__ __forceinline__ int operator()(int n) const { return n; } };
struct RmE1 { __device__ __forceinline__ int operator()(int n) const { const int half = n >> 9, r = n & 511; return (r >> 7) * 256 + half * 128 + (r & 127); } };

__device__ __forceinline__ void phase0(const P& p, LAS unsigned char* lds) {
    const int tid = threadIdx.x, lane = tid & 63, wave = tid >> 6;
    for (int it = blockIdx.x; it < 192; it += gridDim.x) p0_mod_item(p, lds, it);
    LAS float* scr = (LAS float*)(lds + wave * 16384);
    const int gw = blockIdx.x * 8 + wave, NGW = gridDim.x * 8;
    constexpr int I_IN = 16 * 114, I_OUT = 16 * 32, I_E1 = 32 * 16 * 32, I_E2 = 32 * 8 * 32, NIT = I_IN + I_OUT + I_E1 + I_E2;
    bf16_t* WINT = (bf16_t*)(p.ws + WS_WINT); bf16_t* WOUTT = (bf16_t*)(p.ws + WS_WOUTT); bf16_t* E1T = (bf16_t*)(p.ws + WS_E1T); bf16_t* E2T = (bf16_t*)(p.ws + WS_E2T);
    for (int it = gw; it < NIT; it += NGW) {
        int r = it;
        if (r < I_IN) { transpose_item(p.in[7], 1024, INW, WINT, scr, r / 114, r % 114, lane, RmIn()); continue; } r -= I_IN;
        if (r < I_OUT) { transpose_item(p.in[16], 1024, 1024, WOUTT, scr, r >> 5, r & 31, lane, RmId()); continue; } r -= I_OUT;
        if (r < I_E1) { const int e = r >> 9, q = r & 511; transpose_item(p.in[22] + (size_t)e * 1024 * 1024, 1024, 1024, E1T + (size_t)e * 1024 * 1024, scr, q >> 5, q & 31, lane, RmE1()); continue; } r -= I_E1;
        { const int e = r >> 8, q = r & 255; transpose_item(p.in[23] + (size_t)e * 512 * 1024, 512, 1024, E2T + (size_t)e * 1024 * 512, scr, q >> 5, q & 31, lane, RmId()); }
    }
    for (int i = blockIdx.x * NTHR + tid; i < 208 * 128; i += gridDim.x * NTHR) ((u32x4*)(WINT + (size_t)INW * 1024))[i] = (u32x4){0u, 0u, 0u, 0u};
}

__device__ __forceinline__ void phase1(const P& p) {
    const int tid = threadIdx.x, lane = tid & 63, wave = tid >> 6;
    const float* mod = (const float*)(p.ws + WS_MOD); bf16_t* A = (bf16_t*)(p.ws + WS_A);
    const int gw = blockIdx.x * 8 + wave, NGW = gridDim.x * 8;
    for (int row = gw; row < MT; row += NGW) {
        const float* src = row < MX ? p.in[0] + (size_t)row * D : p.in[2] + (size_t)(row - MX) * D;
        const float* mv = mod + (size_t)(row < MX ? (row >> 12) : 4) * 6144;
        f32x4 v[4]; float ss = 0.f;
#pragma unroll
        for (int j = 0; j < 4; ++j) { v[j] = *(const f32x4*)(src + 4 * lane + 256 * j); ss += v[j].x * v[j].x + v[j].y * v[j].y + v[j].z * v[j].z + v[j].w * v[j].w; }
        const float rstd = 1.f / sqrtf(wave_sum(ss) * (1.f / D) + EPS);
#pragma unroll
        for (int j = 0; j < 4; ++j) { const int k = 4 * lane + 256 * j;
            const f32x4 g = *(const f32x4*)(p.in[6] + k), sh = *(const f32x4*)(mv + k), sc = *(const f32x4*)(mv + 1024 + k);
            const f32x4 o = (v[j] * rstd * g) * (sc + 1.f) + sh;
            u32x2 w; w.x = pk2(o.x, o.y); w.y = pk2(o.z, o.w);
            *(u32x2*)(A + (size_t)row * D + k) = w; }
    }
}

__device__ __forceinline__ void phase3(const P& p) {
    const bf16_t* Z = (const bf16_t*)(p.ws + WS_Z); bf16_t* MQ = (bf16_t*)(p.ws + WS_MQ); bf16_t* MK = (bf16_t*)(p.ws + WS_MK);
    const int tid = threadIdx.x, cg8 = tid & 127, tl = tid >> 7, ch0 = cg8 * 8;
    float w[9][8], bias[8];
#pragma unroll
    for (int a = 0; a < 9; ++a)
#pragma unroll
        for (int j = 0; j < 8; ++j) w[a][j] = p.in[11][a * 1024 + ch0 + j];
#pragma unroll
    for (int j = 0; j < 8; ++j) bias[j] = p.in[12][ch0 + j];
    const float osc = ch0 >= 512 ? 0.08838834764831845f : 1.f;
    bf16_t* dst = ch0 >= 512 ? MK : MQ;
    for (int it = blockIdx.x; it < 272; it += gridDim.x) {
        int rowbase, y, Hh, Ww, x0;
        if (it < 256) { rowbase = (it >> 6) * 4096; y = it & 63; Hh = 64; Ww = 64; x0 = 0; }
        else { const int ci = it - 256; rowbase = MX + (ci >> 2) * 256; y = 0; Hh = 1; Ww = 256; x0 = (ci & 3) * 64; }
        for (int i = 0; i < 16; ++i) {
            const int x = x0 + tl + 4 * i;
            float acc[8];
#pragma unroll
            for (int j = 0; j < 8; ++j) acc[j] = bias[j];
#pragma unroll
            for (int dy = 0; dy < 3; ++dy) { const int yy = y + dy - 1; if (yy < 0 || yy >= Hh) continue;
#pragma unroll
                for (int dx = 0; dx < 3; ++dx) { const int xx = x + dx - 1; if (xx < 0 || xx >= Ww) continue;
                    const u32x4 v = *(const u32x4*)(Z + (size_t)(rowbase + yy * Ww + xx) * ZLD + 1536 + ch0);
                    acc[0] += w[dy * 3 + dx][0] * bflo(v.x); acc[1] += w[dy * 3 + dx][1] * bfhi(v.x);
                    acc[2] += w[dy * 3 + dx][2] * bflo(v.y); acc[3] += w[dy * 3 + dx][3] * bfhi(v.y);
                    acc[4] += w[dy * 3 + dx][4] * bflo(v.z); acc[5] += w[dy * 3 + dx][5] * bfhi(v.z);
                    acc[6] += w[dy * 3 + dx][6] * bflo(v.w); acc[7] += w[dy * 3 + dx][7] * bfhi(v.w); } }
#pragma unroll
            for (int j = 0; j < 8; ++j) acc[j] = siluf(acc[j]) * osc;
            u32x4 o; o.x = pk2(acc[0], acc[1]); o.y = pk2(acc[2], acc[3]); o.z = pk2(acc[4], acc[5]); o.w = pk2(acc[6], acc[7]);
            *(u32x4*)(dst + (size_t)(rowbase + y * Ww + x) * 512 + (ch0 & 511)) = o;
        }
    }
}

__device__ __forceinline__ int chunk_tok0(int b, int tc) { return tc < 64 ? b * SEQ + tc * 64 : MX + b * CTXL + (tc - 64) * 64; }

__device__ __forceinline__ void load_vt(const bf16_t* Z, int tok0, int col0, LAS bf16_t* VT, int tid) {
#pragma unroll
    for (int i = 0; i < 2; ++i) { const int idx = tid + NTHR * i, t = idx >> 4, c = idx & 15;
        const u32x4 v = *(const u32x4*)(Z + (size_t)(tok0 + t) * ZLD + col0 + c * 8);
        LAS bf16_t* d = VT + (c * 8) * 72 + t;
        d[0 * 72] = (bf16_t)(v.x & 0xffff); d[1 * 72] = (bf16_t)(v.x >> 16); d[2 * 72] = (bf16_t)(v.y & 0xffff); d[3 * 72] = (bf16_t)(v.y >> 16);
        d[4 * 72] = (bf16_t)(v.z & 0xffff); d[5 * 72] = (bf16_t)(v.z >> 16); d[6 * 72] = (bf16_t)(v.w & 0xffff); d[7 * 72] = (bf16_t)(v.w >> 16); }
}

__device__ __forceinline__ void p4_gla(const P& p, LAS unsigned char* lds, int b, int h, int tc) {
    const int tid = threadIdx.x, lane = tid & 63, wave = __builtin_amdgcn_readfirstlane(tid >> 6);
    const bf16_t* Z = (const bf16_t*)(p.ws + WS_Z); const float* GT = (const float*)(p.ws + WS_GATES);
    const int tok0 = chunk_tok0(b, tc), sidx = (b * 4 + h) * NCH + tc;
    LAS bf16_t* VT = (LAS bf16_t*)lds; LAS bf16_t* KT = (LAS bf16_t*)(lds + 18432); LAS float* GLR = (LAS float*)(lds + 36864); LAS float* QS = (LAS float*)(lds + 45056);
    load_vt(Z, tok0, 512 + h * 128, VT, tid);
    { const int t = tid >> 3, c4 = tid & 7; *(LAS f32x4*)(GLR + t * 32 + c4 * 4) = *(const f32x4*)(GT + (size_t)(tok0 + t) * 48 + c4 * 4); }
    __syncthreads();
    const int dir = tid >> 8, tq = (tid >> 6) & 3, d = tid & 63;
    float upw[16];
#pragma unroll
    for (int r = 0; r < 16; ++r) upw[r] = p.in[8][(dir * 16 + r) * 256 + h * 64 + d];
    const float upb = p.in[9][dir * 256 + h * 64 + d];
    float la[16]; float tot = 0.f;
#pragma unroll
    for (int i = 0; i < 16; ++i) { const int t = tq * 16 + i; float lg = upb;
#pragma unroll
        for (int r = 0; r < 16; ++r) lg += GLR[t * 32 + dir * 16 + r] * upw[r];
        la[i] = logsigf(lg) * 0.0625f; tot += la[i]; }
    QS[(dir * 4 + tq) * 64 + d] = tot;
    __syncthreads();
    float before = 0.f, all = 0.f;
#pragma unroll
    for (int q = 0; q < 4; ++q) { const float v = QS[(dir * 4 + q) * 64 + d]; all += v; before += (q < tq) ? v : 0.f; }
    float run = before;
#pragma unroll
    for (int i = 0; i < 16; ++i) { const int t = tq * 16 + i;
        const float kx = bf2f(Z[(size_t)(tok0 + t) * ZLD + 256 + h * 64 + d]);
        float e; if (dir == 0) { run += la[i]; e = all - run; } else { e = run; run += la[i]; }
        KT[(dir * 64 + d) * 72 + t] = (bf16_t)f2bf(kx * __expf(e)); }
    if (tq == 0) ((float*)(p.ws + WS_GDEC))[(sidx * 2 + dir) * 64 + d] = __expf(all);
    __syncthreads();
    const int dw = wave >> 2, vt = wave & 3;
    f32x16 acc0, acc1;
#pragma unroll
    for (int r = 0; r < 16; ++r) { acc0[r] = 0.f; acc1[r] = 0.f; }
#pragma unroll
    for (int ks = 0; ks < 4; ++ks) { const bf16x8 a = ldfrag(VT, 72, vt * 32, ks * 16, lane);
        const bf16x8 b0 = ldfrag(KT + dw * 64 * 72, 72, 0, ks * 16, lane), b1 = ldfrag(KT + dw * 64 * 72, 72, 32, ks * 16, lane);
        acc0 = MFMA32(a, b0, acc0); acc1 = MFMA32(a, b1, acc1); }
    bf16_t* U = (bf16_t*)(p.ws + WS_UG) + (size_t)(sidx * 2 + dw) * 8192;
#pragma unroll
    for (int r = 0; r < 16; ++r) { const int v = vt * 32 + crow(r, lane); U[v * 64 + (lane & 31)] = (bf16_t)f2bf(acc0[r]); U[v * 64 + 32 + (lane & 31)] = (bf16_t)f2bf(acc1[r]); }
    __syncthreads();
}

__device__ __forceinline__ void load_ml_gates(const P& p, int tok0, int h, LAS float* IG, LAS float* LF, int tid) {
    if (tid < 128) { const int dir = tid >> 6, t = tid & 63; const float* g = (const float*)(p.ws + WS_GATES) + (size_t)(tok0 + t) * 48;
        IG[dir * 64 + t] = g[32 + dir * 4 + h] + p.in[13][dir * 4 + h];
        LF[dir * 64 + t] = logsigf(g[40 + dir * 4 + h] + p.in[14][dir * 4 + h]); }
}

__device__ __forceinline__ void p4_ml(const P& p, LAS unsigned char* lds, int b, int h, int tc) {
    const int tid = threadIdx.x, lane = tid & 63, wave = __builtin_amdgcn_readfirstlane(tid >> 6);
    const bf16_t* Z = (const bf16_t*)(p.ws + WS_Z); const bf16_t* MK = (const bf16_t*)(p.ws + WS_MK);
    const int tok0 = chunk_tok0(b, tc), sidx = (b * 4 + h) * NCH + tc;
    LAS bf16_t* VT = (LAS bf16_t*)lds; LAS bf16_t* KT = (LAS bf16_t*)(lds + 18432);
    LAS float* IG = (LAS float*)(lds + 55296); LAS float* LF = IG + 128; LAS float* KW = IG + 256;
    load_vt(Z, tok0, 2560 + h * 128, VT, tid);
    load_ml_gates(p, tok0, h, IG, LF, tid);
    __syncthreads();
    if (tid < 128) { const int dir = tid >> 6, t = tid & 63;
        const float lf = LF[dir * 64 + t], a = scan_sum_up(lf, t), tot = __shfl(a, 63);
        const float g = (dir == 0 ? tot - a : a - lf) + IG[dir * 64 + t];
        const float ml = wave_max(g);
        KW[dir * 64 + t] = __expf(g - ml);
        if (t == 0) { float* sc = (float*)(p.ws + WS_MSC) + (size_t)(sidx * 2 + dir) * 4; sc[0] = tot; sc[1] = ml; } }
    __syncthreads();
    { const int dir = tid >> 8, th = (tid >> 7) & 1, d = tid & 127;
#pragma unroll 8
        for (int i = 0; i < 32; ++i) { const int t = th * 32 + i; const float kx = bf2f(MK[(size_t)(tok0 + t) * 512 + h * 128 + d]);
            KT[(dir * 128 + d) * 72 + t] = (bf16_t)f2bf(kx * KW[dir * 64 + t]); } }
    __syncthreads();
    if (tid < 256) { const int dir = tid >> 7, d = tid & 127; float s = 0.f;
        for (int t = 0; t < 64; ++t) s += bf2f(KT[(dir * 128 + d) * 72 + t]);
        ((float*)(p.ws + WS_MN))[(size_t)(sidx * 2 + dir) * 128 + d] = s; }
    const int dw = wave >> 2, vt = wave & 3;
    f32x16 acc[4];
#pragma unroll
    for (int q = 0; q < 4; ++q)
#pragma unroll
        for (int r = 0; r < 16; ++r) acc[q][r] = 0.f;
#pragma unroll
    for (int ks = 0; ks < 4; ++ks) { const bf16x8 a = ldfrag(VT, 72, vt * 32, ks * 16, lane);
#pragma unroll
        for (int q = 0; q < 4; ++q) { const bf16x8 bq = ldfrag(KT + dw * 128 * 72, 72, q * 32, ks * 16, lane); acc[q] = MFMA32(a, bq, acc[q]); } }
    bf16_t* U = (bf16_t*)(p.ws + WS_UM) + (size_t)(sidx * 2 + dw) * 16384;
#pragma unroll
    for (int q = 0; q < 4; ++q)
#pragma unroll
        for (int r = 0; r < 16; ++r) { const int v = vt * 32 + crow(r, lane); U[v * 128 + q * 32 + (lane & 31)] = (bf16_t)f2bf(acc[q][r]); }
    __syncthreads();
}

__device__ __forceinline__ void phase4(const P& p, LAS unsigned char* lds) {
    for (int it = blockIdx.x; it < 2 * NSTATE; it += gridDim.x) {
        const int ty = it / NSTATE, r = it % NSTATE, b = r / (4 * NCH), h = (r / NCH) & 3, tc = r % NCH;
        if (ty == 0) p4_gla(p, lds, b, h, tc); else p4_ml(p, lds, b, h, tc);
    }
}

__device__ __forceinline__ int tc_of(int c, int dir) { return dir == 0 ? (c < 4 ? 64 + c : c - 4) : (c < 4 ? 67 - c : 67 - c); }

__device__ __forceinline__ void phase5(const P& p) {
    const int gtid = blockIdx.x * NTHR + threadIdx.x, nthr = gridDim.x * NTHR;
    constexpr int PF = 8;
    for (int task = gtid; task < 32768 + 65536 + 512; task += nthr) {
        if (task < 32768) {
            const int chain = task >> 10, e8 = task & 1023, bh = chain >> 1, dir = chain & 1, d0 = (e8 & 7) * 8;
            bf16_t* UG = (bf16_t*)(p.ws + WS_UG); const float* GD = (const float*)(p.ws + WS_GDEC);
            float s[8];
#pragma unroll
            for (int j = 0; j < 8; ++j) s[j] = 0.f;
            u32x4 ub[PF]; f32x4 da[PF], db[PF];
#pragma unroll
            for (int i = 0; i < PF; ++i) { const int si = (bh * NCH + tc_of(i, dir)) * 2 + dir;
                ub[i] = *(const u32x4*)(UG + (size_t)si * 8192 + e8 * 8); da[i] = *(const f32x4*)(GD + si * 64 + d0); db[i] = *(const f32x4*)(GD + si * 64 + d0 + 4); }
            for (int c0 = 0; c0 < NCH; c0 += PF) {
#pragma unroll
                for (int i = 0; i < PF; ++i) { const int c = c0 + i; if (c < NCH) { const int si = (bh * NCH + tc_of(c, dir)) * 2 + dir;
                    const u32x4 u = ub[i]; const f32x4 a = da[i], bq = db[i];
                    if (c + PF < NCH) { const int sn = (bh * NCH + tc_of(c + PF, dir)) * 2 + dir;
                        ub[i] = *(const u32x4*)(UG + (size_t)sn * 8192 + e8 * 8); da[i] = *(const f32x4*)(GD + sn * 64 + d0); db[i] = *(const f32x4*)(GD + sn * 64 + d0 + 4); }
                    u32x4 o; o.x = pk2(s[0], s[1]); o.y = pk2(s[2], s[3]); o.z = pk2(s[4], s[5]); o.w = pk2(s[6], s[7]);
                    *(u32x4*)(UG + (size_t)si * 8192 + e8 * 8) = o;
                    s[0] = a.x * s[0] + bflo(u.x); s[1] = a.y * s[1] + bfhi(u.x); s[2] = a.z * s[2] + bflo(u.y); s[3] = a.w * s[3] + bfhi(u.y);
                    s[4] = bq.x * s[4] + bflo(u.z); s[5] = bq.y * s[5] + bfhi(u.z); s[6] = bq.z * s[6] + bflo(u.w); s[7] = bq.w * s[7] + bfhi(u.w); } }
            }
        } else if (task < 98304) {
            const int tk = task - 32768, chain = tk >> 11, e8 = tk & 2047, bh = chain >> 1, dir = chain & 1;
            bf16_t* UM = (bf16_t*)(p.ws + WS_UM); float* SC = (float*)(p.ws + WS_MSC);
            float s[8];
#pragma unroll
            for (int j = 0; j < 8; ++j) s[j] = 0.f;
            float m = 0.f;
            u32x4 ub[PF]; float ae[PF], ml[PF];
#pragma unroll
            for (int i = 0; i < PF; ++i) { const int si = (bh * NCH + tc_of(i, dir)) * 2 + dir;
                ub[i] = *(const u32x4*)(UM + (size_t)si * 16384 + e8 * 8); ae[i] = SC[si * 4 + 0]; ml[i] = SC[si * 4 + 1]; }
            for (int c0 = 0; c0 < NCH; c0 += PF) {
#pragma unroll
                for (int i = 0; i < PF; ++i) { const int c = c0 + i; if (c < NCH) { const int si = (bh * NCH + tc_of(c, dir)) * 2 + dir;
                    const u32x4 u = ub[i]; const float aend = ae[i], mloc = ml[i];
                    if (c + PF < NCH) { const int sn = (bh * NCH + tc_of(c + PF, dir)) * 2 + dir;
                        ub[i] = *(const u32x4*)(UM + (size_t)sn * 16384 + e8 * 8); ae[i] = SC[sn * 4 + 0]; ml[i] = SC[sn * 4 + 1]; }
                    u32x4 o; o.x = pk2(s[0], s[1]); o.y = pk2(s[2], s[3]); o.z = pk2(s[4], s[5]); o.w = pk2(s[6], s[7]);
                    *(u32x4*)(UM + (size_t)si * 16384 + e8 * 8) = o;
                    if (e8 == 0) SC[si * 4 + 2] = m;
                    const float mn = fmaxf(aend + m, mloc), f1 = __expf(aend + m - mn), f2 = __expf(mloc - mn); m = mn;
                    s[0] = f1 * s[0] + f2 * bflo(u.x); s[1] = f1 * s[1] + f2 * bfhi(u.x); s[2] = f1 * s[2] + f2 * bflo(u.y); s[3] = f1 * s[3] + f2 * bfhi(u.y);
                    s[4] = f1 * s[4] + f2 * bflo(u.z); s[5] = f1 * s[5] + f2 * bfhi(u.z); s[6] = f1 * s[6] + f2 * bflo(u.w); s[7] = f1 * s[7] + f2 * bfhi(u.w); } }
            }
        } else {
            const int tk = task - 98304, chain = tk >> 4, part = tk & 15, bh = chain >> 1, dir = chain & 1;
            float* MN = (float*)(p.ws + WS_MN); const float* SC = (const float*)(p.ws + WS_MSC);
            f32x4 n0 = {0.f, 0.f, 0.f, 0.f}, n1 = {0.f, 0.f, 0.f, 0.f}; float m = 0.f;
            f32x4 p0[PF], p1[PF]; float ae[PF], ml[PF];
#pragma unroll
            for (int i = 0; i < PF; ++i) { const int si = (bh * NCH + tc_of(i, dir)) * 2 + dir; const float* np = MN + (size_t)si * 128 + part * 8;
                p0[i] = *(const f32x4*)np; p1[i] = *(const f32x4*)(np + 4); ae[i] = SC[si * 4 + 0]; ml[i] = SC[si * 4 + 1]; }
            for (int c0 = 0; c0 < NCH; c0 += PF) {
#pragma unroll
                for (int i = 0; i < PF; ++i) { const int c = c0 + i; if (c < NCH) { const int si = (bh * NCH + tc_of(c, dir)) * 2 + dir;
                    const f32x4 u0 = p0[i], u1 = p1[i]; const float aend = ae[i], mloc = ml[i];
                    if (c + PF < NCH) { const int sn = (bh * NCH + tc_of(c + PF, dir)) * 2 + dir; const float* nq = MN + (size_t)sn * 128 + part * 8;
                        p0[i] = *(const f32x4*)nq; p1[i] = *(const f32x4*)(nq + 4); ae[i] = SC[sn * 4 + 0]; ml[i] = SC[sn * 4 + 1]; }
                    float* np = MN + (size_t)si * 128 + part * 8;
                    *(f32x4*)np = n0; *(f32x4*)(np + 4) = n1;
                    const float mn = fmaxf(aend + m, mloc), f1 = __expf(aend + m - mn), f2 = __expf(mloc - mn); m = mn;
                    n0 = n0 * f1 + u0 * f2; n1 = n1 * f1 + u1 * f2; } }
            }
        }
    }
}

template <bool SIG>
__device__ __forceinline__ void head_norm_store(const P& p, const LAS float* O, int tok0, int h, int zgate_col, const float* gain, int mixcol, int tid) {
    const bf16_t* Z = (const bf16_t*)(p.ws + WS_Z); bf16_t* MIX = (bf16_t*)(p.ws + WS_A);
    const int t = tid >> 3, seg = tid & 7;
    float o[16]; float ss = 0.f;
#pragma unroll
    for (int j = 0; j < 16; ++j) { o[j] = O[t * 132 + seg * 16 + j]; ss += o[j] * o[j]; }
    ss += __shfl_xor(ss, 1); ss += __shfl_xor(ss, 2); ss += __shfl_xor(ss, 4);
    const float rstd = 1.f / sqrtf(ss * (1.f / 128.f) + EPS);
    const u32x4 g0 = *(const u32x4*)(Z + (size_t)(tok0 + t) * ZLD + zgate_col + h * 128 + seg * 16), g1 = *(const u32x4*)(Z + (size_t)(tok0 + t) * ZLD + zgate_col + h * 128 + seg * 16 + 8);
    float gt[16];
    gt[0] = bflo(g0.x); gt[1] = bfhi(g0.x); gt[2] = bflo(g0.y); gt[3] = bfhi(g0.y); gt[4] = bflo(g0.z); gt[5] = bfhi(g0.z); gt[6] = bflo(g0.w); gt[7] = bfhi(g0.w);
    gt[8] = bflo(g1.x); gt[9] = bfhi(g1.x); gt[10] = bflo(g1.y); gt[11] = bfhi(g1.y); gt[12] = bflo(g1.z); gt[13] = bfhi(g1.z); gt[14] = bflo(g1.w); gt[15] = bfhi(g1.w);
    float r[16];
#pragma unroll
    for (int j = 0; j < 16; ++j) { const float gg = SIG ? sigmf(gt[j]) : siluf(gt[j]); r[j] = o[j] * rstd * gain[h * 128 + seg * 16 + j] * gg; }
    u32x4 w0, w1; w0.x = pk2(r[0], r[1]); w0.y = pk2(r[2], r[3]); w0.z = pk2(r[4], r[5]); w0.w = pk2(r[6], r[7]);
    w1.x = pk2(r[8], r[9]); w1.y = pk2(r[10], r[11]); w1.z = pk2(r[12], r[13]); w1.w = pk2(r[14], r[15]);
    bf16_t* dst = MIX + (size_t)(tok0 + t) * D + mixcol + h * 128 + seg * 16;
    *(u32x4*)dst = w0; *(u32x4*)(dst + 8) = w1;
}

__device__ __forceinline__ void p6_gla(const P& p, LAS unsigned char* lds, int b, int h, int j) {
    const int tid = threadIdx.x, lane = tid & 63, wave = __builtin_amdgcn_readfirstlane(tid >> 6);
    const bf16_t* Z = (const bf16_t*)(p.ws + WS_Z); const float* GT = (const float*)(p.ws + WS_GATES);
    const int tok0 = b * SEQ + j * 64, sidx = (b * 4 + h) * NCH + j;
    LAS bf16_t* QF = (LAS bf16_t*)lds; LAS bf16_t* QB = QF + 64 * 72; LAS bf16_t* KF = QB + 64 * 72; LAS bf16_t* KB = KF + 64 * 72;
    LAS bf16_t* VT = (LAS bf16_t*)(lds + 36864); LAS bf16_t* ST = (LAS bf16_t*)(lds + 55296); LAS bf16_t* PF = (LAS bf16_t*)(lds + 92160); LAS bf16_t* PB = PF + 64 * 72;
    LAS float* GLR = (LAS float*)(lds + 110592); LAS float* QS = (LAS float*)(lds + 118784); LAS float* O = (LAS float*)lds;
    load_vt(Z, tok0, 512 + h * 128, VT, tid);
    { const bf16_t* S = (const bf16_t*)(p.ws + WS_UG) + (size_t)(sidx * 2) * 8192;
#pragma unroll
        for (int i = 0; i < 4; ++i) { const int idx = tid + NTHR * i, row = idx >> 3, c = idx & 7;
            *(LAS u32x4*)(ST + row * 72 + c * 8) = *(const u32x4*)(S + (size_t)row * 64 + c * 8); } }
    { const int t = tid >> 3, c4 = tid & 7; *(LAS f32x4*)(GLR + t * 32 + c4 * 4) = *(const f32x4*)(GT + (size_t)(tok0 + t) * 48 + c4 * 4); }
    __syncthreads();
    const int dir = tid >> 8, tq = (tid >> 6) & 3, d = tid & 63;
    {
        float upw[16];
#pragma unroll
        for (int r = 0; r < 16; ++r) upw[r] = p.in[8][(dir * 16 + r) * 256 + h * 64 + d];
        const float upb = p.in[9][dir * 256 + h * 64 + d];
        float la[16]; float tot = 0.f;
#pragma unroll
        for (int i = 0; i < 16; ++i) { const int t = tq * 16 + i; float lg = upb;
#pragma unroll
            for (int r = 0; r < 16; ++r) lg += GLR[t * 32 + dir * 16 + r] * upw[r];
            la[i] = logsigf(lg) * 0.0625f; tot += la[i]; }
        QS[(dir * 4 + tq) * 64 + d] = tot;
        __syncthreads();
        float before = 0.f, all = 0.f;
#pragma unroll
        for (int q = 0; q < 4; ++q) { const float v = QS[(dir * 4 + q) * 64 + d]; all += v; before += (q < tq) ? v : 0.f; }
        float run = before;
        LAS bf16_t* Qd = dir == 0 ? QF : QB; LAS bf16_t* Kd = dir == 0 ? KF : KB;
#pragma unroll
        for (int i = 0; i < 16; ++i) { const int t = tq * 16 + i;
            const float qx = bf2f(Z[(size_t)(tok0 + t) * ZLD + h * 64 + d]) * 0.125f, kx = bf2f(Z[(size_t)(tok0 + t) * ZLD + 256 + h * 64 + d]);
            float bb; if (dir == 0) { run += la[i]; bb = run; } else { bb = all - run; run += la[i]; }
            const float eb = __expf(bb);
            Qd[t * 72 + d] = (bf16_t)f2bf(qx * eb); Kd[t * 72 + d] = (bf16_t)f2bf(kx / eb); }
    }
    __syncthreads();
    {
        const int dw = wave >> 2, tt = (wave >> 1) & 1, st = wave & 1;
        const LAS bf16_t* Qd = dw == 0 ? QF : QB; const LAS bf16_t* Kd = dw == 0 ? KF : KB; LAS bf16_t* Pd = dw == 0 ? PF : PB;
        f32x16 acc;
#pragma unroll
        for (int r = 0; r < 16; ++r) acc[r] = 0.f;
#pragma unroll
        for (int ks = 0; ks < 4; ++ks) acc = MFMA32(ldfrag(Qd, 72, tt * 32, ks * 16, lane), ldfrag(Kd, 72, st * 32, ks * 16, lane), acc);
        const int s = st * 32 + (lane & 31);
#pragma unroll
        for (int r = 0; r < 16; ++r) { const int t = tt * 32 + crow(r, lane); const bool ok = dw == 0 ? (s <= t) : (s >= t);
            Pd[t * 72 + s] = (bf16_t)f2bf(ok ? acc[r] : 0.f); }
    }
    __syncthreads();
    const int tt = wave >> 2, vt = wave & 3;
    f32x16 acc;
#pragma unroll
    for (int r = 0; r < 16; ++r) acc[r] = 0.f;
#pragma unroll
    for (int ks = 0; ks < 4; ++ks) { const bf16x8 vb = ldfrag(VT, 72, vt * 32, ks * 16, lane);
        acc = MFMA32(ldfrag(PF, 72, tt * 32, ks * 16, lane), vb, acc); acc = MFMA32(ldfrag(PB, 72, tt * 32, ks * 16, lane), vb, acc); }
#pragma unroll
    for (int ks = 0; ks < 4; ++ks) { acc = MFMA32(ldfrag(QF, 72, tt * 32, ks * 16, lane), ldfrag(ST, 72, vt * 32, ks * 16, lane), acc);
        acc = MFMA32(ldfrag(QB, 72, tt * 32, ks * 16, lane), ldfrag(ST + 128 * 72, 72, vt * 32, ks * 16, lane), acc); }
    __syncthreads();
#pragma unroll
    for (int r = 0; r < 16; ++r) O[(tt * 32 + crow(r, lane)) * 132 + vt * 32 + (lane & 31)] = acc[r];
    __syncthreads();
    head_norm_store<false>(p, O, tok0, h, 1024, p.in[10], 0, tid);
    __syncthreads();
}

__device__ __forceinline__ void p6_ml(const P& p, LAS unsigned char* lds, int b, int h, int j) {
    const int tid = threadIdx.x, lane = tid & 63, wave = __builtin_amdgcn_readfirstlane(tid >> 6);
    const bf16_t* Z = (const bf16_t*)(p.ws + WS_Z); const bf16_t* MQ = (const bf16_t*)(p.ws + WS_MQ); const bf16_t* MK = (const bf16_t*)(p.ws + WS_MK);
    const int tok0 = b * SEQ + j * 64, sidx = (b * 4 + h) * NCH + j;
    LAS bf16_t* Q = (LAS bf16_t*)lds; LAS bf16_t* K = (LAS bf16_t*)(lds + 17408); LAS bf16_t* VT = (LAS bf16_t*)(lds + 34816); LAS bf16_t* ST = (LAS bf16_t*)(lds + 53248);
    LAS bf16_t* PF = (LAS bf16_t*)(lds + 122880); LAS bf16_t* PB = PF + 64 * 72; LAS float* SM = (LAS float*)(lds + 141312); LAS float* O = (LAS float*)lds;
    LAS float* IG = SM; LAS float* LF = SM + 128; LAS float* CT = SM + 256; LAS float* RT = SM + 384; LAS float* WT = SM + 512; LAS float* ET = SM + 640;
    LAS float* NV = SM + 768;
    LAS float* INV = SM + 1024;
    LAS float* MS = SM + 1152;
#pragma unroll
    for (int i = 0; i < 2; ++i) { const int idx = tid + NTHR * i, t = idx >> 4, c = idx & 15;
        *(LAS u32x4*)(Q + t * 136 + c * 8) = *(const u32x4*)(MQ + (size_t)(tok0 + t) * 512 + h * 128 + c * 8);
        *(LAS u32x4*)(K + t * 136 + c * 8) = *(const u32x4*)(MK + (size_t)(tok0 + t) * 512 + h * 128 + c * 8); }
    load_vt(Z, tok0, 2560 + h * 128, VT, tid);
    { const bf16_t* S = (const bf16_t*)(p.ws + WS_UM) + (size_t)(sidx * 2) * 16384;
#pragma unroll
        for (int i = 0; i < 8; ++i) { const int idx = tid + NTHR * i, row = idx >> 4, c = idx & 15;
            *(LAS u32x4*)(ST + row * 136 + c * 8) = *(const u32x4*)(S + (size_t)row * 128 + c * 8); } }
    load_ml_gates(p, tok0, h, IG, LF, tid);
    if (tid >= 128 && tid < 384) { const int q = tid - 128; NV[q] = ((const float*)(p.ws + WS_MN))[(size_t)(sidx * 2) * 128 + q]; }
    if (tid >= 384 && tid < 386) { const int dir = tid - 384; MS[dir] = ((const float*)(p.ws + WS_MSC))[(size_t)(sidx * 2 + dir) * 4 + 2]; }
    __syncthreads();
    if (tid < 64) {
        const int t = tid; const float ms = MS[0], a = scan_sum_up(LF[t], t), c = IG[t] - a, pm = scan_max_up(c, t), mt = a + fmaxf(ms, pm);
        CT[t] = c; RT[t] = a - mt; WT[t] = __expf(a + ms - mt); ET[t] = __expf(-mt);
    } else if (tid < 128) {
        const int t = tid - 64; const float ms = MS[1], a = scan_sum_down(LF[64 + t], t), c = IG[64 + t] - a, pm = scan_max_down(c, t), mt = a + fmaxf(ms, pm);
        CT[64 + t] = c; RT[64 + t] = a - mt; WT[64 + t] = __expf(a + ms - mt); ET[64 + t] = __expf(-mt);
    }
    __syncthreads();
    {
        const int dw = wave >> 2, tt = (wave >> 1) & 1, st = wave & 1; LAS bf16_t* Pd = dw == 0 ? PF : PB;
        f32x16 acc;
#pragma unroll
        for (int r = 0; r < 16; ++r) acc[r] = 0.f;
#pragma unroll
        for (int ks = 0; ks < 8; ++ks) acc = MFMA32(ldfrag(Q, 136, tt * 32, ks * 16, lane), ldfrag(K, 136, st * 32, ks * 16, lane), acc);
        const int s = st * 32 + (lane & 31); const float cs = CT[dw * 64 + s];
#pragma unroll
        for (int r = 0; r < 16; ++r) { const int t = tt * 32 + crow(r, lane); const bool ok = dw == 0 ? (s <= t) : (s >= t);
            const float wgt = __expf(fminf(RT[dw * 64 + t] + cs, 0.f));
            Pd[t * 72 + s] = (bf16_t)f2bf(ok ? acc[r] * wgt : 0.f); }
    }
    __syncthreads();
    {
        const int t = tid >> 3, seg = tid & 7;
        float rs0 = 0.f, rs1 = 0.f, qn0 = 0.f, qn1 = 0.f;
#pragma unroll
        for (int i = 0; i < 8; ++i) { rs0 += bf2f(PF[t * 72 + seg * 8 + i]); rs1 += bf2f(PB[t * 72 + seg * 8 + i]); }
#pragma unroll
        for (int i = 0; i < 16; ++i) { const float qv = bf2f(Q[t * 136 + seg * 16 + i]); qn0 += qv * NV[seg * 16 + i]; qn1 += qv * NV[128 + seg * 16 + i]; }
#pragma unroll
        for (int o = 1; o < 8; o <<= 1) { rs0 += __shfl_xor(rs0, o); rs1 += __shfl_xor(rs1, o); qn0 += __shfl_xor(qn0, o); qn1 += __shfl_xor(qn1, o); }
        if (seg == 0) { const float d0 = rs0 + WT[t] * qn0, d1 = rs1 + WT[64 + t] * qn1;
            INV[t] = 1.f / fmaxf(fabsf(d0), ET[t]); INV[64 + t] = 1.f / fmaxf(fabsf(d1), ET[64 + t]); }
    }
    const int tt = wave >> 2, vt = wave & 3;
    f32x16 apf, apb, aqf, aqb;
#pragma unroll
    for (int r = 0; r < 16; ++r) { apf[r] = 0.f; apb[r] = 0.f; aqf[r] = 0.f; aqb[r] = 0.f; }
#pragma unroll
    for (int ks = 0; ks < 4; ++ks) { const bf16x8 vb = ldfrag(VT, 72, vt * 32, ks * 16, lane);
        apf = MFMA32(ldfrag(PF, 72, tt * 32, ks * 16, lane), vb, apf); apb = MFMA32(ldfrag(PB, 72, tt * 32, ks * 16, lane), vb, apb); }
#pragma unroll
    for (int ks = 0; ks < 8; ++ks) { const bf16x8 qa = ldfrag(Q, 136, tt * 32, ks * 16, lane);
        aqf = MFMA32(qa, ldfrag(ST, 136, vt * 32, ks * 16, lane), aqf); aqb = MFMA32(qa, ldfrag(ST + 128 * 136, 136, vt * 32, ks * 16, lane), aqb); }
    __syncthreads();
#pragma unroll
    for (int r = 0; r < 16; ++r) { const int t = tt * 32 + crow(r, lane);
        const float hv = INV[t] * (apf[r] + WT[t] * aqf[r]) + INV[64 + t] * (apb[r] + WT[64 + t] * aqb[r]);
        O[t * 132 + vt * 32 + (lane & 31)] = hv; }
    __syncthreads();
    head_norm_store<true>(p, O, tok0, h, 3072, p.in[15], 512, tid);
    __syncthreads();
}

__device__ __forceinline__ void phase6(const P& p, LAS unsigned char* lds) {
    for (int it = blockIdx.x; it < 2048; it += gridDim.x) {
        const int ty = it >> 10, r = it & 1023, b = r >> 8, h = (r >> 6) & 3, j = r & 63;
        if (ty == 0) p6_gla(p, lds, b, h, j); else p6_ml(p, lds, b, h, j);
    }
}

__device__ __forceinline__ void phase8(const P& p, LAS unsigned char* lds) {
    const int tid = threadIdx.x, lane = tid & 63, wave = tid >> 6;
    LAS bf16_t* RWB = (LAS bf16_t*)lds; LAS float* AB = (LAS float*)(lds + 99072); LAS float* LG = (LAS float*)(lds + 131840) + wave * 768;
    const float* mod = (const float*)(p.ws + WS_MOD);
    for (int k = tid; k < 1024; k += NTHR) {
        const f32x4 g = *(const f32x4*)(p.in[18] + k * 4);
        RWB[0 * 1032 + k] = (bf16_t)f2bf(g.x); RWB[1 * 1032 + k] = (bf16_t)f2bf(g.y); RWB[2 * 1032 + k] = (bf16_t)f2bf(g.z); RWB[3 * 1032 + k] = (bf16_t)f2bf(g.w);
#pragma unroll
        for (int q = 0; q < 8; ++q) { const f32x4 e = *(const f32x4*)(p.in[20] + k * 32 + q * 4);
            RWB[(4 + q * 4 + 0) * 1032 + k] = (bf16_t)f2bf(e.x); RWB[(4 + q * 4 + 1) * 1032 + k] = (bf16_t)f2bf(e.y); RWB[(4 + q * 4 + 2) * 1032 + k] = (bf16_t)f2bf(e.z); RWB[(4 + q * 4 + 3) * 1032 + k] = (bf16_t)f2bf(e.w); }
#pragma unroll
        for (int r = 36; r < 48; ++r) RWB[r * 1032 + k] = (bf16_t)0;
    }
    for (int i = tid; i < 4096; i += NTHR) { const int b = i >> 10, k = i & 1023;
        AB[(b * 2 + 0) * 1024 + k] = p.in[17][k] * (1.f + mod[b * 6144 + 4096 + k]); AB[(b * 2 + 1) * 1024 + k] = mod[b * 6144 + 3072 + k]; }
    __syncthreads();
    bf16_t* H2 = (bf16_t*)(p.ws + WS_MQ);
    int* RT = (int*)(p.ws + WS_ROUTE); unsigned* CNT = (unsigned*)(p.ws + WS_CTL) + CW_CNT;
    const float* PSS = (const float*)(p.ws + WS_PSS);
    LAS float* LGA = (LAS float*)(lds + 131840);
    LAS int* LC = (LAS int*)(lds + 156416); LAS int* LB = LC + 32;
    const int r16 = lane & 15, kq = lane >> 4, gsub = wave & 3, kh = wave >> 2;
    for (int blk = blockIdx.x; blk < MX / 64; blk += gridDim.x) {
        const int grp = blk * 4 + gsub, row = grp * 16 + r16, b = grp >> 8;
        const f32x4 pq = *(const f32x4*)(PSS + (size_t)row * 16 + kq * 4);
        float ss = pq.x + pq.y + pq.z + pq.w;
        ss += __shfl_xor(ss, 16); ss += __shfl_xor(ss, 32);
        const float rstd = 1.f / sqrtf(ss * (1.f / D) + EPS);
        const float* src = p.out + (size_t)row * D + kh * 512 + kq * 8;
        const LAS float* al = AB + (b * 2) * 1024 + kh * 512 + kq * 8; const LAS float* be = al + 1024;
        bf16_t* hdst = H2 + (size_t)row * D + kh * 512 + kq * 8;
        f32x4 acc[3];
#pragma unroll
        for (int nt = 0; nt < 3; ++nt) acc[nt] = (f32x4){0.f, 0.f, 0.f, 0.f};
#pragma unroll 8
        for (int ks = 0; ks < 16; ++ks) {
            const f32x4 x0 = *(const f32x4*)(src + ks * 32), x1 = *(const f32x4*)(src + ks * 32 + 4);
            const f32x4 a0 = *(const LAS f32x4*)(al + ks * 32), a1 = *(const LAS f32x4*)(al + ks * 32 + 4), b0 = *(const LAS f32x4*)(be + ks * 32), b1 = *(const LAS f32x4*)(be + ks * 32 + 4);
            const f32x4 h0 = x0 * rstd * a0 + b0, h1 = x1 * rstd * a1 + b1;
            u32x4 hw; hw.x = pk2(h0.x, h0.y); hw.y = pk2(h0.z, h0.w); hw.z = pk2(h1.x, h1.y); hw.w = pk2(h1.z, h1.w);
            *(u32x4*)(hdst + ks * 32) = hw;
            const bf16x8 af = __builtin_bit_cast(bf16x8, hw);
#pragma unroll
            for (int nt = 0; nt < 3; ++nt) { const bf16x8 bfr = *(const LAS bf16x8*)(RWB + (nt * 16 + r16) * 1032 + kh * 512 + ks * 32 + kq * 8);
                acc[nt] = __builtin_amdgcn_mfma_f32_16x16x32_bf16(af, bfr, acc[nt], 0, 0, 0); }
        }
        LAS float* LG = LGA + (kh * 4 + gsub) * 768;
#pragma unroll
        for (int nt = 0; nt < 3; ++nt)
#pragma unroll
            for (int r = 0; r < 4; ++r) LG[(kq * 4 + r) * 48 + nt * 16 + r16] = acc[nt][r];
        if (tid < 32) LC[tid] = 0;
        __syncthreads();
        int ea = 0, eb = 0, la = 0, lb = 0; float w0 = 0.f, w1 = 0.f;
        const bool sel = wave < 4 && lane < 16;
        if (sel) {
            const LAS float* lg0 = LGA + gsub * 768 + lane * 48; const LAS float* lg1 = lg0 + 4 * 768;
            float gl[4];
#pragma unroll
            for (int q = 0; q < 4; ++q) gl[q] = lg0[q] + lg1[q] + p.in[19][q];
            int gi = 0; float gm = gl[0];
#pragma unroll
            for (int q = 1; q < 4; ++q) if (gl[q] > gm) { gm = gl[q]; gi = q; }
            float den = 0.f;
#pragma unroll
            for (int q = 0; q < 4; ++q) den += __expf(gl[q] - gm);
            const float gwt = 1.f / den;
            float el[8];
#pragma unroll
            for (int q = 0; q < 8; ++q) el[q] = lg0[4 + gi * 8 + q] + lg1[4 + gi * 8 + q] + p.in[21][gi * 8 + q];
            int i0 = 0; float v0 = el[0];
#pragma unroll
            for (int q = 1; q < 8; ++q) if (el[q] > v0) { v0 = el[q]; i0 = q; }
            int i1 = -1; float v1 = -3.0e38f;
#pragma unroll
            for (int q = 0; q < 8; ++q) if (q != i0 && el[q] > v1) { v1 = el[q]; i1 = q; }
            const float e1 = __expf(v1 - v0); w0 = gwt / (1.f + e1); w1 = gwt * e1 / (1.f + e1);
            ea = gi * 8 + i0; eb = gi * 8 + i1;
            la = __hip_atomic_fetch_add(&LC[ea], 1, __ATOMIC_RELAXED, __HIP_MEMORY_SCOPE_WORKGROUP); lb = __hip_atomic_fetch_add(&LC[eb], 1, __ATOMIC_RELAXED, __HIP_MEMORY_SCOPE_WORKGROUP);
        }
        __syncthreads();
        if (tid < 32) { const int c = LC[tid]; LB[tid] = c > 0 ? (int)atomicAdd(&CNT[tid * 64], (unsigned)c) : 0; }
        __syncthreads();
        if (sel) { int* r = RT + (size_t)(grp * 16 + lane) * 8; r[0] = ea; r[1] = eb; r[2] = LB[ea] + la; r[3] = LB[eb] + lb; ((float*)r)[4] = w0; ((float*)r)[5] = w1; }
        __syncthreads();
    }
}

__device__ __forceinline__ int build_tables(const P& p, LAS int* PST, LAS int* TEX) {
    const unsigned* CNT = (const unsigned*)(p.ws + WS_CTL) + CW_CNT;
    if (threadIdx.x == 0) { int acc = 0;
        for (int e = 0; e < 32; ++e) { PST[e] = acc; const int c = (int)__hip_atomic_load(&CNT[e * 64], __ATOMIC_RELAXED, __HIP_MEMORY_SCOPE_AGENT); const int nt = (c + 255) >> 8;
            for (int t = 0; t < nt; ++t) TEX[(acc >> 8) + t] = e;
            acc += nt << 8; }
        PST[32] = acc; }
    __syncthreads();
    return PST[32] >> 8;
}

__device__ __forceinline__ void phase9(const P& p, LAS unsigned char* lds) {
    LAS int* PST = (LAS int*)lds; LAS int* TEX = PST + 64;
    (void)build_tables(p, PST, TEX);
    const int tid = threadIdx.x, lane = tid & 63, wave = tid >> 6;
    const bf16_t* H2 = (const bf16_t*)(p.ws + WS_MQ); bf16_t* XS = (bf16_t*)(p.ws + WS_Z); int* RT = (int*)(p.ws + WS_ROUTE);
    const int gw = blockIdx.x * 8 + wave, NGW = gridDim.x * 8;
    for (int row = gw; row < MX; row += NGW) {
        int* r = RT + (size_t)row * 8;
        const int s0 = PST[r[0]] + r[2], s1 = PST[r[1]] + r[3];
        const u32x4 a = *(const u32x4*)(H2 + (size_t)row * D + lane * 8), bq = *(const u32x4*)(H2 + (size_t)row * D + 512 + lane * 8);
        *(u32x4*)(XS + (size_t)s0 * D + lane * 8) = a; *(u32x4*)(XS + (size_t)s0 * D + 512 + lane * 8) = bq;
        *(u32x4*)(XS + (size_t)s1 * D + lane * 8) = a; *(u32x4*)(XS + (size_t)s1 * D + 512 + lane * 8) = bq;
        if (lane == 0) { r[6] = s0; r[7] = s1; }
    }
}

__device__ __forceinline__ void phase12(const P& p, float* dstbase) {
    const int tid = threadIdx.x, lane = tid & 63, wave = tid >> 6;
    const float* mod = (const float*)(p.ws + WS_MOD); const bf16_t* Y = (const bf16_t*)(p.ws + WS_Z); const int* RT = (const int*)(p.ws + WS_ROUTE);
    const int gw = blockIdx.x * 8 + wave, NGW = gridDim.x * 8;
    for (int row = gw; row < MX; row += NGW) {
        const int* r = RT + (size_t)row * 8; const int s0 = r[6], s1 = r[7]; const float w0 = ((const float*)r)[4], w1 = ((const float*)r)[5];
        float* xr = p.out + (size_t)row * D; const float* g2 = mod + (size_t)(row >> 12) * 6144 + 5120;
        f32x4 v[4]; float ss = 0.f;
#pragma unroll
        for (int j = 0; j < 4; ++j) { const int k = 4 * lane + 256 * j;
            const f32x4 x1 = *(const f32x4*)(xr + k), g = *(const f32x4*)(g2 + k);
            const u32x2 ya = *(const u32x2*)(Y + (size_t)s0 * D + k), yb = *(const u32x2*)(Y + (size_t)s1 * D + k);
            f32x4 m; m.x = w0 * bflo(ya.x) + w1 * bflo(yb.x); m.y = w0 * bfhi(ya.x) + w1 * bfhi(yb.x); m.z = w0 * bflo(ya.y) + w1 * bflo(yb.y); m.w = w0 * bfhi(ya.y) + w1 * bfhi(yb.y);
            v[j] = x1 + g * m; ss += v[j].x * v[j].x + v[j].y * v[j].y + v[j].z * v[j].z + v[j].w * v[j].w; }
        const float rstd = 1.f / sqrtf(wave_sum(ss) * (1.f / D) + EPS);
#pragma unroll
        for (int j = 0; j < 4; ++j) { const int k = 4 * lane + 256 * j; const f32x4 g = *(const f32x4*)(p.in[24] + k); *(f32x4*)(dstbase + (size_t)row * D + k) = v[j] * rstd * g; }
    }
}

constexpr int NPH = 13;
__global__ void __launch_bounds__(NTHR, 2) mega(P p) {
    extern __shared__ __attribute__((aligned(16))) unsigned char lds_raw[];
    LAS unsigned char* lds = (LAS unsigned char*)lds_raw;
    volatile LAS unsigned* xst = (volatile LAS unsigned*)(lds + LDS_XB);
    if (threadIdx.x < 2) xst[threadIdx.x] = 0u;
    __syncthreads();
    XcdBarrier xb = xcd_barrier_post((unsigned*)(p.ws + WS_CTL) + CW_BAR, xst);
    const int lo = p.ph_lo, hi = p.ph_hi;
    const int G = gridDim.x, bx = blockIdx.x;
    const int vcu = (G % 8 == 0) ? (bx % 8) * (G / 8) + bx / 8 : bx;
#ifndef PHASE_MASK
#define PHASE_MASK 0x1fff
#endif
#define IN(k) (((PHASE_MASK >> (k)) & 1) && lo <= (k) && (k) < hi)
#define SEAM(k) do { if ((k) + 1 < hi) xcd_barrier(xb); } while (0)
#define REPN(k) (1 + ((REP_MASK >> (k)) & 1))
    if (IN(0)) { for (int rep = 0; rep < REPN(0); ++rep) { if (rep) xcd_barrier(xb); phase0(p, lds); } for (int q = 0; q < EXTRA_SYNCS; ++q) xcd_barrier(xb); SEAM(0); }
    if (IN(1)) { for (int rep = 0; rep < REPN(1); ++rep) { if (rep) xcd_barrier(xb); phase1(p); } SEAM(1); }
    if (IN(2)) {
        pg8::SchedDense S; S.nM = MT / 256; S.nN = NPADW / 256; S.nwg = S.nM * S.nN; S.G = G; S.c = bx; S.K = 1024; S.A = (const char*)(p.ws + WS_A); S.Bt = (const char*)(p.ws + WS_WINT);
        EpiZ E; E.Z = (bf16_t*)(p.ws + WS_Z); E.G = (float*)(p.ws + WS_GATES);
        for (int rep = 0; rep < REPN(2); ++rep) { if (rep) xcd_barrier(xb); pg8::gemm_phase(lds, 1024, S, E); } SEAM(2); }
    if (IN(3)) { for (int rep = 0; rep < REPN(3); ++rep) { if (rep) xcd_barrier(xb); phase3(p); } SEAM(3); }
    if (IN(4)) { for (int rep = 0; rep < REPN(4); ++rep) { if (rep) xcd_barrier(xb); phase4(p, lds); } SEAM(4); }
    if (IN(5)) { for (int rep = 0; rep < REPN(5); ++rep) { if (rep) { xcd_barrier(xb); phase4(p, lds); xcd_barrier(xb); } phase5(p); } SEAM(5); }
    if (IN(6)) { for (int rep = 0; rep < REPN(6); ++rep) { if (rep) xcd_barrier(xb); phase6(p, lds); } SEAM(6); }
    if (IN(7)) {
        pg8::SchedDense S; S.nM = MX / 256; S.nN = 4; S.nwg = S.nM * S.nN; S.G = G; S.c = bx; S.K = 1024; S.A = (const char*)(p.ws + WS_A); S.Bt = (const char*)(p.ws + WS_WOUTT);
        EpiX1 E; E.x = p.in[0]; E.mod = (const float*)(p.ws + WS_MOD); E.out = p.out; E.pss = (float*)(p.ws + WS_PSS);
        for (int rep = 0; rep < REPN(7); ++rep) { if (rep) xcd_barrier(xb); pg8::gemm_phase(lds, 1024, S, E); } SEAM(7); }
    if (IN(8)) { for (int rep = 0; rep < REPN(8); ++rep) { if (rep) { xcd_barrier(xb); if (bx == 0 && threadIdx.x < 32) ((unsigned*)(p.ws + WS_CTL))[CW_CNT + threadIdx.x * 64] = 0u; xcd_barrier(xb); } phase8(p, lds); } SEAM(8); }
    if (IN(9)) { for (int rep = 0; rep < REPN(9); ++rep) { if (rep) xcd_barrier(xb); phase9(p, lds); } SEAM(9); }
    if (IN(10)) {
        LAS int* PST = (LAS int*)(lds + pg8::STAGE_BYTES); LAS int* TEX = PST + 64;
        const int ntiles = build_tables(p, PST, TEX);
        pg8::SchedMoE S; S.ntiles = ntiles; S.G = G; S.c = vcu; S.K = 1024; S.tex = TEX; S.A = (const char*)(p.ws + WS_Z); S.Bt = (const char*)(p.ws + WS_E1T); S.bstride = (size_t)1024 * 1024 * 2;
        EpiH E; E.H = (bf16_t*)(p.ws + WS_UM);
        for (int rep = 0; rep < REPN(10); ++rep) { if (rep) xcd_barrier(xb); pg8::gemm_phase(lds, 1024, S, E); } SEAM(10); }
    if (IN(11)) {
        LAS int* PST = (LAS int*)(lds + pg8::STAGE_BYTES); LAS int* TEX = PST + 64;
        const int ntiles = build_tables(p, PST, TEX);
        pg8::SchedMoE S; S.ntiles = ntiles; S.G = G; S.c = vcu; S.K = 512; S.tex = TEX; S.A = (const char*)(p.ws + WS_UM); S.Bt = (const char*)(p.ws + WS_E2T); S.bstride = (size_t)1024 * 512 * 2;
        EpiY E; E.Y = (bf16_t*)(p.ws + WS_Z);
        for (int rep = 0; rep < REPN(11); ++rep) { if (rep) xcd_barrier(xb); pg8::gemm_phase(lds, 512, S, E); } SEAM(11); }
    if (IN(12)) { for (int rep = 1; rep < REPN(12); ++rep) { phase12(p, (float*)(p.ws + WS_MQ)); xcd_barrier(xb); } phase12(p, p.out); }
#undef IN
#undef SEAM
}

extern "C" void kernel_launch(void* const* d_in, const int* in_sizes, int n_in, void* d_out, int out_size, void* d_ws, size_t ws_size, hipStream_t stream) {
    static int grid = 0;
    if (grid == 0) {
        if (n_in != 25 || out_size != MX * D || ws_size < WS_END) { fprintf(stderr, "kernel_launch: unexpected problem (n_in %d out %d ws %zu)\n", n_in, out_size, ws_size); grid = -1; return; }
        int dev = 0, cus = 0, per_cu = 0;
        hipGetDevice(&dev); hipDeviceGetAttribute(&cus, hipDeviceAttributeMultiprocessorCount, dev);
        if (hipFuncSetAttribute((const void*)mega, hipFuncAttributeMaxDynamicSharedMemorySize, LDS_BYTES) != hipSuccess) { fprintf(stderr, "kernel_launch: hipFuncSetAttribute failed\n"); grid = -1; return; }
        if (hipOccupancyMaxActiveBlocksPerMultiprocessor(&per_cu, (const void*)mega, NTHR, LDS_BYTES) != hipSuccess || per_cu < 1) { fprintf(stderr, "kernel_launch: occupancy query says %d\n", per_cu); per_cu = 1; }
        (void)hipGetLastError();
        grid = cus;
    }
    if (grid < 0) return;
    hipMemsetAsync((char*)d_ws + WS_CTL, 0, 1 * MiB, stream);
    P a{};
    for (int i = 0; i < 25; ++i) a.in[i] = (const float*)d_in[i];
    a.out = (float*)d_out; a.ws = (unsigned char*)d_ws;
#if N_LAUNCH_MODE == 1
    a.ph_lo = 0; a.ph_hi = NPH;
    void* args[] = {&a};
    hipError_t e = hipLaunchCooperativeKernel((const void*)mega, dim3(grid), dim3(NTHR), args, LDS_BYTES, stream);
    if (e != hipSuccess) fprintf(stderr, "cooperative launch failed: %s (grid %d)\n", hipGetErrorString(e), grid);
#else
    for (int ph = 0; ph < NPH; ++ph) { a.ph_lo = ph; a.ph_hi = ph + 1; hipLaunchKernelGGL(mega, dim3(grid), dim3(NTHR), LDS_BYTES, stream, a); }
#endif
}
```

```cpp
#include <hip/hip_runtime.h>
#include <hip/hip_cooperative_groups.h>
#include <cstdio>
namespace cg = cooperative_groups;

#ifndef N_LAUNCH_MODE
#define N_LAUNCH_MODE 1
#endif

#ifndef REP_MASK
#define REP_MASK 0
#endif
#ifndef FWD_REPS
#define FWD_REPS 1
#endif
#ifndef ITEM_REP3
#define ITEM_REP3 1
#endif
#ifndef ITEM_REP6
#define ITEM_REP6 1
#endif
#ifndef EXTRA_SYNCS
#define EXTRA_SYNCS 0
#endif
#define LAS __attribute__((address_space(3)))
typedef unsigned short bf16_t;
typedef short bf16x8 __attribute__((ext_vector_type(8)));
typedef float f32x4 __attribute__((ext_vector_type(4)));
typedef float f32x16 __attribute__((ext_vector_type(16)));
typedef unsigned u32x2 __attribute__((ext_vector_type(2)));
typedef unsigned u32x4 __attribute__((ext_vector_type(4)));

constexpr int D = 1024, NB = 4, SEQ = 4096, CTXL = 256;
constexpr int MX = NB * SEQ, MC = NB * CTXL, MT = MX + MC;
constexpr int INW = 3632, ZLD = 3584, NPADW = 3840;
constexpr int NCH = 68;
constexpr int NSTATE = NB * 4 * NCH;
constexpr float EPS = 1e-6f;
constexpr int NTHR = 512;
constexpr int LDS_BYTES = 160 * 1024;

constexpr size_t MiB = 1u << 20;
constexpr size_t WS_CTL = 0;
constexpr size_t WS_MOD = 1 * MiB;
constexpr size_t WS_ROUTE = 2 * MiB;
constexpr size_t WS_GDEC = 3 * MiB;
constexpr size_t WS_MN = 4 * MiB;
constexpr size_t WS_MSC = 6 * MiB;
constexpr size_t WS_GATES = 7 * MiB;
constexpr size_t WS_WINT = 11 * MiB;
constexpr size_t WS_WOUTT = 19 * MiB;
constexpr size_t WS_E1T = 21 * MiB;
constexpr size_t WS_E2T = 85 * MiB;
constexpr size_t WS_A = 117 * MiB;
constexpr size_t WS_Z = 151 * MiB;
constexpr size_t WS_MQ = 270 * MiB;
constexpr size_t WS_MK = 287 * MiB;
constexpr size_t WS_UG = 304 * MiB;
constexpr size_t WS_UM = 338 * MiB;
constexpr size_t WS_PSS = 406 * MiB;
constexpr size_t WS_TOK = 408 * MiB;
constexpr size_t WS_END = 410 * MiB;
constexpr int CW_CNT = 64;
constexpr int CW_BAR = 4096;
constexpr int LDS_XB = LDS_BYTES - 64;

struct P { const float* in[25]; float* out; unsigned char* ws; int ph_lo, ph_hi; };

__device__ __forceinline__ unsigned f2bf(float f) { unsigned u = __float_as_uint(f); return (u + 0x7fffu + ((u >> 16) & 1u)) >> 16; }
__device__ __forceinline__ unsigned pk2(float lo, float hi) { return f2bf(lo) | (f2bf(hi) << 16); }
__device__ __forceinline__ float bf2f(unsigned b) { return __uint_as_float(b << 16); }
__device__ __forceinline__ float bflo(unsigned w) { return __uint_as_float(w << 16); }
__device__ __forceinline__ float bfhi(unsigned w) { return __uint_as_float(w & 0xffff0000u); }
__device__ __forceinline__ float wave_sum(float v) {
#pragma unroll
    for (int o = 32; o >= 1; o >>= 1) v += __shfl_xor(v, o);
    return v;
}
__device__ __forceinline__ float siluf(float x) { return x / (1.f + __expf(-x)); }
__device__ __forceinline__ float sigmf(float x) { return 1.f / (1.f + __expf(-x)); }
__device__ __forceinline__ float logsigf(float x) { return fminf(x, 0.f) - __logf(1.f + __expf(-fabsf(x))); }


__device__ __forceinline__ float scan_sum_up(float v, int lane) {
#pragma unroll
    for (int o = 1; o < 64; o <<= 1) { const float t = __shfl_up(v, o); v += (lane >= o) ? t : 0.f; }
    return v;
}
__device__ __forceinline__ float scan_sum_down(float v, int lane) {
#pragma unroll
    for (int o = 1; o < 64; o <<= 1) { const float t = __shfl_down(v, o); v += (lane + o < 64) ? t : 0.f; }
    return v;
}
__device__ __forceinline__ float scan_max_up(float v, int lane) {
#pragma unroll
    for (int o = 1; o < 64; o <<= 1) { const float t = __shfl_up(v, o); v = (lane >= o) ? fmaxf(v, t) : v; }
    return v;
}
__device__ __forceinline__ float scan_max_down(float v, int lane) {
#pragma unroll
    for (int o = 1; o < 64; o <<= 1) { const float t = __shfl_down(v, o); v = (lane + o < 64) ? fmaxf(v, t) : v; }
    return v;
}
__device__ __forceinline__ float wave_max(float v) {
#pragma unroll
    for (int o = 32; o >= 1; o >>= 1) v = fmaxf(v, __shfl_xor(v, o));
    return v;
}

__device__ __forceinline__ bf16x8 ldfrag(const LAS bf16_t* T, int ld, int row0, int k0, int lane) {
    return *(const LAS bf16x8*)(T + (row0 + (lane & 31)) * ld + k0 + 8 * (lane >> 5));
}
#define MFMA32(a, b, c) __builtin_amdgcn_mfma_f32_32x32x16_bf16((a), (b), (c), 0, 0, 0)
__device__ __forceinline__ int crow(int r, int lane) { return (r & 3) + 8 * (r >> 2) + 4 * (lane >> 5); }


#define XB_TMO      128
#define XB_XCNT(j)  (256  + 64 * (j))
#define XB_XSUB(j)  (1280 + 64 * (j))
#define XB_XGEN(j)  (2304 + 64 * (j))
#define XB_TOP      3328
#define XB_TOPGEN   3392
#define XCD_BAR_WORDS 3456
#define XB_SPIN_CAP (1u << 22)
__device__ __forceinline__ unsigned xb_ld(unsigned* p)              { return __hip_atomic_load(p, __ATOMIC_RELAXED, __HIP_MEMORY_SCOPE_AGENT); }
__device__ __forceinline__ unsigned xb_add(unsigned* p, unsigned v) { return __hip_atomic_fetch_add(p, v, __ATOMIC_RELAXED, __HIP_MEMORY_SCOPE_AGENT); }
__device__ __forceinline__ unsigned xb_xcc_id() { return (unsigned)__builtin_amdgcn_s_getreg((3 << 11) | 20) & 0xFu; }
#define XB_SPIN(cond, bar) do { unsigned _sp = 0; while (cond) { __builtin_amdgcn_s_sleep(1); \
    if ((++_sp & 255u) == 0u) { if (xb_ld(&(bar)[XB_TMO])) break; if (_sp > XB_SPIN_CAP) { atomicAdd(&(bar)[XB_TMO], 1u); break; } } } } while (0)
struct XcdBarrier { unsigned* bar; unsigned x; volatile LAS unsigned* st; };
__device__ __forceinline__ XcdBarrier xcd_barrier_post(unsigned* bar, volatile LAS unsigned* st) {
    XcdBarrier b; b.bar = bar; b.x = xb_xcc_id(); b.st = st;
    if (threadIdx.x == 0) (void)xb_add(&bar[XB_XCNT(b.x)], 1u);
    return b;
}
__device__ __forceinline__ void xcd_barrier_complete(unsigned* bar, unsigned x, unsigned& nloc, unsigned& nx) {
    const unsigned G = gridDim.x * gridDim.y * gridDim.z;
    unsigned sum, cnt, mine, sp = 0u;
    for (;;) {
        sum = 0u; cnt = 0u; mine = 0u;
#pragma unroll
        for (unsigned j = 0; j < 16; ++j) { const unsigned c = xb_ld(&bar[XB_XCNT(j)]); sum += c; cnt += (c > 0u) ? 1u : 0u; mine = (j == x) ? c : mine; }
        if (sum == G) break;
        __builtin_amdgcn_s_sleep(1);
        if ((++sp & 255u) == 0u) { if (xb_ld(&bar[XB_TMO])) break; if (sp > XB_SPIN_CAP) { atomicAdd(&bar[XB_TMO], 1u); break; } }
    }
    nloc = mine > 0u ? mine : 1u; nx = cnt > 0u ? cnt : 1u;
}
__device__ __forceinline__ void xcd_barrier(const XcdBarrier& b) {
    asm volatile("s_waitcnt vmcnt(0)" ::: "memory");
    __syncthreads();
    if (threadIdx.x == 0) {
        unsigned* bar = b.bar;
        __builtin_amdgcn_s_waitcnt(0);
        unsigned nloc = b.st[0], nx = b.st[1];
        if (nloc == 0u) { xcd_barrier_complete(bar, b.x, nloc, nx); b.st[0] = nloc; b.st[1] = nx; }
        const unsigned old = xb_add(&bar[XB_XSUB(b.x)], 1u);
        const unsigned gen = old / nloc;
        if (old + 1u == (gen + 1u) * nloc) {
            __builtin_amdgcn_fence(__ATOMIC_RELEASE, "agent");
            asm volatile("s_waitcnt vmcnt(0)" ::: "memory");
            const unsigned og = xb_add(&bar[XB_TOP], 1u);
            const unsigned tg = og / nx;
            if (og + 1u == (tg + 1u) * nx) xb_add(&bar[XB_TOPGEN], 1u);
            else XB_SPIN(xb_ld(&bar[XB_TOPGEN]) == tg, bar);
            __builtin_amdgcn_fence(__ATOMIC_ACQUIRE, "agent");
            xb_add(&bar[XB_XGEN(b.x)], 1u);
            asm volatile("s_waitcnt vmcnt(0)" ::: "memory");
        } else {
            XB_SPIN(xb_ld(&bar[XB_XGEN(b.x)]) == gen, bar);
            __builtin_amdgcn_fence(__ATOMIC_ACQUIRE, "agent");
            asm volatile("s_waitcnt vmcnt(0)" ::: "memory");
        }
    }
    __syncthreads();
}

namespace pg8 {
constexpr int BM = 256, BK = 64, HALF = 128, HTB = HALF * BK * 2, STAGE_BYTES = 8 * HTB;
__device__ __forceinline__ int lds_byte(int r, int c) { const int st = (r >> 4) * 2 + (c >> 5), rr = r & 15, cc = c & 31, ob = rr * 64 + cc * 2; return st * 1024 + (ob ^ (((ob >> 9) & 1) << 5)); }
__device__ __forceinline__ void stage_rc(int b, int& R, int& C) { const int st = b / 1024, sb = b % 1024, swz = sb ^ (((sb >> 9) & 1) << 5); R = (st >> 1) * 16 + swz / 64; C = (st & 1) * 32 + (swz % 64) / 2; }
__device__ __forceinline__ int perm32(int rho) { const int n = rho >> 4, i = rho & 15; return 8 * (i >> 2) + 4 * n + (i & 3); }
struct Unit { int pm, pn; const char* a; const char* b; };

template <class Epi, class Sched, bool GATHER = false>
__device__ __forceinline__ void gemm_phase(LAS unsigned char* lds, const int K, const Sched& S, const Epi& E) {
    const int tid = threadIdx.x, wid = __builtin_amdgcn_readfirstlane(tid >> 6), lane = tid & 63, wr = wid >> 2, wc = wid & 3, fr = lane & 15, fq = lane >> 4;
    const int nt = K / BK;
    unsigned voffA[2], voffB[2];
#pragma unroll
    for (int i = 0; i < 2; ++i) { int R, C; stage_rc(tid * 16 + i * 8192, R, C); const int Rb = Epi::PERM ? ((R & ~31) + perm32(R & 31)) : R;
        voffA[i] = (unsigned)(R * K + C) * 2u; voffB[i] = (unsigned)(Rb * K + C) * 2u; }
    unsigned ca[2][2], na[2][2];
#define PG8_GOFF(dst, u) do { if constexpr (GATHER) { _Pragma("unroll") for (int _h = 0; _h < 2; ++_h) _Pragma("unroll") for (int _i = 0; _i < 2; ++_i) { int _R, _C; stage_rc(tid * 16 + _i * 8192, _R, _C); \
        dst[_h][_i] = S.row_off(u, _h * HALF + _R) + (unsigned)_C * 2u; } } } while (0)
    const size_t kstep = (size_t)(BK * 2);
    const size_t hstep = (size_t)HALF * K * 2;
    const size_t hstepA = GATHER ? 0 : hstep;
    const unsigned ldsw = (unsigned)wid * 1024u;
    const int aoff = lds_byte(wr * 64 + fr, fq * 8), boff = lds_byte(wc * 32 + fr, fq * 8);
#define PG8_SA(b, h) (((b) * 2 + (h)) * HTB)
#define PG8_SB(b, h) ((4 + (b) * 2 + (h)) * HTB)
#define PG8_STAGE(bufoff, gbase, voff) do { _Pragma("unroll") for (int _i = 0; _i < 2; ++_i) \
        __builtin_amdgcn_global_load_lds((const unsigned*)((const char*)(gbase) + (voff)[_i]), (LAS unsigned*)(lds + (bufoff) + ldsw + _i * 8192), 16, 0, 0); } while (0)
#define PG8_STAGEA(bufoff, gbase, h, nx) do { _Pragma("unroll") for (int _i = 0; _i < 2; ++_i) { const unsigned _vo = GATHER ? ((nx) ? na[h][_i] : ca[h][_i]) : voffA[_i]; \
        __builtin_amdgcn_global_load_lds((const unsigned*)((const char*)(gbase) + (size_t)(h) * hstepA + _vo), (LAS unsigned*)(lds + (bufoff) + ldsw + _i * 8192), 16, 0, 0); } } while (0)
#define PG8_LDA(dst, b, h) do { _Pragma("unroll") for (int m = 0; m < 4; ++m) _Pragma("unroll") for (int k = 0; k < 2; ++k) dst[m][k] = *(const LAS bf16x8*)(lds + PG8_SA(b, h) + aoff + m * 2048 + k * 1024); } while (0)
#define PG8_LDB(dst, b, h) do { _Pragma("unroll") for (int n = 0; n < 2; ++n) _Pragma("unroll") for (int k = 0; k < 2; ++k) dst[n][k] = *(const LAS bf16x8*)(lds + PG8_SB(b, h) + boff + n * 2048 + k * 1024); } while (0)
#define PG8_MMA(ai, bj, At, Bt) do { __builtin_amdgcn_s_setprio(1); _Pragma("unroll") for (int m = 0; m < 4; ++m) _Pragma("unroll") for (int n = 0; n < 2; ++n) _Pragma("unroll") for (int k = 0; k < 2; ++k) \
        acc[ai][bj][m][n] = __builtin_amdgcn_mfma_f32_16x16x32_bf16(Bt[n][k], At[m][k], acc[ai][bj][m][n], 0, 0, 0); __builtin_amdgcn_s_setprio(0); } while (0)
#define PG8_WAIT_V(n) asm volatile("s_waitcnt vmcnt(" #n ")" ::: "memory")
#define PG8_WAIT_L(n) asm volatile("s_waitcnt lgkmcnt(" #n ")" ::: "memory")
#define PG8_BAR __builtin_amdgcn_s_barrier()
#define PG8_SCHED __builtin_amdgcn_sched_barrier(0)
    Unit cur, nxt; int ui = 0;
    if (!S.next(0, cur)) return;
    f32x4 acc[2][2][4][2];
#pragma unroll
    for (int a = 0; a < 2; ++a)
#pragma unroll
        for (int b = 0; b < 2; ++b)
#pragma unroll
            for (int m = 0; m < 4; ++m)
#pragma unroll
                for (int n = 0; n < 2; ++n) acc[a][b][m][n] = (f32x4){0.f, 0.f, 0.f, 0.f};
    bf16x8 At[4][2], B0[2][2], B1[2][2];
    const char* cA = cur.a; const char* cB = cur.b;
    PG8_GOFF(ca, cur);
    PG8_STAGE(PG8_SB(0, 0), cB, voffB); PG8_STAGEA(PG8_SA(0, 0), cA, 0, false); PG8_STAGE(PG8_SB(0, 1), cB + hstep, voffB); PG8_STAGEA(PG8_SA(0, 1), cA, 1, false);
    if (wr == 1) PG8_BAR;
    PG8_WAIT_V(4); PG8_BAR;
    PG8_STAGE(PG8_SB(1, 0), cB + kstep, voffB); PG8_STAGEA(PG8_SA(1, 0), cA + kstep, 0, false); PG8_STAGE(PG8_SB(1, 1), cB + hstep + kstep, voffB);
    PG8_WAIT_V(6); PG8_BAR;
    for (;;) {
        const bool has_next = S.next(ui + 1, nxt);
        const char* nA = has_next ? nxt.a : cA; const char* nB = has_next ? nxt.b : cB;
        if constexpr (GATHER) { if (has_next) PG8_GOFF(na, nxt); else { _Pragma("unroll") for (int _h = 0; _h < 2; ++_h) _Pragma("unroll") for (int _i = 0; _i < 2; ++_i) na[_h][_i] = ca[_h][_i]; } }
        for (int t = 0; t < nt; t += 2) {
            const bool last = (t == nt - 2);
            const char* a1 = cA + (size_t)(t + 1) * kstep;
            const char* a2 = last ? nA : cA + (size_t)(t + 2) * kstep; const char* b2 = last ? nB : cB + (size_t)(t + 2) * kstep;
            const char* a3 = a2 + kstep; const char* b3 = b2 + kstep;
            PG8_LDB(B0, 0, 0); PG8_SCHED; PG8_LDA(At, 0, 0); PG8_STAGEA(PG8_SA(1, 1), a1, 1, false);
            PG8_WAIT_L(8); PG8_BAR; PG8_WAIT_L(0); PG8_MMA(0, 0, At, B0); PG8_BAR; PG8_SCHED;
            PG8_LDB(B1, 0, 1); PG8_STAGE(PG8_SB(0, 0), b2, voffB);
            PG8_BAR; PG8_WAIT_L(0); PG8_MMA(0, 1, At, B1); PG8_BAR;
            PG8_LDA(At, 0, 1); PG8_STAGEA(PG8_SA(0, 0), a2, 0, last);
            PG8_BAR; PG8_WAIT_L(0); PG8_MMA(1, 0, At, B0); PG8_BAR; PG8_SCHED;
            PG8_STAGE(PG8_SB(0, 1), b2 + hstep, voffB);
            PG8_WAIT_V(6); PG8_BAR; PG8_MMA(1, 1, At, B1); PG8_BAR;
            PG8_LDB(B0, 1, 0); PG8_SCHED; PG8_LDA(At, 1, 0); PG8_STAGEA(PG8_SA(0, 1), a2, 1, last);
            PG8_WAIT_L(8); PG8_BAR; PG8_WAIT_L(0); PG8_MMA(0, 0, At, B0); PG8_BAR; PG8_SCHED;
            PG8_LDB(B1, 1, 1); PG8_STAGE(PG8_SB(1, 0), b3, voffB);
            PG8_BAR; PG8_WAIT_L(0); PG8_MMA(0, 1, At, B1); PG8_BAR;
            PG8_LDA(At, 1, 1); PG8_STAGEA(PG8_SA(1, 0), a3, 0, last);
            PG8_BAR; PG8_WAIT_L(0); PG8_MMA(1, 0, At, B0); PG8_BAR; PG8_SCHED;
            PG8_STAGE(PG8_SB(1, 1), b3 + hstep, voffB);
            PG8_WAIT_V(6); PG8_BAR; PG8_MMA(1, 1, At, B1); PG8_BAR;
        }
        E(acc, cur, wr, wc, fr, fq);
        if (!has_next) break;
#pragma unroll
        for (int a = 0; a < 2; ++a)
#pragma unroll
            for (int b = 0; b < 2; ++b)
#pragma unroll
                for (int m = 0; m < 4; ++m)
#pragma unroll
                    for (int n = 0; n < 2; ++n) acc[a][b][m][n] = (f32x4){0.f, 0.f, 0.f, 0.f};
        cur = nxt; cA = nA; cB = nB; ++ui;
        if constexpr (GATHER) { _Pragma("unroll") for (int _h = 0; _h < 2; ++_h) _Pragma("unroll") for (int _i = 0; _i < 2; ++_i) ca[_h][_i] = na[_h][_i]; }
    }
    PG8_WAIT_V(0);
    if (wr == 0) PG8_BAR;
    PG8_BAR;
#undef PG8_SA
#undef PG8_SB
#undef PG8_STAGE
#undef PG8_STAGEA
#undef PG8_GOFF
#undef PG8_LDA
#undef PG8_LDB
#undef PG8_MMA
#undef PG8_WAIT_V
#undef PG8_WAIT_L
#undef PG8_BAR
#undef PG8_SCHED
}

struct SchedDense {
    int nM, nN, nwg, G, c, K; const char* A; const char* Bt;
    __device__ __forceinline__ bool next(int i, Unit& u) const {
        const long L = (long)i * G + c; if (L >= nwg) return false;
        int wgid = (int)L; { const int q = nwg / 8, r = nwg % 8, xcd = wgid % 8, off = wgid / 8; wgid = (xcd < r ? xcd * (q + 1) : r * (q + 1) + (xcd - r) * q) + off; }
        const int nig = 8 * nN, gid = wgid / nig, fm = gid * 8, gsz = (nM - fm) < 8 ? (nM - fm) : 8;
        u.pm = fm + ((wgid % nig) % gsz); u.pn = (wgid % nig) / gsz;
        u.a = A + (size_t)u.pm * 256 * K * 2; u.b = Bt + (size_t)u.pn * 256 * K * 2; return true;
    }
};
struct SchedMoE {
    int ntiles, G, c, K; const LAS int* tex; const LAS int* pst; const LAS int* cnt; const int* tok; const char* A; const char* Bt; size_t bstride; bool gather;
    __device__ __forceinline__ bool next(int i, Unit& u) const {
        const int L = i * G + c; const int rt = L >> 2; if (rt >= ntiles) return false;
        u.pm = rt; u.pn = L & 3; const int e = tex[rt];
        u.a = gather ? A : A + (size_t)rt * 256 * K * 2; u.b = Bt + (size_t)e * bstride + (size_t)u.pn * 256 * K * 2; return true;
    }
    __device__ __forceinline__ unsigned row_off(const Unit& u, int r) const {
        const int e = tex[u.pm], idx = (u.pm - (pst[e] >> 8)) * 256 + r;
        const int t = idx < cnt[e] ? tok[e * 16384 + idx] : 0;
        return (unsigned)t * (unsigned)(K * 2);
    }
};
}

typedef const f32x4 (&AccRef)[2][2][4][2];
struct EpiZ {
    static constexpr bool PERM = true; bf16_t* Z; float* G;
    __device__ __forceinline__ void operator()(AccRef acc, const pg8::Unit& u, int wr, int wc, int fr, int fq) const {
        const int row0 = u.pm * 256 + wr * 64 + fr;
        if (u.pn < 14) {
            const int col0 = u.pn * 256 + wc * 32 + 8 * fq;
#pragma unroll
            for (int ai = 0; ai < 2; ++ai)
#pragma unroll
                for (int m = 0; m < 4; ++m) { bf16_t* rowp = Z + (size_t)(row0 + ai * 128 + m * 16) * ZLD + col0;
#pragma unroll
                    for (int bj = 0; bj < 2; ++bj) { const f32x4 v0 = acc[ai][bj][m][0], v1 = acc[ai][bj][m][1];
                        u32x4 o; o.x = pk2(v0[0], v0[1]); o.y = pk2(v0[2], v0[3]); o.z = pk2(v1[0], v1[1]); o.w = pk2(v1[2], v1[3]);
                        *(u32x4*)(rowp + bj * 128) = o; } }
        } else {
            const int c0 = wc * 32 + 8 * fq;
            if (c0 < 48) {
#pragma unroll
                for (int ai = 0; ai < 2; ++ai)
#pragma unroll
                    for (int m = 0; m < 4; ++m) { float* rowp = G + (size_t)(row0 + ai * 128 + m * 16) * 48 + c0;
                        *(f32x4*)rowp = acc[ai][0][m][0]; *(f32x4*)(rowp + 4) = acc[ai][0][m][1]; }
            }
        }
    }
};
struct EpiX1 {
    static constexpr bool PERM = false; const float* x; const float* mod; float* out; float* pss;
    __device__ __forceinline__ void operator()(AccRef acc, const pg8::Unit& u, int wr, int wc, int fr, int fq) const {
        const int row0 = u.pm * 256 + wr * 64 + fr, col0 = u.pn * 256 + wc * 32 + 4 * fq;
        const float* g1 = mod + (size_t)(u.pm >> 4) * 6144 + 2048;
        f32x4 gv[2][2];
#pragma unroll
        for (int bj = 0; bj < 2; ++bj)
#pragma unroll
            for (int n = 0; n < 2; ++n) gv[bj][n] = *(const f32x4*)(g1 + col0 + bj * 128 + n * 16);
#pragma unroll
        for (int ai = 0; ai < 2; ++ai)
#pragma unroll
            for (int m = 0; m < 4; ++m) { const int row = row0 + ai * 128 + m * 16; const size_t off = (size_t)row * D + col0; float ss = 0.f;
#pragma unroll
                for (int bj = 0; bj < 2; ++bj)
#pragma unroll
                    for (int n = 0; n < 2; ++n) { const f32x4 xv = *(const f32x4*)(x + off + bj * 128 + n * 16);
                        const f32x4 o = xv + gv[bj][n] * acc[ai][bj][m][n];
                        ss += o.x * o.x + o.y * o.y + o.z * o.z + o.w * o.w;
                        *(f32x4*)(out + off + bj * 128 + n * 16) = o; }
                ss += __shfl_xor(ss, 16); ss += __shfl_xor(ss, 32);
                if (fq == 0) pss[(size_t)row * 16 + u.pn * 4 + wc] = ss; }
    }
};
struct EpiH {
    static constexpr bool PERM = true; bf16_t* H;
    __device__ __forceinline__ void operator()(AccRef acc, const pg8::Unit& u, int wr, int wc, int fr, int fq) const {
        const int row0 = u.pm * 256 + wr * 64 + fr, col0 = u.pn * 128 + wc * 32 + 8 * fq;
#pragma unroll
        for (int ai = 0; ai < 2; ++ai)
#pragma unroll
            for (int m = 0; m < 4; ++m) { bf16_t* rowp = H + (size_t)(row0 + ai * 128 + m * 16) * 512 + col0;
                float h[8];
#pragma unroll
                for (int n = 0; n < 2; ++n)
#pragma unroll
                    for (int j = 0; j < 4; ++j) { const float g = acc[ai][0][m][n][j], up = acc[ai][1][m][n][j]; h[n * 4 + j] = siluf(g) * up; }
                u32x4 o; o.x = pk2(h[0], h[1]); o.y = pk2(h[2], h[3]); o.z = pk2(h[4], h[5]); o.w = pk2(h[6], h[7]);
                *(u32x4*)rowp = o; }
    }
};
struct EpiY {
    static constexpr bool PERM = true; bf16_t* Y;
    __device__ __forceinline__ void operator()(AccRef acc, const pg8::Unit& u, int wr, int wc, int fr, int fq) const {
        const int row0 = u.pm * 256 + wr * 64 + fr, col0 = u.pn * 256 + wc * 32 + 8 * fq;
#pragma unroll
        for (int ai = 0; ai < 2; ++ai)
#pragma unroll
            for (int m = 0; m < 4; ++m) { bf16_t* rowp = Y + (size_t)(row0 + ai * 128 + m * 16) * D + col0;
#pragma unroll
                for (int bj = 0; bj < 2; ++bj) { const f32x4 v0 = acc[ai][bj][m][0], v1 = acc[ai][bj][m][1];
                    u32x4 o; o.x = pk2(v0[0], v0[1]); o.y = pk2(v0[2], v0[3]); o.z = pk2(v1[0], v1[1]); o.w = pk2(v1[2], v1[3]);
                    *(u32x4*)(rowp + bj * 128) = o; } }
    }
};

__device__ __forceinline__ void p0_mod_item(const P& p, LAS unsigned char* lds, int item) {
    LAS float* SV = (LAS float*)lds; LAS float* PS = (LAS float*)(lds + 20480);
    const int tid = threadIdx.x;
    for (int i = tid; i < 5 * 1024; i += NTHR) { const int v = i >> 10, k = i & 1023; const float c = v < 4 ? p.in[1][v * 1024 + k] : p.in[3][k]; SV[i] = c / (1.f + expf(-c)); }
    __syncthreads();
    const int col = tid & 31, kq = tid >> 5, n = item * 32 + col;
    float acc[5] = {0.f, 0.f, 0.f, 0.f, 0.f};
    const float* W = p.in[4] + (size_t)(kq * 64) * 6144 + n;
#pragma unroll 8
    for (int k = 0; k < 64; ++k) { const float w = W[(size_t)k * 6144]; const int kk = kq * 64 + k;
#pragma unroll
        for (int v = 0; v < 5; ++v) acc[v] += SV[v * 1024 + kk] * w; }
#pragma unroll
    for (int v = 0; v < 5; ++v) PS[(kq * 5 + v) * 32 + col] = acc[v];
    __syncthreads();
    if (tid < 160) { const int v = tid >> 5, c = tid & 31; float s = 0.f;
#pragma unroll
        for (int q = 0; q < 16; ++q) s += PS[(q * 5 + v) * 32 + c];
        ((float*)(p.ws + WS_MOD))[v * 6144 + item * 32 + c] = s + p.in[5][item * 32 + c]; }
    __syncthreads();
}
template <class RowMap>
__device__ __forceinline__ void transpose_item(const float* W, int K, int N, bf16_t* WT, LAS float* scr, int kb, int nb, int lane, RowMap rm) {
    const int k0 = 64 * kb, n0 = 32 * nb;
#pragma unroll 8
    for (int i = 0; i < 32; ++i) { const int kk = 2 * i + (lane >> 5), n = n0 + (lane & 31); scr[kk * 33 + (lane & 31)] = n < N ? W[(size_t)(k0 + kk) * N + n] : 0.f; }
    asm volatile("s_waitcnt lgkmcnt(0)" ::: "memory");
    const int c = lane & 7;
#pragma unroll
    for (int j = 0; j < 4; ++j) { const int nl = (lane >> 3) + 8 * j, n = n0 + nl;
        if (n < N) { const LAS float* s = scr + (8 * c) * 33 + nl;
            u32x4 o; o.x = pk2(s[0 * 33], s[1 * 33]); o.y = pk2(s[2 * 33], s[3 * 33]); o.z = pk2(s[4 * 33], s[5 * 33]); o.w = pk2(s[6 * 33], s[7 * 33]);
            *(u32x4*)(WT + (size_t)rm(n) * K + k0 + 8 * c) = o; } }
    asm volatile("s_waitcnt lgkmcnt(0)" ::: "memory");
}
struct RmIn { __device__ __forceinline__ int operator()(int n) const { return n < 1536 ? n : (n < 1568 ? n + 2048 : (n < 3616 ? n - 32 : n)); } };
struct RmId { __device__ __forceinline__ int operator()(int n) const { return n; } };
struct RmE1 { __device__ __forceinline__ int operator()(int n) const { const int half = n >> 9, r = n & 511; return (r >> 7) * 256 + half * 128 + (r & 127); } };

__device__ __forceinline__ void phase0(const P& p, LAS unsigned char* lds) {
    const int tid = threadIdx.x, lane = tid & 63, wave = tid >> 6;
    for (int it = blockIdx.x; it < 192; it += gridDim.x) p0_mod_item(p, lds, it);
    LAS float* scr = (LAS float*)(lds + wave * 16384);
    const int gw = blockIdx.x * 8 + wave, NGW = gridDim.x * 8;
    constexpr int I_IN = 16 * 114, I_OUT = 16 * 32, I_E1 = 32 * 16 * 32, NIT = I_IN + I_OUT + I_E1;
    bf16_t* WINT = (bf16_t*)(p.ws + WS_WINT); bf16_t* WOUTT = (bf16_t*)(p.ws + WS_WOUTT); bf16_t* E1T = (bf16_t*)(p.ws + WS_E1T);
    for (int it = gw; it < NIT; it += NGW) {
        int r = it;
        if (r < I_IN) { transpose_item(p.in[7], 1024, INW, WINT, scr, r / 114, r % 114, lane, RmIn()); continue; } r -= I_IN;
        if (r < I_OUT) { transpose_item(p.in[16], 1024, 1024, WOUTT, scr, r >> 5, r & 31, lane, RmId()); continue; } r -= I_OUT;
        { const int e = r >> 9, q = r & 511; transpose_item(p.in[22] + (size_t)e * 1024 * 1024, 1024, 1024, E1T + (size_t)e * 1024 * 1024, scr, q >> 5, q & 31, lane, RmE1()); }
    }
    for (int i = blockIdx.x * NTHR + tid; i < 208 * 128; i += gridDim.x * NTHR) ((u32x4*)(WINT + (size_t)INW * 1024))[i] = (u32x4){0u, 0u, 0u, 0u};
}

__device__ __forceinline__ void phase1(const P& p) {
    const int tid = threadIdx.x, lane = tid & 63, wave = tid >> 6;
    const float* mod = (const float*)(p.ws + WS_MOD); bf16_t* A = (bf16_t*)(p.ws + WS_A);
    const int gw = blockIdx.x * 8 + wave, NGW = gridDim.x * 8;
    for (int r0 = gw * 2; r0 < MT; r0 += NGW * 2) {
        f32x4 v[2][4]; float ss[2];
#pragma unroll
        for (int q = 0; q < 2; ++q) { const int row = r0 + q; const float* src = row < MX ? p.in[0] + (size_t)row * D : p.in[2] + (size_t)(row - MX) * D;
#pragma unroll
            for (int j = 0; j < 4; ++j) v[q][j] = *(const f32x4*)(src + 4 * lane + 256 * j); }
#pragma unroll
        for (int q = 0; q < 2; ++q) { float s0 = 0.f;
#pragma unroll
            for (int j = 0; j < 4; ++j) s0 += v[q][j].x * v[q][j].x + v[q][j].y * v[q][j].y + v[q][j].z * v[q][j].z + v[q][j].w * v[q][j].w;
            ss[q] = wave_sum(s0); }
#pragma unroll
        for (int q = 0; q < 2; ++q) { const int row = r0 + q; const float rstd = 1.f / sqrtf(ss[q] * (1.f / D) + EPS);
            const float* mv = mod + (size_t)(row < MX ? (row >> 12) : 4) * 6144;
#pragma unroll
            for (int j = 0; j < 4; ++j) { const int k = 4 * lane + 256 * j;
                const f32x4 g = *(const f32x4*)(p.in[6] + k), sh = *(const f32x4*)(mv + k), sc = *(const f32x4*)(mv + 1024 + k);
                const f32x4 o = (v[q][j] * rstd * g) * (sc + 1.f) + sh;
                u32x2 w; w.x = pk2(o.x, o.y); w.y = pk2(o.z, o.w);
                *(u32x2*)(A + (size_t)row * D + k) = w; } }
    }
}

struct ConvItem { int rowbase, y, H, W, x0, valid; };
__device__ __forceinline__ ConvItem conv_item(int it) {
    ConvItem c; const int r = it >> 3; c.valid = it < 2176;
    if (r < 256) { c.rowbase = (r >> 6) * 4096; c.y = r & 63; c.H = 64; c.W = 64; c.x0 = 0; }
    else { const int ci = r - 256; c.rowbase = MX + (ci >> 2) * 256; c.y = 0; c.H = 1; c.W = 256; c.x0 = (ci & 3) * 64; }
    return c;
}
__device__ __forceinline__ void conv_load(const bf16_t* Z, const ConvItem& c, int sl, int tid, u32x4 (&rg)[6], u32x4& halo) {
    const u32x4 z4 = {0u, 0u, 0u, 0u};
#pragma unroll
    for (int i = 0; i < 6; ++i) { const int q = tid + NTHR * i, dy = q >> 10, x = (q >> 4) & 63, cg = q & 15, yy = c.y + dy - 1;
        rg[i] = (c.valid && yy >= 0 && yy < c.H) ? *(const u32x4*)(Z + (size_t)(c.rowbase + yy * c.W + c.x0 + x) * ZLD + 1536 + sl * 128 + cg * 8) : z4; }
    halo = z4;
    if (tid < 32 && c.valid) { const int side = tid >> 4, cg = tid & 15, xx = side ? c.x0 + 64 : c.x0 - 1;
        if (xx >= 0 && xx < c.W) halo = *(const u32x4*)(Z + (size_t)(c.rowbase + c.y * c.W + xx) * ZLD + 1536 + sl * 128 + cg * 8); }
}
__device__ __forceinline__ void phase3(const P& p, LAS unsigned char* lds) {
    const bf16_t* Z = (const bf16_t*)(p.ws + WS_Z); bf16_t* MQ = (bf16_t*)(p.ws + WS_MQ); bf16_t* MK = (bf16_t*)(p.ws + WS_MK);
    const int tid = threadIdx.x, cg = tid & 15, xt = tid >> 4;
    LAS bf16_t* T = (LAS bf16_t*)lds;
    int it = blockIdx.x; if (it >= 2176) return;
    int sl = it & 7;
    float w[9][8], bias[8];
    int wsl = -1;
    u32x4 rg[6], halo;
    ConvItem cur = conv_item(it);
    conv_load(Z, cur, sl, tid, rg, halo);
    for (; it < 2176; it += gridDim.x) {
        sl = it & 7;
        if (sl != wsl) { wsl = sl;
#pragma unroll
            for (int a = 0; a < 9; ++a) { const f32x4 w0 = *(const f32x4*)(p.in[11] + a * 1024 + sl * 128 + cg * 8), w1 = *(const f32x4*)(p.in[11] + a * 1024 + sl * 128 + cg * 8 + 4);
                w[a][0] = w0.x; w[a][1] = w0.y; w[a][2] = w0.z; w[a][3] = w0.w; w[a][4] = w1.x; w[a][5] = w1.y; w[a][6] = w1.z; w[a][7] = w1.w; }
            const f32x4 b0 = *(const f32x4*)(p.in[12] + sl * 128 + cg * 8), b1 = *(const f32x4*)(p.in[12] + sl * 128 + cg * 8 + 4);
            bias[0] = b0.x; bias[1] = b0.y; bias[2] = b0.z; bias[3] = b0.w; bias[4] = b1.x; bias[5] = b1.y; bias[6] = b1.z; bias[7] = b1.w; }
#pragma unroll
        for (int i = 0; i < 6; ++i) { const int q = tid + NTHR * i, dy = q >> 10, x = (q >> 4) & 63, c2 = q & 15; *(LAS u32x4*)(T + ((dy * 66 + x + 1) * 128 + c2 * 8)) = rg[i]; }
        if (tid < 32) { const int side = tid >> 4, c2 = tid & 15; *(LAS u32x4*)(T + ((66 + (side ? 65 : 0)) * 128 + c2 * 8)) = halo; }
        else if (tid < 96) { const int q = tid - 32, dy = (q >> 5) * 2, side = (q >> 4) & 1, c2 = q & 15; *(LAS u32x4*)(T + ((dy * 66 + (side ? 65 : 0)) * 128 + c2 * 8)) = (u32x4){0u, 0u, 0u, 0u}; }
        __syncthreads();
        const ConvItem me = cur; const int msl = sl;
        { const int nit = it + gridDim.x; cur = conv_item(nit); conv_load(Z, cur, nit & 7, tid, rg, halo); }
        const float osc = msl >= 4 ? 0.08838834764831845f : 1.f;
        bf16_t* dst = msl >= 4 ? MK : MQ;
#pragma unroll
        for (int hx = 0; hx < 2; ++hx) { const int x = xt + 32 * hx;
            float acc[8];
#pragma unroll
            for (int j = 0; j < 8; ++j) acc[j] = bias[j];
#pragma unroll
            for (int dy = 0; dy < 3; ++dy)
#pragma unroll
                for (int dx = 0; dx < 3; ++dx) { const u32x4 v = *(const LAS u32x4*)(T + ((dy * 66 + x + dx) * 128 + cg * 8));
                    acc[0] += w[dy * 3 + dx][0] * bflo(v.x); acc[1] += w[dy * 3 + dx][1] * bfhi(v.x);
                    acc[2] += w[dy * 3 + dx][2] * bflo(v.y); acc[3] += w[dy * 3 + dx][3] * bfhi(v.y);
                    acc[4] += w[dy * 3 + dx][4] * bflo(v.z); acc[5] += w[dy * 3 + dx][5] * bfhi(v.z);
                    acc[6] += w[dy * 3 + dx][6] * bflo(v.w); acc[7] += w[dy * 3 + dx][7] * bfhi(v.w); }
#pragma unroll
            for (int j = 0; j < 8; ++j) acc[j] = siluf(acc[j]) * osc;
            u32x4 o; o.x = pk2(acc[0], acc[1]); o.y = pk2(acc[2], acc[3]); o.z = pk2(acc[4], acc[5]); o.w = pk2(acc[6], acc[7]);
            *(u32x4*)(dst + (size_t)(me.rowbase + me.y * me.W + me.x0 + x) * 512 + (msl & 3) * 128 + cg * 8) = o; }
        __syncthreads();
    }
}

__device__ __forceinline__ int chunk_tok0(int b, int tc) { return tc < 64 ? b * SEQ + tc * 64 : MX + b * CTXL + (tc - 64) * 64; }

__device__ __forceinline__ void load_v(const bf16_t* Z, int tok0, int col0, LAS bf16_t* V, int tid) {
#pragma unroll
    for (int i = 0; i < 2; ++i) { const int idx = tid + NTHR * i, t = idx >> 4, c = idx & 15;
        *(LAS u32x4*)(V + t * 136 + c * 8) = *(const u32x4*)(Z + (size_t)(tok0 + t) * ZLD + col0 + c * 8); }
}
__device__ __forceinline__ bf16x8 ldfrag_t(const LAS bf16_t* T, int ld, int k0, int n0, int lane) {
    const LAS bf16_t* q = T + (k0 + 8 * (lane >> 5)) * ld + n0 + (lane & 31);
    bf16x8 f;
#pragma unroll
    for (int j = 0; j < 8; ++j) f[j] = (short)q[j * ld];
    return f;
}

struct G4Regs { u32x4 v[2]; u32x4 k; f32x4 glr; };
struct M4Regs { u32x4 v[2]; u32x4 k[2]; float gi, gf; };
__device__ __forceinline__ void item_bhc(int r, int& b, int& h, int& tc) { b = r / (4 * NCH); h = (r / NCH) & 3; tc = r % NCH; }

__device__ __forceinline__ void g4_load(const P& p, int r, int tid, G4Regs& R) {
    int b, h, tc; item_bhc(r, b, h, tc); const int tok0 = chunk_tok0(b, tc);
    const bf16_t* Z = (const bf16_t*)(p.ws + WS_Z); const float* GT = (const float*)(p.ws + WS_GATES);
#pragma unroll
    for (int i = 0; i < 2; ++i) { const int idx = tid + NTHR * i, t = idx >> 4, c = idx & 15; R.v[i] = *(const u32x4*)(Z + (size_t)(tok0 + t) * ZLD + 512 + h * 128 + c * 8); }
    const int t = tid >> 3, c = tid & 7;
    R.glr = *(const f32x4*)(GT + (size_t)(tok0 + t) * 48 + c * 4);
    R.k = *(const u32x4*)(Z + (size_t)(tok0 + t) * ZLD + 256 + h * 64 + c * 8);
}
__device__ __forceinline__ void p4_gla(const P& p, LAS unsigned char* lds, int r, G4Regs& R, int rnext) {
    const int tid = threadIdx.x, lane = tid & 63, wave = __builtin_amdgcn_readfirstlane(tid >> 6);
    int b, h, tc; item_bhc(r, b, h, tc);
    const int sidx = (b * 4 + h) * NCH + tc;
    LAS bf16_t* V = (LAS bf16_t*)lds; LAS bf16_t* KW = (LAS bf16_t*)(lds + 17408); LAS float* GLR = (LAS float*)(lds + 35840); LAS float* QS = (LAS float*)(lds + 44032);
    LAS bf16_t* KR = (LAS bf16_t*)(lds + 46080); LAS bf16_t* OUT = (LAS bf16_t*)(lds + 55296);
#pragma unroll
    for (int i = 0; i < 2; ++i) { const int idx = tid + NTHR * i, t = idx >> 4, c = idx & 15; *(LAS u32x4*)(V + t * 136 + c * 8) = R.v[i]; }
    { const int t = tid >> 3, c = tid & 7; *(LAS f32x4*)(GLR + t * 32 + c * 4) = R.glr; *(LAS u32x4*)(KR + t * 72 + c * 8) = R.k; }
    __syncthreads();
    if (rnext < NSTATE) g4_load(p, rnext, tid, R);
    const int dir = tid >> 8, tq = (tid >> 6) & 3, d = tid & 63;
    float upw[16];
#pragma unroll
    for (int q = 0; q < 16; ++q) upw[q] = p.in[8][(dir * 16 + q) * 256 + h * 64 + d];
    const float upb = p.in[9][dir * 256 + h * 64 + d];
    float la[16]; float tot = 0.f;
#pragma unroll
    for (int i = 0; i < 16; ++i) { const int t = tq * 16 + i; float lg = upb;
#pragma unroll
        for (int q = 0; q < 16; ++q) lg += GLR[t * 32 + dir * 16 + q] * upw[q];
        la[i] = logsigf(lg) * 0.0625f; tot += la[i]; }
    QS[(dir * 4 + tq) * 64 + d] = tot;
    __syncthreads();
    float before = 0.f, all = 0.f;
#pragma unroll
    for (int q = 0; q < 4; ++q) { const float v = QS[(dir * 4 + q) * 64 + d]; all += v; before += (q < tq) ? v : 0.f; }
    float run = before;
#pragma unroll
    for (int i = 0; i < 16; ++i) { const int t = tq * 16 + i;
        const float kx = bf2f(KR[t * 72 + d]);
        float e; if (dir == 0) { run += la[i]; e = all - run; } else { e = run; run += la[i]; }
        KW[(dir * 64 + t) * 72 + d] = (bf16_t)f2bf(kx * __expf(e)); }
    if (tq == 0) ((float*)(p.ws + WS_GDEC))[(sidx * 2 + dir) * 64 + d] = __expf(all);
    __syncthreads();
    const int dw = wave >> 2, vt = wave & 3;
    f32x16 acc0, acc1;
#pragma unroll
    for (int q = 0; q < 16; ++q) { acc0[q] = 0.f; acc1[q] = 0.f; }
#pragma unroll
    for (int ks = 0; ks < 4; ++ks) { const bf16x8 a = ldfrag_t(V, 136, ks * 16, vt * 32, lane);
        const bf16x8 b0 = ldfrag_t(KW + dw * 64 * 72, 72, ks * 16, 0, lane), b1 = ldfrag_t(KW + dw * 64 * 72, 72, ks * 16, 32, lane);
        acc0 = MFMA32(a, b0, acc0); acc1 = MFMA32(a, b1, acc1); }
#pragma unroll
    for (int q = 0; q < 16; ++q) { const int v = vt * 32 + crow(q, lane); OUT[(dw * 128 + v) * 72 + (lane & 31)] = (bf16_t)f2bf(acc0[q]); OUT[(dw * 128 + v) * 72 + 32 + (lane & 31)] = (bf16_t)f2bf(acc1[q]); }
    __syncthreads();
    bf16_t* U = (bf16_t*)(p.ws + WS_UG) + (size_t)(sidx * 2) * 8192;
#pragma unroll
    for (int i = 0; i < 4; ++i) { const int idx = tid + NTHR * i, row = idx >> 3, c = idx & 7; *(u32x4*)(U + (size_t)row * 64 + c * 8) = *(const LAS u32x4*)(OUT + row * 72 + c * 8); }
    __syncthreads();
}

__device__ __forceinline__ void m4_load(const P& p, int r, int tid, M4Regs& R) {
    int b, h, tc; item_bhc(r, b, h, tc); const int tok0 = chunk_tok0(b, tc);
    const bf16_t* Z = (const bf16_t*)(p.ws + WS_Z); const bf16_t* MK = (const bf16_t*)(p.ws + WS_MK);
#pragma unroll
    for (int i = 0; i < 2; ++i) { const int idx = tid + NTHR * i, t = idx >> 4, c = idx & 15;
        R.v[i] = *(const u32x4*)(Z + (size_t)(tok0 + t) * ZLD + 2560 + h * 128 + c * 8);
        R.k[i] = *(const u32x4*)(MK + (size_t)(tok0 + t) * 512 + h * 128 + c * 8); }
    R.gi = 0.f; R.gf = 0.f;
    if (tid < 128) { const int dir = tid >> 6, t = tid & 63; const float* g = (const float*)(p.ws + WS_GATES) + (size_t)(tok0 + t) * 48; R.gi = g[32 + dir * 4 + h]; R.gf = g[40 + dir * 4 + h]; }
}
__device__ __forceinline__ void p4_ml(const P& p, LAS unsigned char* lds, int r, M4Regs& R, int rnext) {
    const int tid = threadIdx.x, lane = tid & 63, wave = __builtin_amdgcn_readfirstlane(tid >> 6);
    int b, h, tc; item_bhc(r, b, h, tc);
    const int sidx = (b * 4 + h) * NCH + tc;
    LAS bf16_t* V = (LAS bf16_t*)lds; LAS bf16_t* KW = (LAS bf16_t*)(lds + 17408);
    LAS float* IG = (LAS float*)(lds + 52224); LAS float* LF = IG + 128; LAS float* KG = IG + 256;
    LAS bf16_t* KR = (LAS bf16_t*)(lds + 53760); LAS bf16_t* OUT = (LAS bf16_t*)(lds + 71168);
#pragma unroll
    for (int i = 0; i < 2; ++i) { const int idx = tid + NTHR * i, t = idx >> 4, c = idx & 15; *(LAS u32x4*)(V + t * 136 + c * 8) = R.v[i]; *(LAS u32x4*)(KR + t * 136 + c * 8) = R.k[i]; }
    if (tid < 128) { const int dir = tid >> 6, t = tid & 63; IG[dir * 64 + t] = R.gi + p.in[13][dir * 4 + h]; LF[dir * 64 + t] = logsigf(R.gf + p.in[14][dir * 4 + h]); }
    __syncthreads();
    if (rnext < NSTATE) m4_load(p, rnext, tid, R);
    if (tid < 128) { const int dir = tid >> 6, t = tid & 63;
        const float lf = LF[dir * 64 + t], a = scan_sum_up(lf, t), tot = __shfl(a, 63);
        const float g = (dir == 0 ? tot - a : a - lf) + IG[dir * 64 + t];
        const float ml = wave_max(g);
        KG[dir * 64 + t] = __expf(g - ml);
        if (t == 0) { float* sc = (float*)(p.ws + WS_MSC) + (size_t)(sidx * 2 + dir) * 4; sc[0] = tot; sc[1] = ml; } }
    __syncthreads();
    { const int dir = tid >> 8, th = (tid >> 7) & 1, d = tid & 127;
#pragma unroll 8
        for (int i = 0; i < 32; ++i) { const int t = th * 32 + i; const float kx = bf2f(KR[t * 136 + d]);
            KW[(dir * 64 + t) * 136 + d] = (bf16_t)f2bf(kx * KG[dir * 64 + t]); } }
    __syncthreads();
    if (tid < 256) { const int dir = tid >> 7, d = tid & 127; float s0 = 0.f;
#pragma unroll 16
        for (int t = 0; t < 64; ++t) s0 += bf2f(KW[(dir * 64 + t) * 136 + d]);
        ((float*)(p.ws + WS_MN))[(size_t)(sidx * 2 + dir) * 128 + d] = s0; }
    const int dw = wave >> 2, vt = wave & 3;
    f32x16 acc[4];
#pragma unroll
    for (int q = 0; q < 4; ++q)
#pragma unroll
        for (int x = 0; x < 16; ++x) acc[q][x] = 0.f;
#pragma unroll
    for (int ks = 0; ks < 4; ++ks) { const bf16x8 a = ldfrag_t(V, 136, ks * 16, vt * 32, lane);
#pragma unroll
        for (int q = 0; q < 4; ++q) { const bf16x8 bq = ldfrag_t(KW + dw * 64 * 136, 136, ks * 16, q * 32, lane); acc[q] = MFMA32(a, bq, acc[q]); } }
#pragma unroll
    for (int q = 0; q < 4; ++q)
#pragma unroll
        for (int x = 0; x < 16; ++x) { const int v = vt * 32 + crow(x, lane); OUT[(dw * 128 + v) * 136 + q * 32 + (lane & 31)] = (bf16_t)f2bf(acc[q][x]); }
    __syncthreads();
    bf16_t* U = (bf16_t*)(p.ws + WS_UM) + (size_t)(sidx * 2) * 16384;
#pragma unroll
    for (int i = 0; i < 8; ++i) { const int idx = tid + NTHR * i, row = idx >> 4, c = idx & 15; *(u32x4*)(U + (size_t)row * 128 + c * 8) = *(const LAS u32x4*)(OUT + row * 136 + c * 8); }
    __syncthreads();
}

__device__ __forceinline__ void phase4(const P& p, LAS unsigned char* lds) {
    const int tid = threadIdx.x;
    { G4Regs R; int r = blockIdx.x; if (r < NSTATE) g4_load(p, r, tid, R);
        for (; r < NSTATE; r += gridDim.x) p4_gla(p, lds, r, R, r + gridDim.x); }
    { M4Regs R; int r = (blockIdx.x + NSTATE % gridDim.x) % gridDim.x; if (r < NSTATE) m4_load(p, r, tid, R);
        for (; r < NSTATE; r += gridDim.x) p4_ml(p, lds, r, R, r + gridDim.x); }
}

__device__ __forceinline__ int tc_of(int c, int dir) { return dir == 0 ? (c < 4 ? 64 + c : c - 4) : (c < 4 ? 67 - c : 67 - c); }

__device__ __forceinline__ void phase5(const P& p) {
    const int gtid = blockIdx.x * NTHR + threadIdx.x, nthr = gridDim.x * NTHR;
    constexpr int PF = 8;
    for (int task = gtid; task < 32768 + 65536 + 512; task += nthr) {
        if (task < 32768) {
            const int chain = task >> 10, e8 = task & 1023, bh = chain >> 1, dir = chain & 1, d0 = (e8 & 7) * 8;
            bf16_t* UG = (bf16_t*)(p.ws + WS_UG); const float* GD = (const float*)(p.ws + WS_GDEC);
            float s[8];
#pragma unroll
            for (int j = 0; j < 8; ++j) s[j] = 0.f;
            u32x4 ub[PF]; f32x4 da[PF], db[PF];
#pragma unroll
            for (int i = 0; i < PF; ++i) { const int si = (bh * NCH + tc_of(i, dir)) * 2 + dir;
                ub[i] = *(const u32x4*)(UG + (size_t)si * 8192 + e8 * 8); da[i] = *(const f32x4*)(GD + si * 64 + d0); db[i] = *(const f32x4*)(GD + si * 64 + d0 + 4); }
            for (int c0 = 0; c0 < NCH; c0 += PF) {
#pragma unroll
                for (int i = 0; i < PF; ++i) { const int c = c0 + i; if (c < NCH) { const int si = (bh * NCH + tc_of(c, dir)) * 2 + dir;
                    const u32x4 u = ub[i]; const f32x4 a = da[i], bq = db[i];
                    if (c + PF < NCH) { const int sn = (bh * NCH + tc_of(c + PF, dir)) * 2 + dir;
                        ub[i] = *(const u32x4*)(UG + (size_t)sn * 8192 + e8 * 8); da[i] = *(const f32x4*)(GD + sn * 64 + d0); db[i] = *(const f32x4*)(GD + sn * 64 + d0 + 4); }
                    u32x4 o; o.x = pk2(s[0], s[1]); o.y = pk2(s[2], s[3]); o.z = pk2(s[4], s[5]); o.w = pk2(s[6], s[7]);
                    *(u32x4*)(UG + (size_t)si * 8192 + e8 * 8) = o;
                    s[0] = a.x * s[0] + bflo(u.x); s[1] = a.y * s[1] + bfhi(u.x); s[2] = a.z * s[2] + bflo(u.y); s[3] = a.w * s[3] + bfhi(u.y);
                    s[4] = bq.x * s[4] + bflo(u.z); s[5] = bq.y * s[5] + bfhi(u.z); s[6] = bq.z * s[6] + bflo(u.w); s[7] = bq.w * s[7] + bfhi(u.w); } }
            }
        } else if (task < 98304) {
            const int tk = task - 32768, chain = tk >> 11, e8 = tk & 2047, bh = chain >> 1, dir = chain & 1;
            bf16_t* UM = (bf16_t*)(p.ws + WS_UM); float* SC = (float*)(p.ws + WS_MSC);
            float s[8];
#pragma unroll
            for (int j = 0; j < 8; ++j) s[j] = 0.f;
            float m = 0.f;
            u32x4 ub[PF]; float ae[PF], ml[PF];
#pragma unroll
            for (int i = 0; i < PF; ++i) { const int si = (bh * NCH + tc_of(i, dir)) * 2 + dir;
                ub[i] = *(const u32x4*)(UM + (size_t)si * 16384 + e8 * 8); ae[i] = SC[si * 4 + 0]; ml[i] = SC[si * 4 + 1]; }
            for (int c0 = 0; c0 < NCH; c0 += PF) {
#pragma unroll
                for (int i = 0; i < PF; ++i) { const int c = c0 + i; if (c < NCH) { const int si = (bh * NCH + tc_of(c, dir)) * 2 + dir;
                    const u32x4 u = ub[i]; const float aend = ae[i], mloc = ml[i];
                    if (c + PF < NCH) { const int sn = (bh * NCH + tc_of(c + PF, dir)) * 2 + dir;
                        ub[i] = *(const u32x4*)(UM + (size_t)sn * 16384 + e8 * 8); ae[i] = SC[sn * 4 + 0]; ml[i] = SC[sn * 4 + 1]; }
                    u32x4 o; o.x = pk2(s[0], s[1]); o.y = pk2(s[2], s[3]); o.z = pk2(s[4], s[5]); o.w = pk2(s[6], s[7]);
                    *(u32x4*)(UM + (size_t)si * 16384 + e8 * 8) = o;
                    if (e8 == 0) SC[si * 4 + 2] = m;
                    const float mn = fmaxf(aend + m, mloc), f1 = __expf(aend + m - mn), f2 = __expf(mloc - mn); m = mn;
                    s[0] = f1 * s[0] + f2 * bflo(u.x); s[1] = f1 * s[1] + f2 * bfhi(u.x); s[2] = f1 * s[2] + f2 * bflo(u.y); s[3] = f1 * s[3] + f2 * bfhi(u.y);
                    s[4] = f1 * s[4] + f2 * bflo(u.z); s[5] = f1 * s[5] + f2 * bfhi(u.z); s[6] = f1 * s[6] + f2 * bflo(u.w); s[7] = f1 * s[7] + f2 * bfhi(u.w); } }
            }
        } else {
            const int tk = task - 98304, chain = tk >> 4, part = tk & 15, bh = chain >> 1, dir = chain & 1;
            float* MN = (float*)(p.ws + WS_MN); const float* SC = (const float*)(p.ws + WS_MSC);
            f32x4 n0 = {0.f, 0.f, 0.f, 0.f}, n1 = {0.f, 0.f, 0.f, 0.f}; float m = 0.f;
            f32x4 p0[PF], p1[PF]; float ae[PF], ml[PF];
#pragma unroll
            for (int i = 0; i < PF; ++i) { const int si = (bh * NCH + tc_of(i, dir)) * 2 + dir; const float* np = MN + (size_t)si * 128 + part * 8;
                p0[i] = *(const f32x4*)np; p1[i] = *(const f32x4*)(np + 4); ae[i] = SC[si * 4 + 0]; ml[i] = SC[si * 4 + 1]; }
            for (int c0 = 0; c0 < NCH; c0 += PF) {
#pragma unroll
                for (int i = 0; i < PF; ++i) { const int c = c0 + i; if (c < NCH) { const int si = (bh * NCH + tc_of(c, dir)) * 2 + dir;
                    const f32x4 u0 = p0[i], u1 = p1[i]; const float aend = ae[i], mloc = ml[i];
                    if (c + PF < NCH) { const int sn = (bh * NCH + tc_of(c + PF, dir)) * 2 + dir; const float* nq = MN + (size_t)sn * 128 + part * 8;
                        p0[i] = *(const f32x4*)nq; p1[i] = *(const f32x4*)(nq + 4); ae[i] = SC[sn * 4 + 0]; ml[i] = SC[sn * 4 + 1]; }
                    float* np = MN + (size_t)si * 128 + part * 8;
                    *(f32x4*)np = n0; *(f32x4*)(np + 4) = n1;
                    const float mn = fmaxf(aend + m, mloc), f1 = __expf(aend + m - mn), f2 = __expf(mloc - mn); m = mn;
                    n0 = n0 * f1 + u0 * f2; n1 = n1 * f1 + u1 * f2; } }
            }
        }
    }
}

template <bool SIG>
__device__ __forceinline__ void head_norm_store(const P& p, const LAS float* O, const LAS bf16_t* GTt, const LAS float* GN, int tok0, int h, int mixcol, int tid) {
    bf16_t* MIX = (bf16_t*)(p.ws + WS_A);
    const int t = tid >> 3, seg = tid & 7;
    float o[16]; float ss = 0.f;
#pragma unroll
    for (int j = 0; j < 16; ++j) { o[j] = O[t * 132 + seg * 16 + j]; ss += o[j] * o[j]; }
    ss += __shfl_xor(ss, 1); ss += __shfl_xor(ss, 2); ss += __shfl_xor(ss, 4);
    const float rstd = 1.f / sqrtf(ss * (1.f / 128.f) + EPS);
    const u32x4 g0 = *(const LAS u32x4*)(GTt + t * 128 + seg * 16), g1 = *(const LAS u32x4*)(GTt + t * 128 + seg * 16 + 8);
    float gt[16];
    gt[0] = bflo(g0.x); gt[1] = bfhi(g0.x); gt[2] = bflo(g0.y); gt[3] = bfhi(g0.y); gt[4] = bflo(g0.z); gt[5] = bfhi(g0.z); gt[6] = bflo(g0.w); gt[7] = bfhi(g0.w);
    gt[8] = bflo(g1.x); gt[9] = bfhi(g1.x); gt[10] = bflo(g1.y); gt[11] = bfhi(g1.y); gt[12] = bflo(g1.z); gt[13] = bfhi(g1.z); gt[14] = bflo(g1.w); gt[15] = bfhi(g1.w);
    float r[16];
#pragma unroll
    for (int j = 0; j < 16; ++j) { const float gg = SIG ? sigmf(gt[j]) : siluf(gt[j]); r[j] = o[j] * rstd * GN[seg * 16 + j] * gg; }
    u32x4 w0, w1; w0.x = pk2(r[0], r[1]); w0.y = pk2(r[2], r[3]); w0.z = pk2(r[4], r[5]); w0.w = pk2(r[6], r[7]);
    w1.x = pk2(r[8], r[9]); w1.y = pk2(r[10], r[11]); w1.z = pk2(r[12], r[13]); w1.w = pk2(r[14], r[15]);
    bf16_t* dst = MIX + (size_t)(tok0 + t) * D + mixcol + h * 128 + seg * 16;
    *(u32x4*)dst = w0; *(u32x4*)(dst + 8) = w1;
}
__device__ __forceinline__ void load_gate_tile(const P& p, int tok0, int gcol, int h, const float* gain, LAS bf16_t* GTt, LAS float* GN, int tid) {
    const bf16_t* Z = (const bf16_t*)(p.ws + WS_Z);
#pragma unroll
    for (int i = 0; i < 2; ++i) { const int idx = tid + NTHR * i, t = idx >> 4, c = idx & 15;
        *(LAS u32x4*)(GTt + t * 128 + c * 8) = *(const u32x4*)(Z + (size_t)(tok0 + t) * ZLD + gcol + h * 128 + c * 8); }
    if (tid < 32) *(LAS f32x4*)(GN + tid * 4) = *(const f32x4*)(gain + h * 128 + tid * 4);
}

struct G6Regs { u32x4 v[2]; u32x4 st[4]; u32x4 gt[2]; u32x4 q, k; f32x4 glr, gn; };
struct M6Regs { u32x4 q[2], k[2], v[2]; u32x4 gt[2]; f32x4 gn; float gi, gf, nv; };
__device__ __forceinline__ void item_bhj(int it, int& b, int& h, int& j) { b = it >> 8; h = (it >> 6) & 3; j = it & 63; }

__device__ __forceinline__ void g6_load(const P& p, int it, int tid, G6Regs& R) {
    int b, h, j; item_bhj(it, b, h, j); const int tok0 = b * SEQ + j * 64, sidx = (b * 4 + h) * NCH + j;
    const bf16_t* Z = (const bf16_t*)(p.ws + WS_Z); const float* GT = (const float*)(p.ws + WS_GATES);
#pragma unroll
    for (int i = 0; i < 2; ++i) { const int idx = tid + NTHR * i, t = idx >> 4, c = idx & 15;
        R.v[i] = *(const u32x4*)(Z + (size_t)(tok0 + t) * ZLD + 512 + h * 128 + c * 8);
        R.gt[i] = *(const u32x4*)(Z + (size_t)(tok0 + t) * ZLD + 1024 + h * 128 + c * 8); }
    const bf16_t* S = (const bf16_t*)(p.ws + WS_UG) + (size_t)(sidx * 2) * 8192;
#pragma unroll
    for (int i = 0; i < 4; ++i) { const int idx = tid + NTHR * i, row = idx >> 3, c = idx & 7; R.st[i] = *(const u32x4*)(S + (size_t)row * 64 + c * 8); }
    const int t = tid >> 3, c = tid & 7;
    R.q = *(const u32x4*)(Z + (size_t)(tok0 + t) * ZLD + h * 64 + c * 8);
    R.k = *(const u32x4*)(Z + (size_t)(tok0 + t) * ZLD + 256 + h * 64 + c * 8);
    R.glr = *(const f32x4*)(GT + (size_t)(tok0 + t) * 48 + c * 4);
    R.gn = *(const f32x4*)(p.in[10] + h * 128 + (tid & 31) * 4);
}
__device__ __forceinline__ void p6_gla(const P& p, LAS unsigned char* lds, int it, G6Regs& R, int itnext) {
    const int tid = threadIdx.x, lane = tid & 63, wave = __builtin_amdgcn_readfirstlane(tid >> 6);
    int b, h, j; item_bhj(it, b, h, j);
    const int tok0 = b * SEQ + j * 64;
    LAS bf16_t* QF = (LAS bf16_t*)lds; LAS bf16_t* QB = QF + 64 * 72; LAS bf16_t* KF = QB + 64 * 72; LAS bf16_t* KB = KF + 64 * 72;
    LAS bf16_t* VT = (LAS bf16_t*)(lds + 36864); LAS bf16_t* ST = (LAS bf16_t*)(lds + 55296); LAS bf16_t* PF = (LAS bf16_t*)(lds + 92160); LAS bf16_t* PB = PF + 64 * 72;
    LAS float* GLR = (LAS float*)(lds + 110592); LAS float* QS = (LAS float*)(lds + 118784); LAS float* O = (LAS float*)lds;
    LAS bf16_t* GTt = (LAS bf16_t*)(lds + 120832); LAS float* GN = (LAS float*)(lds + 137216); LAS bf16_t* QR = (LAS bf16_t*)(lds + 137728); LAS bf16_t* KR = (LAS bf16_t*)(lds + 146944);
#pragma unroll
    for (int i = 0; i < 2; ++i) { const int idx = tid + NTHR * i, t = idx >> 4, c = idx & 15; *(LAS u32x4*)(VT + t * 136 + c * 8) = R.v[i]; *(LAS u32x4*)(GTt + t * 128 + c * 8) = R.gt[i]; }
#pragma unroll
    for (int i = 0; i < 4; ++i) { const int idx = tid + NTHR * i, row = idx >> 3, c = idx & 7; *(LAS u32x4*)(ST + row * 72 + c * 8) = R.st[i]; }
    { const int t = tid >> 3, c = tid & 7; *(LAS u32x4*)(QR + t * 72 + c * 8) = R.q; *(LAS u32x4*)(KR + t * 72 + c * 8) = R.k; *(LAS f32x4*)(GLR + t * 32 + c * 4) = R.glr; }
    if (tid < 32) *(LAS f32x4*)(GN + tid * 4) = R.gn;
    __syncthreads();
    if (itnext < 1024) g6_load(p, itnext, tid, R);
    const int dir = tid >> 8, tq = (tid >> 6) & 3, d = tid & 63;
    {
        float upw[16];
#pragma unroll
        for (int r = 0; r < 16; ++r) upw[r] = p.in[8][(dir * 16 + r) * 256 + h * 64 + d];
        const float upb = p.in[9][dir * 256 + h * 64 + d];
        float la[16]; float tot = 0.f;
#pragma unroll
        for (int i = 0; i < 16; ++i) { const int t = tq * 16 + i; float lg = upb;
#pragma unroll
            for (int r = 0; r < 16; ++r) lg += GLR[t * 32 + dir * 16 + r] * upw[r];
            la[i] = logsigf(lg) * 0.0625f; tot += la[i]; }
        QS[(dir * 4 + tq) * 64 + d] = tot;
        __syncthreads();
        float before = 0.f, all = 0.f;
#pragma unroll
        for (int q = 0; q < 4; ++q) { const float v = QS[(dir * 4 + q) * 64 + d]; all += v; before += (q < tq) ? v : 0.f; }
        float run = before;
        LAS bf16_t* Qd = dir == 0 ? QF : QB; LAS bf16_t* Kd = dir == 0 ? KF : KB;
#pragma unroll
        for (int i = 0; i < 16; ++i) { const int t = tq * 16 + i;
            const float qx = bf2f(QR[t * 72 + d]) * 0.125f, kx = bf2f(KR[t * 72 + d]);
            float bb; if (dir == 0) { run += la[i]; bb = run; } else { bb = all - run; run += la[i]; }
            const float eb = __expf(bb);
            Qd[t * 72 + d] = (bf16_t)f2bf(qx * eb); Kd[t * 72 + d] = (bf16_t)f2bf(kx / eb); }
    }
    __syncthreads();
    {
        const int dw = wave >> 2, tt = (wave >> 1) & 1, st = wave & 1;
        const LAS bf16_t* Qd = dw == 0 ? QF : QB; const LAS bf16_t* Kd = dw == 0 ? KF : KB; LAS bf16_t* Pd = dw == 0 ? PF : PB;
        f32x16 acc;
#pragma unroll
        for (int r = 0; r < 16; ++r) acc[r] = 0.f;
#pragma unroll
        for (int ks = 0; ks < 4; ++ks) acc = MFMA32(ldfrag(Qd, 72, tt * 32, ks * 16, lane), ldfrag(Kd, 72, st * 32, ks * 16, lane), acc);
        const int s0 = st * 32 + (lane & 31);
#pragma unroll
        for (int r = 0; r < 16; ++r) { const int t = tt * 32 + crow(r, lane); const bool ok = dw == 0 ? (s0 <= t) : (s0 >= t);
            Pd[t * 72 + s0] = (bf16_t)f2bf(ok ? acc[r] : 0.f); }
    }
    __syncthreads();
    const int tt = wave >> 2, vt = wave & 3;
    f32x16 acc;
#pragma unroll
    for (int r = 0; r < 16; ++r) acc[r] = 0.f;
#pragma unroll
    for (int ks = 0; ks < 4; ++ks) { const bf16x8 vb = ldfrag_t(VT, 136, ks * 16, vt * 32, lane);
        acc = MFMA32(ldfrag(PF, 72, tt * 32, ks * 16, lane), vb, acc); acc = MFMA32(ldfrag(PB, 72, tt * 32, ks * 16, lane), vb, acc); }
#pragma unroll
    for (int ks = 0; ks < 4; ++ks) { acc = MFMA32(ldfrag(QF, 72, tt * 32, ks * 16, lane), ldfrag(ST, 72, vt * 32, ks * 16, lane), acc);
        acc = MFMA32(ldfrag(QB, 72, tt * 32, ks * 16, lane), ldfrag(ST + 128 * 72, 72, vt * 32, ks * 16, lane), acc); }
    __syncthreads();
#pragma unroll
    for (int r = 0; r < 16; ++r) O[(tt * 32 + crow(r, lane)) * 132 + vt * 32 + (lane & 31)] = acc[r];
    __syncthreads();
    head_norm_store<false>(p, O, GTt, GN, tok0, h, 0, tid);
    __syncthreads();
}

__device__ __forceinline__ void m6_load(const P& p, int it, int tid, M6Regs& R) {
    int b, h, j; item_bhj(it, b, h, j); const int tok0 = b * SEQ + j * 64, sidx = (b * 4 + h) * NCH + j;
    const bf16_t* Z = (const bf16_t*)(p.ws + WS_Z); const bf16_t* MQ = (const bf16_t*)(p.ws + WS_MQ); const bf16_t* MK = (const bf16_t*)(p.ws + WS_MK);
#pragma unroll
    for (int i = 0; i < 2; ++i) { const int idx = tid + NTHR * i, t = idx >> 4, c = idx & 15;
        R.q[i] = *(const u32x4*)(MQ + (size_t)(tok0 + t) * 512 + h * 128 + c * 8);
        R.k[i] = *(const u32x4*)(MK + (size_t)(tok0 + t) * 512 + h * 128 + c * 8);
        R.v[i] = *(const u32x4*)(Z + (size_t)(tok0 + t) * ZLD + 2560 + h * 128 + c * 8);
        R.gt[i] = *(const u32x4*)(Z + (size_t)(tok0 + t) * ZLD + 3072 + h * 128 + c * 8); }
    R.gn = *(const f32x4*)(p.in[15] + h * 128 + (tid & 31) * 4);
    R.gi = 0.f; R.gf = 0.f; R.nv = 0.f;
    if (tid < 128) { const int dir = tid >> 6, t = tid & 63; const float* g = (const float*)(p.ws + WS_GATES) + (size_t)(tok0 + t) * 48; R.gi = g[32 + dir * 4 + h]; R.gf = g[40 + dir * 4 + h]; }
    else if (tid < 384) R.nv = ((const float*)(p.ws + WS_MN))[(size_t)(sidx * 2) * 128 + (tid - 128)];
    else if (tid < 386) R.nv = ((const float*)(p.ws + WS_MSC))[(size_t)(sidx * 2 + (tid - 384)) * 4 + 2];
}
__device__ __forceinline__ void p6_ml(const P& p, LAS unsigned char* lds, int it, M6Regs& R, int itnext) {
    const int tid = threadIdx.x, lane = tid & 63, wave = __builtin_amdgcn_readfirstlane(tid >> 6);
    int b, h, j; item_bhj(it, b, h, j);
    const int tok0 = b * SEQ + j * 64;
    LAS bf16_t* Q = (LAS bf16_t*)lds; LAS bf16_t* K = (LAS bf16_t*)(lds + 17408); LAS bf16_t* VT = (LAS bf16_t*)(lds + 34816); LAS bf16_t* ST = (LAS bf16_t*)(lds + 53248);
    LAS bf16_t* PF = (LAS bf16_t*)(lds + 122880); LAS bf16_t* PB = PF + 64 * 72; LAS float* SM = (LAS float*)(lds + 141312); LAS float* O = (LAS float*)lds;
    LAS float* IG = SM; LAS float* LF = SM + 128; LAS float* CT = SM + 256; LAS float* RT = SM + 384; LAS float* WT = SM + 512; LAS float* ET = SM + 640;
    LAS float* NV = SM + 768;
    LAS float* INV = SM + 1024;
    LAS float* MS = SM + 1152;
    LAS bf16_t* GTt = (LAS bf16_t*)(lds + 146432); LAS float* GN = (LAS float*)(lds + 162816);
#pragma unroll
    for (int i = 0; i < 2; ++i) { const int idx = tid + NTHR * i, t = idx >> 4, c = idx & 15;
        *(LAS u32x4*)(Q + t * 136 + c * 8) = R.q[i]; *(LAS u32x4*)(K + t * 136 + c * 8) = R.k[i]; *(LAS u32x4*)(VT + t * 136 + c * 8) = R.v[i]; *(LAS u32x4*)(GTt + t * 128 + c * 8) = R.gt[i]; }
    if (tid < 32) *(LAS f32x4*)(GN + tid * 4) = R.gn;
    if (tid < 128) { const int dir = tid >> 6, t = tid & 63; IG[dir * 64 + t] = R.gi + p.in[13][dir * 4 + h]; LF[dir * 64 + t] = logsigf(R.gf + p.in[14][dir * 4 + h]); }
    else if (tid < 384) NV[tid - 128] = R.nv;
    else if (tid < 386) MS[tid - 384] = R.nv;
    u32x4 stc[8];
    { const bf16_t* S = (const bf16_t*)(p.ws + WS_UM) + (size_t)(((b * 4 + h) * NCH + j) * 2) * 16384;
#pragma unroll
        for (int i = 0; i < 8; ++i) { const int idx = tid + NTHR * i, row = idx >> 4, c = idx & 15; stc[i] = *(const u32x4*)(S + (size_t)row * 128 + c * 8); } }
    __syncthreads();
    if (itnext < 1024) m6_load(p, itnext, tid, R);
    if (tid < 64) {
        const int t = tid; const float ms = MS[0], a = scan_sum_up(LF[t], t), c = IG[t] - a, pm = scan_max_up(c, t), mt = a + fmaxf(ms, pm);
        CT[t] = c; RT[t] = a - mt; WT[t] = __expf(a + ms - mt); ET[t] = __expf(-mt);
    } else if (tid < 128) {
        const int t = tid - 64; const float ms = MS[1], a = scan_sum_down(LF[64 + t], t), c = IG[64 + t] - a, pm = scan_max_down(c, t), mt = a + fmaxf(ms, pm);
        CT[64 + t] = c; RT[64 + t] = a - mt; WT[64 + t] = __expf(a + ms - mt); ET[64 + t] = __expf(-mt);
    }
    __syncthreads();
    {
        const int dw = wave >> 2, tt = (wave >> 1) & 1, st = wave & 1; LAS bf16_t* Pd = dw == 0 ? PF : PB;
        f32x16 acc;
#pragma unroll
        for (int r = 0; r < 16; ++r) acc[r] = 0.f;
#pragma unroll
        for (int ks = 0; ks < 8; ++ks) acc = MFMA32(ldfrag(Q, 136, tt * 32, ks * 16, lane), ldfrag(K, 136, st * 32, ks * 16, lane), acc);
        const int s0 = st * 32 + (lane & 31); const float cs = CT[dw * 64 + s0];
#pragma unroll
        for (int r = 0; r < 16; ++r) { const int t = tt * 32 + crow(r, lane); const bool ok = dw == 0 ? (s0 <= t) : (s0 >= t);
            const float wgt = __expf(fminf(RT[dw * 64 + t] + cs, 0.f));
            Pd[t * 72 + s0] = (bf16_t)f2bf(ok ? acc[r] * wgt : 0.f); }
    }
#pragma unroll
    for (int i = 0; i < 8; ++i) { const int idx = tid + NTHR * i, row = idx >> 4, c = idx & 15; *(LAS u32x4*)(ST + row * 136 + c * 8) = stc[i]; }
    __syncthreads();
    {
        const int t = tid >> 3, seg = tid & 7;
        float rs0 = 0.f, rs1 = 0.f, qn0 = 0.f, qn1 = 0.f;
#pragma unroll
        for (int i = 0; i < 8; ++i) { rs0 += bf2f(PF[t * 72 + seg * 8 + i]); rs1 += bf2f(PB[t * 72 + seg * 8 + i]); }
#pragma unroll
        for (int i = 0; i < 16; ++i) { const float qv = bf2f(Q[t * 136 + seg * 16 + i]); qn0 += qv * NV[seg * 16 + i]; qn1 += qv * NV[128 + seg * 16 + i]; }
#pragma unroll
        for (int o = 1; o < 8; o <<= 1) { rs0 += __shfl_xor(rs0, o); rs1 += __shfl_xor(rs1, o); qn0 += __shfl_xor(qn0, o); qn1 += __shfl_xor(qn1, o); }
        if (seg == 0) { const float d0 = rs0 + WT[t] * qn0, d1 = rs1 + WT[64 + t] * qn1;
            INV[t] = 1.f / fmaxf(fabsf(d0), ET[t]); INV[64 + t] = 1.f / fmaxf(fabsf(d1), ET[64 + t]); }
    }
    const int tt = wave >> 2, vt = wave & 3;
    f32x16 af_, ab_;
#pragma unroll
    for (int r = 0; r < 16; ++r) { af_[r] = 0.f; ab_[r] = 0.f; }
#pragma unroll
    for (int ks = 0; ks < 4; ++ks) { const bf16x8 vb = ldfrag_t(VT, 136, ks * 16, vt * 32, lane);
        af_ = MFMA32(ldfrag(PF, 72, tt * 32, ks * 16, lane), vb, af_); ab_ = MFMA32(ldfrag(PB, 72, tt * 32, ks * 16, lane), vb, ab_); }
    { const float wf = WT[tt * 32 + (lane & 31)], wb = WT[64 + tt * 32 + (lane & 31)];
#pragma unroll
        for (int ks = 0; ks < 8; ++ks) { const u32x4 qa = __builtin_bit_cast(u32x4, ldfrag(Q, 136, tt * 32, ks * 16, lane));
            u32x4 qf, qb;
            qf.x = pk2(bflo(qa.x) * wf, bfhi(qa.x) * wf); qf.y = pk2(bflo(qa.y) * wf, bfhi(qa.y) * wf); qf.z = pk2(bflo(qa.z) * wf, bfhi(qa.z) * wf); qf.w = pk2(bflo(qa.w) * wf, bfhi(qa.w) * wf);
            qb.x = pk2(bflo(qa.x) * wb, bfhi(qa.x) * wb); qb.y = pk2(bflo(qa.y) * wb, bfhi(qa.y) * wb); qb.z = pk2(bflo(qa.z) * wb, bfhi(qa.z) * wb); qb.w = pk2(bflo(qa.w) * wb, bfhi(qa.w) * wb);
            af_ = MFMA32(__builtin_bit_cast(bf16x8, qf), ldfrag(ST, 136, vt * 32, ks * 16, lane), af_);
            ab_ = MFMA32(__builtin_bit_cast(bf16x8, qb), ldfrag(ST + 128 * 136, 136, vt * 32, ks * 16, lane), ab_); } }
    __syncthreads();
#pragma unroll
    for (int r = 0; r < 16; ++r) { const int t = tt * 32 + crow(r, lane);
        O[t * 132 + vt * 32 + (lane & 31)] = INV[t] * af_[r] + INV[64 + t] * ab_[r]; }
    __syncthreads();
    head_norm_store<true>(p, O, GTt, GN, tok0, h, 512, tid);
    __syncthreads();
}

__device__ __forceinline__ void phase6(const P& p, LAS unsigned char* lds) {
    const int tid = threadIdx.x; constexpr int NI = 1024 * ITEM_REP6;
#ifndef P6_SKIP_GLA
    { G6Regs R; int it = blockIdx.x; if (it < NI) g6_load(p, it & 1023, tid, R);
        for (; it < NI; it += gridDim.x) { const int i1 = it + gridDim.x; p6_gla(p, lds, it & 1023, R, i1 < NI ? (i1 & 1023) : 1024); } }
#endif
#ifndef P6_SKIP_ML
    { M6Regs R; int it = blockIdx.x; if (it < NI) m6_load(p, it & 1023, tid, R);
        for (; it < NI; it += gridDim.x) { const int i1 = it + gridDim.x; p6_ml(p, lds, it & 1023, R, i1 < NI ? (i1 & 1023) : 1024); } }
#endif
}

__device__ __forceinline__ void phase8(const P& p, LAS unsigned char* lds) {
    const int tid = threadIdx.x, lane = tid & 63, wave = tid >> 6;
    LAS bf16_t* RWB = (LAS bf16_t*)lds; LAS float* AB = (LAS float*)(lds + 99072); LAS float* LG = (LAS float*)(lds + 131840) + wave * 768;
    const float* mod = (const float*)(p.ws + WS_MOD);
    for (int k = tid; k < 1024; k += NTHR) {
        const f32x4 g = *(const f32x4*)(p.in[18] + k * 4);
        RWB[0 * 1032 + k] = (bf16_t)f2bf(g.x); RWB[1 * 1032 + k] = (bf16_t)f2bf(g.y); RWB[2 * 1032 + k] = (bf16_t)f2bf(g.z); RWB[3 * 1032 + k] = (bf16_t)f2bf(g.w);
#pragma unroll
        for (int q = 0; q < 8; ++q) { const f32x4 e = *(const f32x4*)(p.in[20] + k * 32 + q * 4);
            RWB[(4 + q * 4 + 0) * 1032 + k] = (bf16_t)f2bf(e.x); RWB[(4 + q * 4 + 1) * 1032 + k] = (bf16_t)f2bf(e.y); RWB[(4 + q * 4 + 2) * 1032 + k] = (bf16_t)f2bf(e.z); RWB[(4 + q * 4 + 3) * 1032 + k] = (bf16_t)f2bf(e.w); }
#pragma unroll
        for (int r = 36; r < 48; ++r) RWB[r * 1032 + k] = (bf16_t)0;
    }
    for (int i = tid; i < 4096; i += NTHR) { const int b = i >> 10, k = i & 1023;
        AB[(b * 2 + 0) * 1024 + k] = p.in[17][k] * (1.f + mod[b * 6144 + 4096 + k]); AB[(b * 2 + 1) * 1024 + k] = mod[b * 6144 + 3072 + k]; }
    __syncthreads();
    bf16_t* H2 = (bf16_t*)(p.ws + WS_MQ);
    int* RT = (int*)(p.ws + WS_ROUTE); unsigned* CNT = (unsigned*)(p.ws + WS_CTL) + CW_CNT;
    const float* PSS = (const float*)(p.ws + WS_PSS);
    LAS float* LGA = (LAS float*)(lds + 131840);
    LAS int* LC = (LAS int*)(lds + 156416); LAS int* LB = LC + 32;
    const int r16 = lane & 15, kq = lane >> 4, gsub = wave & 3, kh = wave >> 2;
    for (int blk = blockIdx.x; blk < MX / 64; blk += gridDim.x) {
        const int grp = blk * 4 + gsub, row = grp * 16 + r16, b = grp >> 8;
        const f32x4 pq = *(const f32x4*)(PSS + (size_t)row * 16 + kq * 4);
        float ss = pq.x + pq.y + pq.z + pq.w;
        ss += __shfl_xor(ss, 16); ss += __shfl_xor(ss, 32);
        const float rstd = 1.f / sqrtf(ss * (1.f / D) + EPS);
        const float* src = p.out + (size_t)row * D + kh * 512 + kq * 8;
        const LAS float* al = AB + (b * 2) * 1024 + kh * 512 + kq * 8; const LAS float* be = al + 1024;
        bf16_t* hdst = H2 + (size_t)row * D + kh * 512 + kq * 8;
        f32x4 acc[3];
#pragma unroll
        for (int nt = 0; nt < 3; ++nt) acc[nt] = (f32x4){0.f, 0.f, 0.f, 0.f};
#pragma unroll 8
        for (int ks = 0; ks < 16; ++ks) {
            const f32x4 x0 = *(const f32x4*)(src + ks * 32), x1 = *(const f32x4*)(src + ks * 32 + 4);
            const f32x4 a0 = *(const LAS f32x4*)(al + ks * 32), a1 = *(const LAS f32x4*)(al + ks * 32 + 4), b0 = *(const LAS f32x4*)(be + ks * 32), b1 = *(const LAS f32x4*)(be + ks * 32 + 4);
            const f32x4 h0 = x0 * rstd * a0 + b0, h1 = x1 * rstd * a1 + b1;
            u32x4 hw; hw.x = pk2(h0.x, h0.y); hw.y = pk2(h0.z, h0.w); hw.z = pk2(h1.x, h1.y); hw.w = pk2(h1.z, h1.w);
            *(u32x4*)(hdst + ks * 32) = hw;
            const bf16x8 af = __builtin_bit_cast(bf16x8, hw);
#pragma unroll
            for (int nt = 0; nt < 3; ++nt) { const bf16x8 bfr = *(const LAS bf16x8*)(RWB + (nt * 16 + r16) * 1032 + kh * 512 + ks * 32 + kq * 8);
                acc[nt] = __builtin_amdgcn_mfma_f32_16x16x32_bf16(af, bfr, acc[nt], 0, 0, 0); }
        }
        LAS float* LG = LGA + (kh * 4 + gsub) * 768;
#pragma unroll
        for (int nt = 0; nt < 3; ++nt)
#pragma unroll
            for (int r = 0; r < 4; ++r) LG[(kq * 4 + r) * 48 + nt * 16 + r16] = acc[nt][r];
        if (tid < 32) LC[tid] = 0;
        __syncthreads();
        int ea = 0, eb = 0, la = 0, lb = 0; float w0 = 0.f, w1 = 0.f;
        const bool sel = wave < 4 && lane < 16;
        if (sel) {
            const LAS float* lg0 = LGA + gsub * 768 + lane * 48; const LAS float* lg1 = lg0 + 4 * 768;
            float gl[4];
#pragma unroll
            for (int q = 0; q < 4; ++q) gl[q] = lg0[q] + lg1[q] + p.in[19][q];
            int gi = 0; float gm = gl[0];
#pragma unroll
            for (int q = 1; q < 4; ++q) if (gl[q] > gm) { gm = gl[q]; gi = q; }
            float den = 0.f;
#pragma unroll
            for (int q = 0; q < 4; ++q) den += __expf(gl[q] - gm);
            const float gwt = 1.f / den;
            float el[8];
#pragma unroll
            for (int q = 0; q < 8; ++q) el[q] = lg0[4 + gi * 8 + q] + lg1[4 + gi * 8 + q] + p.in[21][gi * 8 + q];
            int i0 = 0; float v0 = el[0];
#pragma unroll
            for (int q = 1; q < 8; ++q) if (el[q] > v0) { v0 = el[q]; i0 = q; }
            int i1 = -1; float v1 = -3.0e38f;
#pragma unroll
            for (int q = 0; q < 8; ++q) if (q != i0 && el[q] > v1) { v1 = el[q]; i1 = q; }
            const float e1 = __expf(v1 - v0); w0 = gwt / (1.f + e1); w1 = gwt * e1 / (1.f + e1);
            ea = gi * 8 + i0; eb = gi * 8 + i1;
            la = __hip_atomic_fetch_add(&LC[ea], 1, __ATOMIC_RELAXED, __HIP_MEMORY_SCOPE_WORKGROUP); lb = __hip_atomic_fetch_add(&LC[eb], 1, __ATOMIC_RELAXED, __HIP_MEMORY_SCOPE_WORKGROUP);
        }
        __syncthreads();
        if (tid < 32) { const int c = LC[tid]; LB[tid] = c > 0 ? (int)atomicAdd(&CNT[tid * 64], (unsigned)c) : 0; }
        __syncthreads();
        if (sel) { const int trow = grp * 16 + lane, ra = LB[ea] + la, rb = LB[eb] + lb; int* r = RT + (size_t)trow * 8; r[0] = ea; r[1] = eb; r[2] = ra; r[3] = rb; ((float*)r)[4] = w0; ((float*)r)[5] = w1;
            int* TOK = (int*)(p.ws + WS_TOK); TOK[ea * 16384 + ra] = trow; TOK[eb * 16384 + rb] = trow; }
        __syncthreads();
    }
}

__device__ __forceinline__ int build_tables(const P& p, LAS int* PST, LAS int* TEX) {
    const unsigned* CNT = (const unsigned*)(p.ws + WS_CTL) + CW_CNT;
    if (threadIdx.x == 0) { int acc = 0;
        for (int e = 0; e < 32; ++e) { PST[e] = acc; const int c = (int)__hip_atomic_load(&CNT[e * 64], __ATOMIC_RELAXED, __HIP_MEMORY_SCOPE_AGENT); const int nt = (c + 255) >> 8; PST[40 + e] = c;
            for (int t = 0; t < nt; ++t) TEX[(acc >> 8) + t] = e;
            acc += nt << 8; }
        PST[32] = acc; }
    __syncthreads();
    return PST[32] >> 8;
}

__device__ __forceinline__ void phase12(const P& p, LAS unsigned char* lds, float* dstbase) {
    const int tid = threadIdx.x, lane = tid & 63, wave = tid >> 6;
    LAS int* PST = (LAS int*)lds; (void)build_tables(p, PST, PST + 128);
    const float* mod = (const float*)(p.ws + WS_MOD); const bf16_t* Y = (const bf16_t*)(p.ws + WS_Z); const int* RT = (const int*)(p.ws + WS_ROUTE);
    const int gw = blockIdx.x * 8 + wave, NGW = gridDim.x * 8;
    for (int r0 = gw * 2; r0 < MX; r0 += NGW * 2) {
        int s0[2], s1[2]; float w0[2], w1[2];
#pragma unroll
        for (int q = 0; q < 2; ++q) { const int* r = RT + (size_t)(r0 + q) * 8; s0[q] = PST[r[0]] + r[2]; s1[q] = PST[r[1]] + r[3]; w0[q] = ((const float*)r)[4]; w1[q] = ((const float*)r)[5]; }
        f32x4 x1[2][4]; u32x2 ya[2][4], yb[2][4];
#pragma unroll
        for (int q = 0; q < 2; ++q)
#pragma unroll
            for (int j = 0; j < 4; ++j) { const int k = 4 * lane + 256 * j;
                x1[q][j] = *(const f32x4*)(p.out + (size_t)(r0 + q) * D + k);
                ya[q][j] = *(const u32x2*)(Y + (size_t)s0[q] * D + k); yb[q][j] = *(const u32x2*)(Y + (size_t)s1[q] * D + k); }
#pragma unroll
        for (int q = 0; q < 2; ++q) { const int row = r0 + q; const float* g2 = mod + (size_t)(row >> 12) * 6144 + 5120;
            f32x4 v[4]; float ss = 0.f;
#pragma unroll
            for (int j = 0; j < 4; ++j) { const int k = 4 * lane + 256 * j; const f32x4 g = *(const f32x4*)(g2 + k);
                f32x4 m; m.x = w0[q] * bflo(ya[q][j].x) + w1[q] * bflo(yb[q][j].x); m.y = w0[q] * bfhi(ya[q][j].x) + w1[q] * bfhi(yb[q][j].x);
                m.z = w0[q] * bflo(ya[q][j].y) + w1[q] * bflo(yb[q][j].y); m.w = w0[q] * bfhi(ya[q][j].y) + w1[q] * bfhi(yb[q][j].y);
                v[j] = x1[q][j] + g * m; ss += v[j].x * v[j].x + v[j].y * v[j].y + v[j].z * v[j].z + v[j].w * v[j].w; }
            const float rstd = 1.f / sqrtf(wave_sum(ss) * (1.f / D) + EPS);
#pragma unroll
            for (int j = 0; j < 4; ++j) { const int k = 4 * lane + 256 * j; const f32x4 g = *(const f32x4*)(p.in[24] + k); *(f32x4*)(dstbase + (size_t)row * D + k) = v[j] * rstd * g; } }
    }
}

constexpr int NPH = 13;
__global__ void __launch_bounds__(NTHR, 2) mega(P p) {
    extern __shared__ __attribute__((aligned(16))) unsigned char lds_raw[];
    LAS unsigned char* lds = (LAS unsigned char*)lds_raw;
    volatile LAS unsigned* xst = (volatile LAS unsigned*)(lds + LDS_XB);
    if (threadIdx.x < 2) xst[threadIdx.x] = 0u;
    __syncthreads();
    XcdBarrier xb = xcd_barrier_post((unsigned*)(p.ws + WS_CTL) + CW_BAR, xst);
    const int lo = p.ph_lo, hi = p.ph_hi;
    const int G = gridDim.x, bx = blockIdx.x;
    const int vcu = (G % 8 == 0) ? (bx % 8) * (G / 8) + bx / 8 : bx;
#ifndef PHASE_MASK
#define PHASE_MASK 0x1fff
#endif
#define IN(k) (((PHASE_MASK >> (k)) & 1) && lo <= (k) && (k) < hi)
#define SEAM(k) do { if ((k) + 1 < hi) xcd_barrier(xb); } while (0)
#define REPN(k) (1 + ((REP_MASK >> (k)) & 1))
    if (IN(0)) { _Pragma("nounroll") for (int rep = 0; rep < REPN(0); ++rep) { if (rep) xcd_barrier(xb); phase0(p, lds); } for (int q = 0; q < EXTRA_SYNCS; ++q) xcd_barrier(xb); SEAM(0); }
    if (IN(1)) { _Pragma("nounroll") for (int rep = 0; rep < REPN(1); ++rep) { if (rep) xcd_barrier(xb); phase1(p); } SEAM(1); }
    if (IN(2)) {
        pg8::SchedDense S; S.nM = MT / 256; S.nN = NPADW / 256; S.nwg = S.nM * S.nN; S.G = G; S.c = bx; S.K = 1024; S.A = (const char*)(p.ws + WS_A); S.Bt = (const char*)(p.ws + WS_WINT);
        EpiZ E; E.Z = (bf16_t*)(p.ws + WS_Z); E.G = (float*)(p.ws + WS_GATES);
        _Pragma("nounroll") for (int rep = 0; rep < REPN(2); ++rep) { if (rep) xcd_barrier(xb); pg8::gemm_phase(lds, 1024, S, E); } SEAM(2); }
    if (IN(3)) { _Pragma("nounroll") for (int rep = 0; rep < REPN(3); ++rep) { if (rep) xcd_barrier(xb); phase3(p, lds); } SEAM(3); }
    if (IN(4)) { _Pragma("nounroll") for (int rep = 0; rep < REPN(4); ++rep) { if (rep) xcd_barrier(xb); phase4(p, lds); } SEAM(4); }
    if (IN(5)) { _Pragma("nounroll") for (int rep = 0; rep < REPN(5); ++rep) { if (rep) { xcd_barrier(xb); phase4(p, lds); xcd_barrier(xb); } phase5(p); } SEAM(5); }
    if (IN(6)) { _Pragma("nounroll") for (int rep = 0; rep < REPN(6); ++rep) { if (rep) xcd_barrier(xb); phase6(p, lds); } SEAM(6); }
    if (IN(7)) {
        pg8::SchedDense S; S.nM = MX / 256; S.nN = 4; S.nwg = S.nM * S.nN; S.G = G; S.c = bx; S.K = 1024; S.A = (const char*)(p.ws + WS_A); S.Bt = (const char*)(p.ws + WS_WOUTT);
        EpiX1 E; E.x = p.in[0]; E.mod = (const float*)(p.ws + WS_MOD); E.out = p.out; E.pss = (float*)(p.ws + WS_PSS);
        _Pragma("nounroll") for (int rep = 0; rep < REPN(7); ++rep) { if (rep) xcd_barrier(xb); pg8::gemm_phase(lds, 1024, S, E); } SEAM(7); }
    if (IN(8)) { _Pragma("nounroll") for (int rep = 0; rep < REPN(8); ++rep) { if (rep) { xcd_barrier(xb); if (bx == 0 && threadIdx.x < 32) ((unsigned*)(p.ws + WS_CTL))[CW_CNT + threadIdx.x * 64] = 0u; xcd_barrier(xb); } phase8(p, lds); } if (10 < hi) xcd_barrier(xb); }
    if (IN(10)) {
        LAS int* PST = (LAS int*)(lds + pg8::STAGE_BYTES); LAS int* TEX = PST + 128;
        const int ntiles = build_tables(p, PST, TEX);
        pg8::SchedMoE S; S.ntiles = ntiles; S.G = G; S.c = vcu; S.K = 1024; S.tex = TEX; S.pst = PST; S.cnt = PST + 40; S.tok = (const int*)(p.ws + WS_TOK); S.gather = true;
        S.A = (const char*)(p.ws + WS_MQ); S.Bt = (const char*)(p.ws + WS_E1T); S.bstride = (size_t)1024 * 1024 * 2;
        EpiH E; E.H = (bf16_t*)(p.ws + WS_UM);
        _Pragma("nounroll") for (int rep = 0; rep < REPN(10); ++rep) { if (rep) xcd_barrier(xb); pg8::gemm_phase<EpiH, pg8::SchedMoE, true>(lds, 1024, S, E); }
        {
            const int rem = (ntiles * 4) % G, nslack = rem ? G - rem : G, sidx = rem ? vcu - rem : vcu;
            if (sidx >= 0) { const int wave = threadIdx.x >> 6, lane = threadIdx.x & 63; LAS float* scr = (LAS float*)(lds + wave * 16384); bf16_t* E2T = (bf16_t*)(p.ws + WS_E2T);
                for (int r = sidx * 8 + wave; r < 32 * 8 * 32; r += nslack * 8) { const int e = r >> 8, q = r & 255;
                    transpose_item(p.in[23] + (size_t)e * 512 * 1024, 512, 1024, E2T + (size_t)e * 1024 * 512, scr, q >> 5, q & 31, lane, RmId()); } } }
        SEAM(10); }
    if (IN(11)) {
        LAS int* PST = (LAS int*)(lds + pg8::STAGE_BYTES); LAS int* TEX = PST + 128;
        const int ntiles = build_tables(p, PST, TEX);
        pg8::SchedMoE S; S.ntiles = ntiles; S.G = G; S.c = vcu; S.K = 512; S.tex = TEX; S.pst = PST; S.cnt = PST + 40; S.tok = nullptr; S.gather = false; S.A = (const char*)(p.ws + WS_UM); S.Bt = (const char*)(p.ws + WS_E2T); S.bstride = (size_t)1024 * 512 * 2;
        EpiY E; E.Y = (bf16_t*)(p.ws + WS_Z);
        _Pragma("nounroll") for (int rep = 0; rep < REPN(11); ++rep) { if (rep) xcd_barrier(xb); pg8::gemm_phase(lds, 512, S, E); } SEAM(11); }
    if (IN(12)) { for (int rep = 1; rep < REPN(12); ++rep) { phase12(p, lds, (float*)(p.ws + WS_MQ)); xcd_barrier(xb); } phase12(p, lds, p.out); }
#undef IN
#undef SEAM
}

extern "C" void kernel_launch(void* const* d_in, const int* in_sizes, int n_in, void* d_out, int out_size, void* d_ws, size_t ws_size, hipStream_t stream) {
    static int grid = 0;
    if (grid == 0) {
        if (n_in != 25 || out_size != MX * D || ws_size < WS_END) { fprintf(stderr, "kernel_launch: unexpected problem (n_in %d out %d ws %zu)\n", n_in, out_size, ws_size); grid = -1; return; }
        int dev = 0, cus = 0, per_cu = 0;
        hipGetDevice(&dev); hipDeviceGetAttribute(&cus, hipDeviceAttributeMultiprocessorCount, dev);
        if (hipFuncSetAttribute((const void*)mega, hipFuncAttributeMaxDynamicSharedMemorySize, LDS_BYTES) != hipSuccess) { fprintf(stderr, "kernel_launch: hipFuncSetAttribute failed\n"); grid = -1; return; }
        if (hipOccupancyMaxActiveBlocksPerMultiprocessor(&per_cu, (const void*)mega, NTHR, LDS_BYTES) != hipSuccess || per_cu < 1) { fprintf(stderr, "kernel_launch: occupancy query says %d\n", per_cu); per_cu = 1; }
        (void)hipGetLastError();
        grid = cus;
    }
    if (grid < 0) return;
    P a{};
    for (int i = 0; i < 25; ++i) a.in[i] = (const float*)d_in[i];
    a.out = (float*)d_out; a.ws = (unsigned char*)d_ws;
#if N_LAUNCH_MODE == 1
    a.ph_lo = 0; a.ph_hi = NPH;
    for (int rep = 0; rep < FWD_REPS; ++rep) {
        hipMemsetAsync((char*)d_ws + WS_CTL, 0, 1 * MiB, stream);
        void* args[] = {&a};
        hipError_t e = hipLaunchCooperativeKernel((const void*)mega, dim3(grid), dim3(NTHR), args, LDS_BYTES, stream);
        if (e != hipSuccess) fprintf(stderr, "cooperative launch failed: %s (grid %d)\n", hipGetErrorString(e), grid);
    }
#else
    hipMemsetAsync((char*)d_ws + WS_CTL, 0, 1 * MiB, stream);
    for (int ph = 0; ph < NPH; ++ph) { a.ph_lo = ph; a.ph_hi = ph + 1; hipLaunchKernelGGL(mega, dim3(grid), dim3(NTHR), LDS_BYTES, stream, a); }
#endif
}
```

```cpp
#include <hip/hip_runtime.h>
#include <hip/hip_cooperative_groups.h>
#include <cstdio>
namespace cg = cooperative_groups;

#ifndef N_LAUNCH_MODE
#define N_LAUNCH_MODE 1
#endif

#ifndef REP_MASK
#define REP_MASK 0
#endif
#ifndef FWD_REPS
#define FWD_REPS 1
#endif
#ifndef ITEM_REP3
#define ITEM_REP3 1
#endif
#ifndef ITEM_REP6
#define ITEM_REP6 1
#endif
#ifndef USE_TR_READ
#define USE_TR_READ 1
#endif
#ifndef STAGE_SEL
#define STAGE_SEL -1
#endif
#ifndef STAGE_FN
#define STAGE_FN 0
#endif
#ifndef STAGE_K
#define STAGE_K 8
#endif
#ifndef FUSE01
#define FUSE01 1
#endif
#ifndef EXTRA_SYNCS
#define EXTRA_SYNCS 0
#endif
#define LAS __attribute__((address_space(3)))
typedef unsigned short bf16_t;
typedef short bf16x8 __attribute__((ext_vector_type(8)));
typedef float f32x4 __attribute__((ext_vector_type(4)));
typedef float f32x16 __attribute__((ext_vector_type(16)));
typedef unsigned u32x2 __attribute__((ext_vector_type(2)));
typedef unsigned u32x4 __attribute__((ext_vector_type(4)));

constexpr int D = 1024, NB = 4, SEQ = 4096, CTXL = 256;
constexpr int MX = NB * SEQ, MC = NB * CTXL, MT = MX + MC;
constexpr int INW = 3632, ZLD = 3584, NPADW = 3840;
constexpr int NCH = 68;
constexpr int NSTATE = NB * 4 * NCH;
constexpr float EPS = 1e-6f;
constexpr int NTHR = 512;
constexpr int LDS_BYTES = 160 * 1024;

constexpr size_t MiB = 1u << 20;
constexpr size_t WS_CTL = 0;
constexpr size_t WS_MOD = 1 * MiB;
constexpr size_t WS_ROUTE = 2 * MiB;
constexpr size_t WS_GDEC = 3 * MiB;
constexpr size_t WS_MN = 4 * MiB;
constexpr size_t WS_MSC = 6 * MiB;
constexpr size_t WS_GATES = 7 * MiB;
constexpr size_t WS_WINT = 11 * MiB;
constexpr size_t WS_WOUTT = 19 * MiB;
constexpr size_t WS_E1T = 21 * MiB;
constexpr size_t WS_E2T = 85 * MiB;
constexpr size_t WS_A = 117 * MiB;
constexpr size_t WS_Z = 151 * MiB;
constexpr size_t WS_MQ = 270 * MiB;
constexpr size_t WS_MK = 287 * MiB;
constexpr size_t WS_X1 = 304 * MiB;
constexpr size_t WS_UG = 304 * MiB;
constexpr size_t WS_UM = 338 * MiB;
constexpr size_t WS_PSS = 406 * MiB;
constexpr size_t WS_TOK = 408 * MiB;
constexpr size_t WS_END = 410 * MiB;
constexpr int CW_CNT = 64;
constexpr int CW_Q = 3200;
constexpr int CW_MODF = 3072;
constexpr int CW_BAR = 4096;
constexpr int LDS_NQ = LDS_BYTES - 128;
constexpr int LDS_XB = LDS_BYTES - 64;

struct P { const float* in[25]; float* out; unsigned char* ws; int ph_lo, ph_hi; };

typedef float f32x2 __attribute__((ext_vector_type(2)));
typedef __bf16 bf16x2_t __attribute__((ext_vector_type(2)));
__device__ __forceinline__ unsigned pk2(float lo, float hi) { const f32x2 v = {lo, hi}; const bf16x2_t b = __builtin_convertvector(v, bf16x2_t); return __builtin_bit_cast(unsigned, b); }
__device__ __forceinline__ unsigned f2bf(float f) { return pk2(f, 0.f) & 0xffffu; }
__device__ __forceinline__ float bf2f(unsigned b) { return __uint_as_float(b << 16); }
__device__ __forceinline__ float bflo(unsigned w) { return __uint_as_float(w << 16); }
__device__ __forceinline__ float bfhi(unsigned w) { return __uint_as_float(w & 0xffff0000u); }

constexpr float SG_SCALE = 2.f, SM_SCALE = 64.f;
__device__ __forceinline__ unsigned pk4_fp8(float a, float b, float c, float d) {
    a = __builtin_amdgcn_fmed3f(a, -448.f, 448.f); b = __builtin_amdgcn_fmed3f(b, -448.f, 448.f); c = __builtin_amdgcn_fmed3f(c, -448.f, 448.f); d = __builtin_amdgcn_fmed3f(d, -448.f, 448.f);
    int w = 0; w = __builtin_amdgcn_cvt_pk_fp8_f32(a, b, w, false); w = __builtin_amdgcn_cvt_pk_fp8_f32(c, d, w, true); return (unsigned)w;
}
__device__ __forceinline__ void up4_fp8(unsigned w, float (&o)[4]) {
    const f32x2 lo = __builtin_amdgcn_cvt_pk_f32_fp8((int)w, false), hi = __builtin_amdgcn_cvt_pk_f32_fp8((int)w, true); o[0] = lo.x; o[1] = lo.y; o[2] = hi.x; o[3] = hi.y;
}
__device__ __forceinline__ u32x4 fp8x8_to_bf16(u32x2 w, float inv) {
    float a[4], b[4]; up4_fp8(w.x, a); up4_fp8(w.y, b);
    u32x4 o; o.x = pk2(a[0] * inv, a[1] * inv); o.y = pk2(a[2] * inv, a[3] * inv); o.z = pk2(b[0] * inv, b[1] * inv); o.w = pk2(b[2] * inv, b[3] * inv); return o;
}
__device__ __forceinline__ float wave_sum(float v) {
#pragma unroll
    for (int o = 32; o >= 1; o >>= 1) v += __shfl_xor(v, o);
    return v;
}
__device__ __forceinline__ float rcpf(float x) { return __builtin_amdgcn_rcpf(x); }
__device__ __forceinline__ float siluf(float x) { return x * rcpf(1.f + __expf(-x)); }
__device__ __forceinline__ float sigmf(float x) { return rcpf(1.f + __expf(-x)); }
__device__ __forceinline__ float logsigf(float x) { return fminf(x, 0.f) - __logf(1.f + __expf(-fabsf(x))); }


#define DPP_F(old, src, ctrl, rmask) __builtin_bit_cast(float, __builtin_amdgcn_update_dpp(__builtin_bit_cast(int, (float)(old)), __builtin_bit_cast(int, (float)(src)), (ctrl), (rmask), 0xf, false))
__device__ __forceinline__ float scan_sum_up(float v, int lane) {
    (void)lane;
    v += DPP_F(0.f, v, 0x111, 0xf); v += DPP_F(0.f, v, 0x112, 0xf); v += DPP_F(0.f, v, 0x114, 0xf); v += DPP_F(0.f, v, 0x118, 0xf);
    v += DPP_F(0.f, v, 0x142, 0xa); v += DPP_F(0.f, v, 0x143, 0xc);
    return v;
}
__device__ __forceinline__ float scan_max_up(float v, int lane) {
    (void)lane; const float ninf = -3.0e38f;
    v = fmaxf(v, DPP_F(ninf, v, 0x111, 0xf)); v = fmaxf(v, DPP_F(ninf, v, 0x112, 0xf)); v = fmaxf(v, DPP_F(ninf, v, 0x114, 0xf)); v = fmaxf(v, DPP_F(ninf, v, 0x118, 0xf));
    v = fmaxf(v, DPP_F(ninf, v, 0x142, 0xa)); v = fmaxf(v, DPP_F(ninf, v, 0x143, 0xc));
    return v;
}
__device__ __forceinline__ float scan_sum_down(float v, int lane) { return __shfl(scan_sum_up(__shfl(v, 63 - lane), lane), 63 - lane); }
__device__ __forceinline__ float scan_max_down(float v, int lane) { return __shfl(scan_max_up(__shfl(v, 63 - lane), lane), 63 - lane); }
__device__ __forceinline__ float wave_max(float v) {
#pragma unroll
    for (int o = 32; o >= 1; o >>= 1) v = fmaxf(v, __shfl_xor(v, o));
    return v;
}

__device__ __forceinline__ bf16x8 ldfrag(const LAS bf16_t* T, int ld, int row0, int k0, int lane) {
    return *(const LAS bf16x8*)(T + (row0 + (lane & 31)) * ld + k0 + 8 * (lane >> 5));
}
#define MFMA32(a, b, c) __builtin_amdgcn_mfma_f32_32x32x16_bf16((a), (b), (c), 0, 0, 0)
__device__ __forceinline__ int crow(int r, int lane) { return (r & 3) + 8 * (r >> 2) + 4 * (lane >> 5); }


#define XB_TMO      128
#define XB_XCNT(j)  (256  + 64 * (j))
#define XB_XSUB(j)  (1280 + 64 * (j))
#define XB_XGEN(j)  (2304 + 64 * (j))
#define XB_TOP      3328
#define XB_TOPGEN   3392
#define XCD_BAR_WORDS 3456
#define XB_SPIN_CAP (1u << 22)
__device__ __forceinline__ unsigned xb_ld(unsigned* p)              { return __hip_atomic_load(p, __ATOMIC_RELAXED, __HIP_MEMORY_SCOPE_AGENT); }
__device__ __forceinline__ unsigned xb_add(unsigned* p, unsigned v) { return __hip_atomic_fetch_add(p, v, __ATOMIC_RELAXED, __HIP_MEMORY_SCOPE_AGENT); }
__device__ __forceinline__ unsigned xb_xcc_id() { return (unsigned)__builtin_amdgcn_s_getreg((3 << 11) | 20) & 0xFu; }
#define XB_SPIN(cond, bar) do { unsigned _sp = 0; while (cond) { __builtin_amdgcn_s_sleep(1); \
    if ((++_sp & 255u) == 0u) { if (xb_ld(&(bar)[XB_TMO])) break; if (_sp > XB_SPIN_CAP) { atomicAdd(&(bar)[XB_TMO], 1u); break; } } } } while (0)
struct XcdBarrier { unsigned* bar; unsigned x; volatile LAS unsigned* st; };
__device__ __forceinline__ XcdBarrier xcd_barrier_post(unsigned* bar, volatile LAS unsigned* st) {
    XcdBarrier b; b.bar = bar; b.x = xb_xcc_id(); b.st = st;
    if (threadIdx.x == 0) (void)xb_add(&bar[XB_XCNT(b.x)], 1u);
    return b;
}
__device__ __forceinline__ void xcd_barrier_complete(unsigned* bar, unsigned x, unsigned& nloc, unsigned& nx) {
    const unsigned G = gridDim.x * gridDim.y * gridDim.z;
    unsigned sum, cnt, mine, sp = 0u;
    for (;;) {
        sum = 0u; cnt = 0u; mine = 0u;
#pragma unroll
        for (unsigned j = 0; j < 16; ++j) { const unsigned c = xb_ld(&bar[XB_XCNT(j)]); sum += c; cnt += (c > 0u) ? 1u : 0u; mine = (j == x) ? c : mine; }
        if (sum == G) break;
        __builtin_amdgcn_s_sleep(1);
        if ((++sp & 255u) == 0u) { if (xb_ld(&bar[XB_TMO])) break; if (sp > XB_SPIN_CAP) { atomicAdd(&bar[XB_TMO], 1u); break; } }
    }
    nloc = mine > 0u ? mine : 1u; nx = cnt > 0u ? cnt : 1u;
}
__device__ __forceinline__ void xcd_barrier(const XcdBarrier& b) {
    asm volatile("s_waitcnt vmcnt(0)" ::: "memory");
    __syncthreads();
    if (threadIdx.x == 0) {
        unsigned* bar = b.bar;
        __builtin_amdgcn_s_waitcnt(0);
        unsigned nloc = b.st[0], nx = b.st[1];
        if (nloc == 0u) { xcd_barrier_complete(bar, b.x, nloc, nx); b.st[0] = nloc; b.st[1] = nx; }
        const unsigned old = xb_add(&bar[XB_XSUB(b.x)], 1u);
        const unsigned gen = old / nloc;
        if (old + 1u == (gen + 1u) * nloc) {
            __builtin_amdgcn_fence(__ATOMIC_RELEASE, "agent");
            asm volatile("s_waitcnt vmcnt(0)" ::: "memory");
            const unsigned og = xb_add(&bar[XB_TOP], 1u);
            const unsigned tg = og / nx;
            if (og + 1u == (tg + 1u) * nx) xb_add(&bar[XB_TOPGEN], 1u);
            else XB_SPIN(xb_ld(&bar[XB_TOPGEN]) == tg, bar);
            __builtin_amdgcn_fence(__ATOMIC_ACQUIRE, "agent");
            xb_add(&bar[XB_XGEN(b.x)], 1u);
            asm volatile("s_waitcnt vmcnt(0)" ::: "memory");
        } else {
            XB_SPIN(xb_ld(&bar[XB_XGEN(b.x)]) == gen, bar);
            __builtin_amdgcn_fence(__ATOMIC_ACQUIRE, "agent");
            asm volatile("s_waitcnt vmcnt(0)" ::: "memory");
        }
    }
    __syncthreads();
}

namespace pg8 {
constexpr int BM = 256, BK = 64, HALF = 128, HTB = HALF * BK * 2, STAGE_BYTES = 8 * HTB;
__device__ __forceinline__ int lds_byte(int r, int c) { const int st = (r >> 4) * 2 + (c >> 5), rr = r & 15, cc = c & 31, ob = rr * 64 + cc * 2; return st * 1024 + (ob ^ (((ob >> 9) & 1) << 5)); }
__device__ __forceinline__ void stage_rc(int b, int& R, int& C) { const int st = b / 1024, sb = b % 1024, swz = sb ^ (((sb >> 9) & 1) << 5); R = (st >> 1) * 16 + swz / 64; C = (st & 1) * 32 + (swz % 64) / 2; }
__device__ __forceinline__ int perm32(int rho) { const int n = rho >> 4, i = rho & 15; return 8 * (i >> 2) + 4 * n + (i & 3); }
struct Unit { int pm, pn; const char* a; const char* b; };

template <class Epi, class Sched, bool GATHER = false>
__device__ __forceinline__ void gemm_phase(LAS unsigned char* lds, const int K, const Sched& S, const Epi& E) {
    const int tid = threadIdx.x, wid = __builtin_amdgcn_readfirstlane(tid >> 6), lane = tid & 63, wr = wid >> 2, wc = wid & 3, fr = lane & 15, fq = lane >> 4;
    const int nt = K / BK;
    unsigned voffA[2], voffB[2];
#pragma unroll
    for (int i = 0; i < 2; ++i) { int R, C; stage_rc(tid * 16 + i * 8192, R, C); const int Rb = Epi::PERM ? ((R & ~31) + perm32(R & 31)) : R;
        voffA[i] = (unsigned)(R * K + C) * 2u; voffB[i] = (unsigned)(Rb * K + C) * 2u; }
    unsigned ca[2][2], na[2][2];
#define PG8_GOFF(dst, u) do { if constexpr (GATHER) { _Pragma("unroll") for (int _h = 0; _h < 2; ++_h) _Pragma("unroll") for (int _i = 0; _i < 2; ++_i) { int _R, _C; stage_rc(tid * 16 + _i * 8192, _R, _C); \
        dst[_h][_i] = S.row_off(u, _h * HALF + _R) + (unsigned)_C * 2u; } } } while (0)
    const size_t kstep = (size_t)(BK * 2);
    const size_t hstep = (size_t)HALF * K * 2;
    const size_t hstepA = GATHER ? 0 : hstep;
    const unsigned ldsw = (unsigned)wid * 1024u;
    const int aoff = lds_byte(wr * 64 + fr, fq * 8), boff = lds_byte(wc * 32 + fr, fq * 8);
#define PG8_SA(b, h) (((b) * 2 + (h)) * HTB)
#define PG8_SB(b, h) ((4 + (b) * 2 + (h)) * HTB)
#define PG8_STAGE(bufoff, gbase, voff) do { _Pragma("unroll") for (int _i = 0; _i < 2; ++_i) \
        __builtin_amdgcn_global_load_lds((const unsigned*)((const char*)(gbase) + (voff)[_i]), (LAS unsigned*)(lds + (bufoff) + ldsw + _i * 8192), 16, 0, 0); } while (0)
#define PG8_STAGEA(bufoff, gbase, h, nx) do { _Pragma("unroll") for (int _i = 0; _i < 2; ++_i) { const unsigned _vo = GATHER ? ((nx) ? na[h][_i] : ca[h][_i]) : voffA[_i]; \
        __builtin_amdgcn_global_load_lds((const unsigned*)((const char*)(gbase) + (size_t)(h) * hstepA + _vo), (LAS unsigned*)(lds + (bufoff) + ldsw + _i * 8192), 16, 0, 0); } } while (0)
#define PG8_LDA(dst, b, h) do { _Pragma("unroll") for (int m = 0; m < 4; ++m) _Pragma("unroll") for (int k = 0; k < 2; ++k) dst[m][k] = *(const LAS bf16x8*)(lds + PG8_SA(b, h) + aoff + m * 2048 + k * 1024); } while (0)
#define PG8_LDB(dst, b, h) do { _Pragma("unroll") for (int n = 0; n < 2; ++n) _Pragma("unroll") for (int k = 0; k < 2; ++k) dst[n][k] = *(const LAS bf16x8*)(lds + PG8_SB(b, h) + boff + n * 2048 + k * 1024); } while (0)
#define PG8_MMA(ai, bj, At, Bt) do { __builtin_amdgcn_s_setprio(1); _Pragma("unroll") for (int m = 0; m < 4; ++m) _Pragma("unroll") for (int n = 0; n < 2; ++n) _Pragma("unroll") for (int k = 0; k < 2; ++k) \
        acc[ai][bj][m][n] = __builtin_amdgcn_mfma_f32_16x16x32_bf16(Bt[n][k], At[m][k], acc[ai][bj][m][n], 0, 0, 0); __builtin_amdgcn_s_setprio(0); } while (0)
#define PG8_WAIT_V(n) asm volatile("s_waitcnt vmcnt(" #n ")" ::: "memory")
#define PG8_WAIT_L(n) asm volatile("s_waitcnt lgkmcnt(" #n ")" ::: "memory")
#define PG8_BAR __builtin_amdgcn_s_barrier()
#define PG8_SCHED __builtin_amdgcn_sched_barrier(0)
    Unit cur, nxt; int ui = 0;
    if (!S.next(0, cur)) return;
    f32x4 acc[2][2][4][2];
#pragma unroll
    for (int a = 0; a < 2; ++a)
#pragma unroll
        for (int b = 0; b < 2; ++b)
#pragma unroll
            for (int m = 0; m < 4; ++m)
#pragma unroll
                for (int n = 0; n < 2; ++n) acc[a][b][m][n] = (f32x4){0.f, 0.f, 0.f, 0.f};
    bf16x8 At[4][2], B0[2][2], B1[2][2];
    const char* cA = cur.a; const char* cB = cur.b;
    PG8_GOFF(ca, cur);
    PG8_STAGE(PG8_SB(0, 0), cB, voffB); PG8_STAGEA(PG8_SA(0, 0), cA, 0, false); PG8_STAGE(PG8_SB(0, 1), cB + hstep, voffB); PG8_STAGEA(PG8_SA(0, 1), cA, 1, false);
    if (wr == 1) PG8_BAR;
    PG8_WAIT_V(4); PG8_BAR;
    PG8_STAGE(PG8_SB(1, 0), cB + kstep, voffB); PG8_STAGEA(PG8_SA(1, 0), cA + kstep, 0, false); PG8_STAGE(PG8_SB(1, 1), cB + hstep + kstep, voffB);
    PG8_WAIT_V(6); PG8_BAR;
    for (;;) {
        const bool has_next = S.next(ui + 1, nxt);
        const char* nA = has_next ? nxt.a : cA; const char* nB = has_next ? nxt.b : cB;
        if constexpr (GATHER) { if (has_next) PG8_GOFF(na, nxt); else { _Pragma("unroll") for (int _h = 0; _h < 2; ++_h) _Pragma("unroll") for (int _i = 0; _i < 2; ++_i) na[_h][_i] = ca[_h][_i]; } }
        for (int t = 0; t < nt; t += 2) {
            const bool last = (t == nt - 2);
            const char* a1 = cA + (size_t)(t + 1) * kstep;
            const char* a2 = last ? nA : cA + (size_t)(t + 2) * kstep; const char* b2 = last ? nB : cB + (size_t)(t + 2) * kstep;
            const char* a3 = a2 + kstep; const char* b3 = b2 + kstep;
            PG8_LDB(B0, 0, 0); PG8_SCHED; PG8_LDA(At, 0, 0); PG8_STAGEA(PG8_SA(1, 1), a1, 1, false);
            PG8_WAIT_L(8); PG8_BAR; PG8_WAIT_L(0); PG8_MMA(0, 0, At, B0); PG8_BAR; PG8_SCHED;
            PG8_LDB(B1, 0, 1); PG8_STAGE(PG8_SB(0, 0), b2, voffB);
            PG8_BAR; PG8_WAIT_L(0); PG8_MMA(0, 1, At, B1); PG8_BAR;
            PG8_LDA(At, 0, 1); PG8_STAGEA(PG8_SA(0, 0), a2, 0, last);
            PG8_BAR; PG8_WAIT_L(0); PG8_MMA(1, 0, At, B0); PG8_BAR; PG8_SCHED;
            PG8_STAGE(PG8_SB(0, 1), b2 + hstep, voffB);
            PG8_WAIT_V(6); PG8_BAR; PG8_MMA(1, 1, At, B1); PG8_BAR;
            PG8_LDB(B0, 1, 0); PG8_SCHED; PG8_LDA(At, 1, 0); PG8_STAGEA(PG8_SA(0, 1), a2, 1, last);
            PG8_WAIT_L(8); PG8_BAR; PG8_WAIT_L(0); PG8_MMA(0, 0, At, B0); PG8_BAR; PG8_SCHED;
            PG8_LDB(B1, 1, 1); PG8_STAGE(PG8_SB(1, 0), b3, voffB);
            PG8_BAR; PG8_WAIT_L(0); PG8_MMA(0, 1, At, B1); PG8_BAR;
            PG8_LDA(At, 1, 1); PG8_STAGEA(PG8_SA(1, 0), a3, 0, last);
            PG8_BAR; PG8_WAIT_L(0); PG8_MMA(1, 0, At, B0); PG8_BAR; PG8_SCHED;
            PG8_STAGE(PG8_SB(1, 1), b3 + hstep, voffB);
            PG8_WAIT_V(6); PG8_BAR; PG8_MMA(1, 1, At, B1); PG8_BAR;
        }
        E(acc, cur, wr, wc, fr, fq);
        if (!has_next) break;
#pragma unroll
        for (int a = 0; a < 2; ++a)
#pragma unroll
            for (int b = 0; b < 2; ++b)
#pragma unroll
                for (int m = 0; m < 4; ++m)
#pragma unroll
                    for (int n = 0; n < 2; ++n) acc[a][b][m][n] = (f32x4){0.f, 0.f, 0.f, 0.f};
        cur = nxt; cA = nA; cB = nB; ++ui;
        if constexpr (GATHER) { _Pragma("unroll") for (int _h = 0; _h < 2; ++_h) _Pragma("unroll") for (int _i = 0; _i < 2; ++_i) ca[_h][_i] = na[_h][_i]; }
    }
    PG8_WAIT_V(0);
    if (wr == 0) PG8_BAR;
    PG8_BAR;
#undef PG8_SA
#undef PG8_SB
#undef PG8_STAGE
#undef PG8_STAGEA
#undef PG8_GOFF
#undef PG8_LDA
#undef PG8_LDB
#undef PG8_MMA
#undef PG8_WAIT_V
#undef PG8_WAIT_L
#undef PG8_BAR
#undef PG8_SCHED
}

struct SchedDense {
    int nM, nN, nwg, G, c, K; const char* A; const char* Bt;
    __device__ __forceinline__ bool next(int i, Unit& u) const {
        const long L = (long)i * G + c; if (L >= nwg) return false;
        int wgid = (int)L; { const int q = nwg / 8, r = nwg % 8, xcd = wgid % 8, off = wgid / 8; wgid = (xcd < r ? xcd * (q + 1) : r * (q + 1) + (xcd - r) * q) + off; }
        const int nig = 8 * nN, gid = wgid / nig, fm = gid * 8, gsz = (nM - fm) < 8 ? (nM - fm) : 8;
        u.pm = fm + ((wgid % nig) % gsz); u.pn = (wgid % nig) / gsz;
        u.a = A + (size_t)u.pm * 256 * K * 2; u.b = Bt + (size_t)u.pn * 256 * K * 2; return true;
    }
};
struct SchedMoE {
    int ntiles, G, c, K; const LAS int* tex; const LAS int* pst; const LAS int* cnt; const int* tok; const char* A; const char* Bt; size_t bstride; bool gather;
    __device__ __forceinline__ bool next(int i, Unit& u) const {
        const int L = i * G + c; const int rt = L >> 2; if (rt >= ntiles) return false;
        u.pm = rt; u.pn = L & 3; const int e = tex[rt];
        u.a = gather ? A : A + (size_t)rt * 256 * K * 2; u.b = Bt + (size_t)e * bstride + (size_t)u.pn * 256 * K * 2; return true;
    }
    __device__ __forceinline__ unsigned row_off(const Unit& u, int r) const {
        const int e = tex[u.pm], idx = (u.pm - (pst[e] >> 8)) * 256 + r;
        const int t = idx < cnt[e] ? tok[e * 16384 + idx] : 0;
        return (unsigned)t * (unsigned)(K * 2);
    }
};
}

typedef const f32x4 (&AccRef)[2][2][4][2];
struct EpiZ {
    static constexpr bool PERM = true; bf16_t* Z; float* G;
    __device__ __forceinline__ void operator()(AccRef acc, const pg8::Unit& u, int wr, int wc, int fr, int fq) const {
        const int row0 = u.pm * 256 + wr * 64 + fr;
        if (u.pn < 14) {
            const int col0 = u.pn * 256 + wc * 32 + 8 * fq;
#pragma unroll
            for (int ai = 0; ai < 2; ++ai)
#pragma unroll
                for (int m = 0; m < 4; ++m) { bf16_t* rowp = Z + (size_t)(row0 + ai * 128 + m * 16) * ZLD + col0;
#pragma unroll
                    for (int bj = 0; bj < 2; ++bj) { const f32x4 v0 = acc[ai][bj][m][0], v1 = acc[ai][bj][m][1];
                        u32x4 o; o.x = pk2(v0[0], v0[1]); o.y = pk2(v0[2], v0[3]); o.z = pk2(v1[0], v1[1]); o.w = pk2(v1[2], v1[3]);
                        *(u32x4*)(rowp + bj * 128) = o; } }
        } else {
            const int c0 = wc * 32 + 8 * fq;
            if (c0 < 48) {
#pragma unroll
                for (int ai = 0; ai < 2; ++ai)
#pragma unroll
                    for (int m = 0; m < 4; ++m) { float* rowp = G + (size_t)(row0 + ai * 128 + m * 16) * 48 + c0;
                        *(f32x4*)rowp = acc[ai][0][m][0]; *(f32x4*)(rowp + 4) = acc[ai][0][m][1]; }
            }
        }
    }
};
struct EpiX1 {
    static constexpr bool PERM = true; const float* x; const float* mod; bf16_t* x1; float* pss;
    __device__ __forceinline__ void operator()(AccRef acc, const pg8::Unit& u, int wr, int wc, int fr, int fq) const {
        const int row0 = u.pm * 256 + wr * 64 + fr, col0 = u.pn * 256 + wc * 32 + 8 * fq;
        const float* g1 = mod + (size_t)(u.pm >> 4) * 6144 + 2048;
        f32x4 gv[2][2];
#pragma unroll
        for (int bj = 0; bj < 2; ++bj)
#pragma unroll
            for (int n = 0; n < 2; ++n) gv[bj][n] = *(const f32x4*)(g1 + col0 + bj * 128 + n * 4);
#pragma unroll
        for (int ai = 0; ai < 2; ++ai)
#pragma unroll
            for (int m = 0; m < 4; ++m) { const int row = row0 + ai * 128 + m * 16; const size_t off = (size_t)row * D + col0; float ss = 0.f;
#pragma unroll
                for (int bj = 0; bj < 2; ++bj) { const f32x4 xa = *(const f32x4*)(x + off + bj * 128), xb = *(const f32x4*)(x + off + bj * 128 + 4);
                    const f32x4 oa = xa + gv[bj][0] * acc[ai][bj][m][0], ob = xb + gv[bj][1] * acc[ai][bj][m][1];
                    ss += oa.x * oa.x + oa.y * oa.y + oa.z * oa.z + oa.w * oa.w + ob.x * ob.x + ob.y * ob.y + ob.z * ob.z + ob.w * ob.w;
                    u32x4 o; o.x = pk2(oa.x, oa.y); o.y = pk2(oa.z, oa.w); o.z = pk2(ob.x, ob.y); o.w = pk2(ob.z, ob.w);
                    *(u32x4*)(x1 + off + bj * 128) = o; }
                ss += __shfl_xor(ss, 16); ss += __shfl_xor(ss, 32);
                if (fq == 0) pss[(size_t)row * 16 + u.pn * 4 + wc] = ss; }
    }
};
struct EpiH {
    static constexpr bool PERM = true; bf16_t* H;
    __device__ __forceinline__ void operator()(AccRef acc, const pg8::Unit& u, int wr, int wc, int fr, int fq) const {
        const int row0 = u.pm * 256 + wr * 64 + fr, col0 = u.pn * 128 + wc * 32 + 8 * fq;
#pragma unroll
        for (int ai = 0; ai < 2; ++ai)
#pragma unroll
            for (int m = 0; m < 4; ++m) { bf16_t* rowp = H + (size_t)(row0 + ai * 128 + m * 16) * 512 + col0;
                float h[8];
#pragma unroll
                for (int n = 0; n < 2; ++n)
#pragma unroll
                    for (int j = 0; j < 4; ++j) { const float g = acc[ai][0][m][n][j], up = acc[ai][1][m][n][j]; h[n * 4 + j] = siluf(g) * up; }
                u32x4 o; o.x = pk2(h[0], h[1]); o.y = pk2(h[2], h[3]); o.z = pk2(h[4], h[5]); o.w = pk2(h[6], h[7]);
                *(u32x4*)rowp = o; }
    }
};
struct EpiY {
    static constexpr bool PERM = true; bf16_t* Y;
    __device__ __forceinline__ void operator()(AccRef acc, const pg8::Unit& u, int wr, int wc, int fr, int fq) const {
        const int row0 = u.pm * 256 + wr * 64 + fr, col0 = u.pn * 256 + wc * 32 + 8 * fq;
#pragma unroll
        for (int ai = 0; ai < 2; ++ai)
#pragma unroll
            for (int m = 0; m < 4; ++m) { bf16_t* rowp = Y + (size_t)(row0 + ai * 128 + m * 16) * D + col0;
#pragma unroll
                for (int bj = 0; bj < 2; ++bj) { const f32x4 v0 = acc[ai][bj][m][0], v1 = acc[ai][bj][m][1];
                    u32x4 o; o.x = pk2(v0[0], v0[1]); o.y = pk2(v0[2], v0[3]); o.z = pk2(v1[0], v1[1]); o.w = pk2(v1[2], v1[3]);
                    *(u32x4*)(rowp + bj * 128) = o; } }
    }
};

__device__ __forceinline__ void p0_mod_item(const P& p, LAS unsigned char* lds, int item) {
    LAS float* SV = (LAS float*)lds; LAS float* PS = (LAS float*)(lds + 20480);
    const int tid = threadIdx.x;
    for (int i = tid; i < 5 * 1024; i += NTHR) { const int v = i >> 10, k = i & 1023; const float c = v < 4 ? p.in[1][v * 1024 + k] : p.in[3][k]; SV[i] = c / (1.f + expf(-c)); }
    __syncthreads();
    const int col = tid & 31, kq = tid >> 5, n = item * 32 + col;
    float acc[5] = {0.f, 0.f, 0.f, 0.f, 0.f};
    const float* W = p.in[4] + (size_t)(kq * 64) * 6144 + n;
#pragma unroll 8
    for (int k = 0; k < 64; ++k) { const float w = W[(size_t)k * 6144]; const int kk = kq * 64 + k;
#pragma unroll
        for (int v = 0; v < 5; ++v) acc[v] += SV[v * 1024 + kk] * w; }
#pragma unroll
    for (int v = 0; v < 5; ++v) PS[(kq * 5 + v) * 32 + col] = acc[v];
    __syncthreads();
    if (tid < 160) { const int v = tid >> 5, c = tid & 31; float s = 0.f;
#pragma unroll
        for (int q = 0; q < 16; ++q) s += PS[(q * 5 + v) * 32 + c];
        ((float*)(p.ws + WS_MOD))[v * 6144 + item * 32 + c] = s + p.in[5][item * 32 + c]; }
    asm volatile("s_waitcnt vmcnt(0)" ::: "memory");
    __syncthreads();
    if (tid == 0) { __builtin_amdgcn_fence(__ATOMIC_RELEASE, "agent"); asm volatile("s_waitcnt vmcnt(0)" ::: "memory");
        (void)__hip_atomic_fetch_add((unsigned*)(p.ws + WS_CTL) + CW_MODF, 1u, __ATOMIC_RELAXED, __HIP_MEMORY_SCOPE_AGENT); }
    __syncthreads();
}
template <class RowMap>
__device__ __forceinline__ void transpose_item(const float* W, int K, int N, bf16_t* WT, LAS float* scr, int kb, int nb, int lane, RowMap rm) {
    const int k0 = 64 * kb, n0 = 32 * nb;
#pragma unroll 8
    for (int i = 0; i < 32; ++i) { const int kk = 2 * i + (lane >> 5), n = n0 + (lane & 31); scr[kk * 33 + (lane & 31)] = n < N ? W[(size_t)(k0 + kk) * N + n] : 0.f; }
    asm volatile("s_waitcnt lgkmcnt(0)" ::: "memory");
    const int c = lane & 7;
#pragma unroll
    for (int j = 0; j < 4; ++j) { const int nl = (lane >> 3) + 8 * j, n = n0 + nl;
        if (n < N) { const LAS float* s = scr + (8 * c) * 33 + nl;
            u32x4 o; o.x = pk2(s[0 * 33], s[1 * 33]); o.y = pk2(s[2 * 33], s[3 * 33]); o.z = pk2(s[4 * 33], s[5 * 33]); o.w = pk2(s[6 * 33], s[7 * 33]);
            *(u32x4*)(WT + (size_t)rm(n) * K + k0 + 8 * c) = o; } }
    asm volatile("s_waitcnt lgkmcnt(0)" ::: "memory");
}
struct RmIn { __device__ __forceinline__ int operator()(int n) const { return n < 1536 ? n : (n < 1568 ? n + 2048 : (n < 3616 ? n - 32 : n)); } };
struct RmId { __device__ __forceinline__ int operator()(int n) const { return n; } };
struct RmE1 { __device__ __forceinline__ int operator()(int n) const { const int half = n >> 9, r = n & 511; return (r >> 7) * 256 + half * 128 + (r & 127); } };

__device__ __forceinline__ void phase0(const P& p, LAS unsigned char* lds) {
    const int tid = threadIdx.x, lane = tid & 63, wave = tid >> 6;
    for (int it = blockIdx.x; it < 192; it += gridDim.x) p0_mod_item(p, lds, it);
    LAS float* scr = (LAS float*)(lds + wave * 16384);
    const int gw = blockIdx.x * 8 + wave, NGW = gridDim.x * 8;
    constexpr int I_IN = 16 * 114, I_OUT = 16 * 32, I_E1 = 32 * 16 * 32, NIT = I_IN + I_OUT + I_E1;
    bf16_t* WINT = (bf16_t*)(p.ws + WS_WINT); bf16_t* WOUTT = (bf16_t*)(p.ws + WS_WOUTT); bf16_t* E1T = (bf16_t*)(p.ws + WS_E1T);
    for (int it = gw; it < NIT; it += NGW) {
        int r = it;
        if (r < I_IN) { transpose_item(p.in[7], 1024, INW, WINT, scr, r / 114, r % 114, lane, RmIn()); continue; } r -= I_IN;
        if (r < I_OUT) { transpose_item(p.in[16], 1024, 1024, WOUTT, scr, r >> 5, r & 31, lane, RmId()); continue; } r -= I_OUT;
        { const int e = r >> 9, q = r & 511; transpose_item(p.in[22] + (size_t)e * 1024 * 1024, 1024, 1024, E1T + (size_t)e * 1024 * 1024, scr, q >> 5, q & 31, lane, RmE1()); }
    }
    for (int i = blockIdx.x * NTHR + tid; i < 208 * 128; i += gridDim.x * NTHR) ((u32x4*)(WINT + (size_t)INW * 1024))[i] = (u32x4){0u, 0u, 0u, 0u};
}

__device__ __forceinline__ void phase1(const P& p) {
    const int tid = threadIdx.x, lane = tid & 63, wave = tid >> 6;
    if (FUSE01) {
        if (tid == 0) { unsigned* f = (unsigned*)(p.ws + WS_CTL) + CW_MODF; unsigned sp = 0;
            while (__hip_atomic_load(f, __ATOMIC_RELAXED, __HIP_MEMORY_SCOPE_AGENT) < 192u) { __builtin_amdgcn_s_sleep(2); if (++sp > (1u << 24)) break; }
            __builtin_amdgcn_fence(__ATOMIC_ACQUIRE, "agent"); asm volatile("s_waitcnt vmcnt(0)" ::: "memory"); }
        __syncthreads();
    }
    const float* mod = (const float*)(p.ws + WS_MOD); bf16_t* A = (bf16_t*)(p.ws + WS_A);
    const int gw = blockIdx.x * 8 + wave, NGW = gridDim.x * 8;
    for (int r0 = gw * 2; r0 < MT; r0 += NGW * 2) {
        f32x4 v[2][4]; float ss[2];
#pragma unroll
        for (int q = 0; q < 2; ++q) { const int row = r0 + q; const float* src = row < MX ? p.in[0] + (size_t)row * D : p.in[2] + (size_t)(row - MX) * D;
#pragma unroll
            for (int j = 0; j < 4; ++j) v[q][j] = *(const f32x4*)(src + 4 * lane + 256 * j); }
#pragma unroll
        for (int q = 0; q < 2; ++q) { float s0 = 0.f;
#pragma unroll
            for (int j = 0; j < 4; ++j) s0 += v[q][j].x * v[q][j].x + v[q][j].y * v[q][j].y + v[q][j].z * v[q][j].z + v[q][j].w * v[q][j].w;
            ss[q] = wave_sum(s0); }
#pragma unroll
        for (int q = 0; q < 2; ++q) { const int row = r0 + q; const float rstd = 1.f / sqrtf(ss[q] * (1.f / D) + EPS);
            const float* mv = mod + (size_t)(row < MX ? (row >> 12) : 4) * 6144;
#pragma unroll
            for (int j = 0; j < 4; ++j) { const int k = 4 * lane + 256 * j;
                const f32x4 g = *(const f32x4*)(p.in[6] + k), sh = *(const f32x4*)(mv + k), sc = *(const f32x4*)(mv + 1024 + k);
                const f32x4 o = (v[q][j] * rstd * g) * (sc + 1.f) + sh;
                u32x2 w; w.x = pk2(o.x, o.y); w.y = pk2(o.z, o.w);
                *(u32x2*)(A + (size_t)row * D + k) = w; } }
    }
}

#define STGF(fn, k) do { if (STAGE_SEL >= 0 && STAGE_FN == (fn)) { const unsigned long long _n = __builtin_amdgcn_s_memrealtime(); if (STAGE_SEL == (k) || STAGE_SEL == 99) tacc += _n - tprev; tprev = _n; } } while (0)
#define STG_SPIN(fn) do { if (STAGE_SEL >= 0 && STAGE_FN == (fn) && (blockIdx.x == 0 || STAGE_SEL == 99) && threadIdx.x == 0) { const unsigned long long t0 = __builtin_amdgcn_s_memrealtime(); while (__builtin_amdgcn_s_memrealtime() - t0 < tacc * STAGE_K) __builtin_amdgcn_s_sleep(8); } } while (0)
struct ConvItem { int rowbase, y, H, W, x0, valid; };
__device__ __forceinline__ ConvItem conv_item(int it) {
    ConvItem c; const int r = it >> 3; c.valid = it < 2176;
    if (r < 256) { c.rowbase = (r >> 6) * 4096; c.y = r & 63; c.H = 64; c.W = 64; c.x0 = 0; }
    else { const int ci = r - 256; c.rowbase = MX + (ci >> 2) * 256; c.y = 0; c.H = 1; c.W = 256; c.x0 = (ci & 3) * 64; }
    return c;
}
__device__ __forceinline__ void conv_load(const bf16_t* Z, const ConvItem& c, int sl, int tid, u32x4 (&rg)[6], u32x4& halo) {
    const u32x4 z4 = {0u, 0u, 0u, 0u};
#pragma unroll
    for (int i = 0; i < 6; ++i) { const int q = tid + NTHR * i, dy = q >> 10, x = (q >> 4) & 63, cg = q & 15, yy = c.y + dy - 1;
        rg[i] = (c.valid && yy >= 0 && yy < c.H) ? *(const u32x4*)(Z + (size_t)(c.rowbase + yy * c.W + c.x0 + x) * ZLD + 1536 + sl * 128 + cg * 8) : z4; }
    halo = z4;
    if (tid < 32 && c.valid) { const int side = tid >> 4, cg = tid & 15, xx = side ? c.x0 + 64 : c.x0 - 1;
        if (xx >= 0 && xx < c.W) halo = *(const u32x4*)(Z + (size_t)(c.rowbase + c.y * c.W + xx) * ZLD + 1536 + sl * 128 + cg * 8); }
}
#define CONV_STEP(RG, HALO, IT) do { const int _it = (IT); const ConvItem me = conv_item(_it); const int msl = _it & 7; \
        _Pragma("unroll") for (int i = 0; i < 6; ++i) { const int q = tid + NTHR * i, dy = q >> 10, x = (q >> 4) & 63, c2 = q & 15; *(LAS u32x4*)(T + ((dy * 66 + x + 1) * 128 + c2 * 8)) = RG[i]; } \
        if (tid < 32) { const int side = tid >> 4, c2 = tid & 15; *(LAS u32x4*)(T + ((66 + (side ? 65 : 0)) * 128 + c2 * 8)) = HALO; } \
        else if (tid < 96) { const int q = tid - 32, dy = (q >> 5) * 2, side = (q >> 4) & 1, c2 = q & 15; *(LAS u32x4*)(T + ((dy * 66 + (side ? 65 : 0)) * 128 + c2 * 8)) = (u32x4){0u, 0u, 0u, 0u}; } \
        __syncthreads(); \
        STGF(5, 0); \
        { const int nit = _it + 2 * (int)gridDim.x; const ConvItem nc = conv_item(nit); conv_load(Z, nc, nit & 7, tid, RG, HALO); } \
        const float osc = msl >= 4 ? 0.08838834764831845f : 1.f; bf16_t* dst = msl >= 4 ? MK : MQ; \
        _Pragma("unroll") for (int hx = 0; hx < 2; ++hx) { const int x = xt + 32 * hx; float acc[8]; \
            _Pragma("unroll") for (int j = 0; j < 8; ++j) acc[j] = bias[j]; \
            _Pragma("unroll") for (int dy = 0; dy < 3; ++dy) _Pragma("unroll") for (int dx = 0; dx < 3; ++dx) { const u32x4 v = *(const LAS u32x4*)(T + ((dy * 66 + x + dx) * 128 + cg * 8)); \
                acc[0] += w[dy * 3 + dx][0] * bflo(v.x); acc[1] += w[dy * 3 + dx][1] * bfhi(v.x); acc[2] += w[dy * 3 + dx][2] * bflo(v.y); acc[3] += w[dy * 3 + dx][3] * bfhi(v.y); \
                acc[4] += w[dy * 3 + dx][4] * bflo(v.z); acc[5] += w[dy * 3 + dx][5] * bfhi(v.z); acc[6] += w[dy * 3 + dx][6] * bflo(v.w); acc[7] += w[dy * 3 + dx][7] * bfhi(v.w); } \
            _Pragma("unroll") for (int j = 0; j < 8; ++j) acc[j] = siluf(acc[j]) * osc; \
            u32x4 o; o.x = pk2(acc[0], acc[1]); o.y = pk2(acc[2], acc[3]); o.z = pk2(acc[4], acc[5]); o.w = pk2(acc[6], acc[7]); \
            *(u32x4*)(dst + (size_t)(me.rowbase + me.y * me.W + me.x0 + x) * 512 + (msl & 3) * 128 + cg * 8) = o; } \
        __syncthreads(); STGF(5, 1); } while (0)

__device__ __forceinline__ void phase3(const P& p, LAS unsigned char* lds) {
    const bf16_t* Z = (const bf16_t*)(p.ws + WS_Z); bf16_t* MQ = (bf16_t*)(p.ws + WS_MQ); bf16_t* MK = (bf16_t*)(p.ws + WS_MK);
    const int tid = threadIdx.x, cg = tid & 15, xt = tid >> 4;
    LAS bf16_t* T = (LAS bf16_t*)lds;
    const int G = gridDim.x; int it = blockIdx.x; if (it >= 2176) return;
    const int sl = it & 7;
    if ((G & 7) != 0) return;
    float w[9][8], bias[8];
#pragma unroll
    for (int a = 0; a < 9; ++a) { const f32x4 w0 = *(const f32x4*)(p.in[11] + a * 1024 + sl * 128 + cg * 8), w1 = *(const f32x4*)(p.in[11] + a * 1024 + sl * 128 + cg * 8 + 4);
        w[a][0] = w0.x; w[a][1] = w0.y; w[a][2] = w0.z; w[a][3] = w0.w; w[a][4] = w1.x; w[a][5] = w1.y; w[a][6] = w1.z; w[a][7] = w1.w; }
    { const f32x4 b0 = *(const f32x4*)(p.in[12] + sl * 128 + cg * 8), b1 = *(const f32x4*)(p.in[12] + sl * 128 + cg * 8 + 4);
        bias[0] = b0.x; bias[1] = b0.y; bias[2] = b0.z; bias[3] = b0.w; bias[4] = b1.x; bias[5] = b1.y; bias[6] = b1.z; bias[7] = b1.w; }
    unsigned long long tacc = 0ull, tprev = (STAGE_SEL >= 0) ? __builtin_amdgcn_s_memrealtime() : 0ull;
    u32x4 ra[6], ha, rb[6], hb;
    { const ConvItem c0 = conv_item(it); conv_load(Z, c0, sl, tid, ra, ha); const ConvItem c1 = conv_item(it + G); conv_load(Z, c1, sl, tid, rb, hb); }
    for (; it < 2176; it += 2 * G) { CONV_STEP(ra, ha, it); if (it + G < 2176) CONV_STEP(rb, hb, it + G); }
    STG_SPIN(5);
}
#undef CONV_STEP

__device__ __forceinline__ int chunk_tok0(int b, int tc) { return tc < 64 ? b * SEQ + tc * 64 : MX + b * CTXL + (tc - 64) * 64; }

__device__ __forceinline__ void load_v(const bf16_t* Z, int tok0, int col0, LAS bf16_t* V, int tid) {
#pragma unroll
    for (int i = 0; i < 2; ++i) { const int idx = tid + NTHR * i, t = idx >> 4, c = idx & 15;
        *(LAS u32x4*)(V + t * 136 + c * 8) = *(const u32x4*)(Z + (size_t)(tok0 + t) * ZLD + col0 + c * 8); }
}
__device__ __forceinline__ bf16x8 ldfrag_t(const LAS bf16_t* T, int ld, int k0, int n0, int lane) {
#if USE_TR_READ
    typedef short v4s __attribute__((ext_vector_type(4)));
    const int q = (lane >> 2) & 3, pp = lane & 3, g = lane >> 4;
    const LAS bf16_t* a0 = T + (k0 + 8 * (g >> 1) + q) * ld + n0 + 16 * (g & 1) + 4 * pp;
    const v4s lo = __builtin_bit_cast(v4s, __builtin_amdgcn_ds_read_tr16_b64_v4i16((LAS v4s*)a0));
    const v4s hi = __builtin_bit_cast(v4s, __builtin_amdgcn_ds_read_tr16_b64_v4i16((LAS v4s*)(a0 + 4 * ld)));
    bf16x8 f; f[0] = lo[0]; f[1] = lo[1]; f[2] = lo[2]; f[3] = lo[3]; f[4] = hi[0]; f[5] = hi[1]; f[6] = hi[2]; f[7] = hi[3];
    return f;
#else
    const LAS bf16_t* q = T + (k0 + 8 * (lane >> 5)) * ld + n0 + (lane & 31);
    bf16x8 f;
#pragma unroll
    for (int j = 0; j < 8; ++j) f[j] = (short)q[j * ld];
    return f;
#endif
}

__device__ __forceinline__ void gla_gates(const LAS bf16_t* GLRB, LAS float* QS, bf16x8 upf, float upb, int lane, int wave, float (&la)[16], float (&incl)[16], float& all) {
    const int dir = wave >> 2, tt = (wave >> 1) & 1, dt = wave & 1, hh = lane >> 5, d = dt * 32 + (lane & 31);
    f32x16 acc;
#pragma unroll
    for (int r = 0; r < 16; ++r) acc[r] = 0.f;
    acc = MFMA32(*(const LAS bf16x8*)(GLRB + (tt * 32 + (lane & 31)) * 40 + dir * 16 + 8 * hh), upf, acc);
    float ss[4];
#pragma unroll
    for (int rg = 0; rg < 4; ++rg) { ss[rg] = 0.f;
#pragma unroll
        for (int x = 0; x < 4; ++x) { la[4 * rg + x] = logsigf(acc[4 * rg + x] + upb) * 0.0625f; ss[rg] += la[4 * rg + x]; } }
    float ps[4];
#pragma unroll
    for (int rg = 0; rg < 4; ++rg) ps[rg] = __shfl_xor(ss[rg], 32);
    float before[4]; float run = 0.f;
#pragma unroll
    for (int rg = 0; rg < 4; ++rg) { before[rg] = run + (hh ? ps[rg] : 0.f); run += ss[rg] + ps[rg]; }
    if (hh == 0) QS[(dir * 2 + tt) * 64 + d] = run;
    __syncthreads();
    const float t0 = QS[(dir * 2 + 0) * 64 + d], t1 = QS[(dir * 2 + 1) * 64 + d];
    all = t0 + t1; const float base = tt ? t0 : 0.f;
#pragma unroll
    for (int rg = 0; rg < 4; ++rg) { float c = base + before[rg];
#pragma unroll
        for (int x = 0; x < 4; ++x) { c += la[4 * rg + x]; incl[4 * rg + x] = c; } }
}

struct G4Regs { u32x4 v[2]; u32x4 k; f32x4 glr; float upw[8]; float upb; };
struct M4Regs { u32x4 v[2]; u32x4 k[2]; float gi, gf; };
__device__ __forceinline__ void item_bhc(int r, int& b, int& h, int& tc) { b = r / (4 * NCH); h = (r / NCH) & 3; tc = r % NCH; }

__device__ __forceinline__ void g4_load(const P& p, int r, int tid, G4Regs& R) {
    int b, h, tc; item_bhc(r, b, h, tc); const int tok0 = chunk_tok0(b, tc);
    const bf16_t* Z = (const bf16_t*)(p.ws + WS_Z); const float* GT = (const float*)(p.ws + WS_GATES);
#pragma unroll
    for (int i = 0; i < 2; ++i) { const int idx = tid + NTHR * i, t = idx >> 4, c = idx & 15; R.v[i] = *(const u32x4*)(Z + (size_t)(tok0 + t) * ZLD + 512 + h * 128 + c * 8); }
    const int t = tid >> 3, c = tid & 7;
    R.glr = *(const f32x4*)(GT + (size_t)(tok0 + t) * 48 + c * 4);
    R.k = *(const u32x4*)(Z + (size_t)(tok0 + t) * ZLD + 256 + h * 64 + c * 8);
    { const int w = tid >> 6, dir = w >> 2, d = (w & 1) * 32 + (tid & 31), hh = (tid >> 5) & 1;
#pragma unroll
        for (int q = 0; q < 8; ++q) R.upw[q] = p.in[8][(dir * 16 + 8 * hh + q) * 256 + h * 64 + d];
        R.upb = p.in[9][dir * 256 + h * 64 + d]; }
}
__device__ __forceinline__ void p4_gla(const P& p, LAS unsigned char* lds, int r, G4Regs& R, int rnext, unsigned long long& tacc, int qid, int& nn) {
    unsigned long long tprev = (STAGE_SEL >= 0) ? __builtin_amdgcn_s_memrealtime() : 0ull;
    const int tid = threadIdx.x, lane = tid & 63, wave = __builtin_amdgcn_readfirstlane(tid >> 6);
    int b, h, tc; item_bhc(r, b, h, tc);
    const int sidx = (b * 4 + h) * NCH + tc;
    LAS bf16_t* V = (LAS bf16_t*)lds; LAS bf16_t* KW = (LAS bf16_t*)(lds + 17408); LAS bf16_t* GLRB = (LAS bf16_t*)(lds + 35840); LAS float* QS = (LAS float*)(lds + 44032);
    LAS bf16_t* KR = (LAS bf16_t*)(lds + 46080); LAS bf16_t* OUT = (LAS bf16_t*)(lds + 55296);
#pragma unroll
    for (int i = 0; i < 2; ++i) { const int idx = tid + NTHR * i, t = idx >> 4, c = idx & 15; *(LAS u32x4*)(V + t * 136 + c * 8) = R.v[i]; }
    { const int t = tid >> 3, c = tid & 7; u32x2 g; g.x = pk2(R.glr.x, R.glr.y); g.y = pk2(R.glr.z, R.glr.w); *(LAS u32x2*)(GLRB + t * 40 + c * 4) = g; *(LAS u32x4*)(KR + t * 72 + c * 8) = R.k; }
    u32x4 upq; upq.x = pk2(R.upw[0], R.upw[1]); upq.y = pk2(R.upw[2], R.upw[3]); upq.z = pk2(R.upw[4], R.upw[5]); upq.w = pk2(R.upw[6], R.upw[7]);
    const float upb = R.upb;
    __syncthreads();
    STGF(2, 0);
    if (rnext < NSTATE) g4_load(p, rnext, tid, R);
    const int dir = wave >> 2, tt = (wave >> 1) & 1, d = (wave & 1) * 32 + (lane & 31);
    float la[16], incl[16], all;
    gla_gates(GLRB, QS, __builtin_bit_cast(bf16x8, upq), upb, lane, wave, la, incl, all);
    STGF(2, 1);
#pragma unroll
    for (int i = 0; i < 16; ++i) { const int t = tt * 32 + 8 * (i >> 2) + 4 * (lane >> 5) + (i & 3);
        const float kx = bf2f(KR[t * 72 + d]);
        const float e = dir == 0 ? all - incl[i] : incl[i] - la[i];
        KW[(dir * 64 + t) * 72 + d] = (bf16_t)f2bf(kx * __expf(e)); }
    const int tq = tt * 2 + (lane >> 5);
    if (tq == 0) ((float*)(p.ws + WS_GDEC))[(sidx * 2 + dir) * 64 + d] = __expf(all);
    __syncthreads();
    STGF(2, 2);
    const int dw = wave >> 2, vt = wave & 3;
    f32x16 acc0, acc1;
#pragma unroll
    for (int q = 0; q < 16; ++q) { acc0[q] = 0.f; acc1[q] = 0.f; }
#pragma unroll
    for (int ks = 0; ks < 4; ++ks) { const bf16x8 vb = ldfrag_t(V, 136, ks * 16, vt * 32, lane);
        const bf16x8 a0 = ldfrag_t(KW + dw * 64 * 72, 72, ks * 16, 0, lane), a1 = ldfrag_t(KW + dw * 64 * 72, 72, ks * 16, 32, lane);
        acc0 = MFMA32(a0, vb, acc0); acc1 = MFMA32(a1, vb, acc1); }
    { LAS unsigned char* orow = (LAS unsigned char*)OUT + (dw * 128 + vt * 32 + (lane & 31)) * 80 + 4 * (lane >> 5);
#pragma unroll
        for (int rg = 0; rg < 4; ++rg) {
            *(LAS unsigned*)(orow + 8 * rg) = pk4_fp8(acc0[4 * rg] * SG_SCALE, acc0[4 * rg + 1] * SG_SCALE, acc0[4 * rg + 2] * SG_SCALE, acc0[4 * rg + 3] * SG_SCALE);
            *(LAS unsigned*)(orow + 32 + 8 * rg) = pk4_fp8(acc1[4 * rg] * SG_SCALE, acc1[4 * rg + 1] * SG_SCALE, acc1[4 * rg + 2] * SG_SCALE, acc1[4 * rg + 3] * SG_SCALE); } }
    __syncthreads();
    STGF(2, 3);
    unsigned char* U = (unsigned char*)(p.ws + WS_UG) + (size_t)(sidx * 2) * 8192;
#pragma unroll
    for (int i = 0; i < 2; ++i) { const int idx = tid + NTHR * i, row = idx >> 2, c = idx & 3; *(u32x4*)(U + (size_t)row * 64 + c * 16) = *(const LAS u32x4*)((const LAS unsigned char*)OUT + row * 80 + c * 16); }
    if (threadIdx.x == 0) *(LAS int*)(lds + LDS_NQ) = qid;
    __syncthreads();
    nn = *(const LAS int*)(lds + LDS_NQ);
    STGF(2, 4);
}

__device__ __forceinline__ void m4_load(const P& p, int r, int tid, M4Regs& R) {
    int b, h, tc; item_bhc(r, b, h, tc); const int tok0 = chunk_tok0(b, tc);
    const bf16_t* Z = (const bf16_t*)(p.ws + WS_Z); const bf16_t* MK = (const bf16_t*)(p.ws + WS_MK);
#pragma unroll
    for (int i = 0; i < 2; ++i) { const int idx = tid + NTHR * i, t = idx >> 4, c = idx & 15;
        R.v[i] = *(const u32x4*)(Z + (size_t)(tok0 + t) * ZLD + 2560 + h * 128 + c * 8);
        R.k[i] = *(const u32x4*)(MK + (size_t)(tok0 + t) * 512 + h * 128 + c * 8); }
    R.gi = 0.f; R.gf = 0.f;
    if (tid < 128) { const int dir = tid >> 6, t = tid & 63; const float* g = (const float*)(p.ws + WS_GATES) + (size_t)(tok0 + t) * 48; R.gi = g[32 + dir * 4 + h] + p.in[13][dir * 4 + h]; R.gf = g[40 + dir * 4 + h] + p.in[14][dir * 4 + h]; }
}
__device__ __forceinline__ void p4_ml(const P& p, LAS unsigned char* lds, int r, M4Regs& R, int rnext, unsigned long long& tacc, int qid, int& nn) {
    unsigned long long tprev = (STAGE_SEL >= 0) ? __builtin_amdgcn_s_memrealtime() : 0ull;
    const int tid = threadIdx.x, lane = tid & 63, wave = __builtin_amdgcn_readfirstlane(tid >> 6);
    int b, h, tc; item_bhc(r, b, h, tc);
    const int sidx = (b * 4 + h) * NCH + tc;
    LAS bf16_t* V = (LAS bf16_t*)lds; LAS bf16_t* KW = (LAS bf16_t*)(lds + 17408);
    LAS float* IG = (LAS float*)(lds + 52224); LAS float* LF = IG + 128; LAS float* KG = IG + 256;
    LAS bf16_t* KR = (LAS bf16_t*)(lds + 53760); LAS bf16_t* OUT = (LAS bf16_t*)(lds + 71168); LAS float* NP = (LAS float*)(lds + 144384);
#pragma unroll
    for (int i = 0; i < 2; ++i) { const int idx = tid + NTHR * i, t = idx >> 4, c = idx & 15; *(LAS u32x4*)(V + t * 136 + c * 8) = R.v[i]; *(LAS u32x4*)(KR + t * 136 + c * 8) = R.k[i]; }
    if (tid < 128) { const int dir = tid >> 6, t = tid & 63; IG[dir * 64 + t] = R.gi; LF[dir * 64 + t] = logsigf(R.gf); }
    __syncthreads();
    STGF(3, 0);
    if (rnext < NSTATE) m4_load(p, rnext, tid, R);
    if (tid < 128) { const int dir = tid >> 6, t = tid & 63;
        const float lf = LF[dir * 64 + t], a = scan_sum_up(lf, t), tot = __shfl(a, 63);
        const float g = (dir == 0 ? tot - a : a - lf) + IG[dir * 64 + t];
        const float ml = wave_max(g);
        KG[dir * 64 + t] = __expf(g - ml);
        if (t == 0) { float* sc = (float*)(p.ws + WS_MSC) + (size_t)(sidx * 2 + dir) * 4; sc[0] = tot; sc[1] = ml; } }
    __syncthreads();
    STGF(3, 1);
    { const int dir = tid >> 8, th = (tid >> 7) & 1, d = tid & 127; float ns = 0.f;
#pragma unroll 8
        for (int i = 0; i < 32; ++i) { const int t = th * 32 + i; const float kx = bf2f(KR[t * 136 + d]);
            const unsigned kb = f2bf(kx * KG[dir * 64 + t]); KW[(dir * 64 + t) * 136 + d] = (bf16_t)kb; ns += bf2f(kb); }
        NP[(dir * 2 + th) * 128 + d] = ns; }
    __syncthreads();
    STGF(3, 2);
    if (tid < 256) { const int dir = tid >> 7, d = tid & 127;
        ((float*)(p.ws + WS_MN))[(size_t)(sidx * 2 + dir) * 128 + d] = NP[(dir * 2) * 128 + d] + NP[(dir * 2 + 1) * 128 + d]; }
    const int dw = wave >> 2, vt = wave & 3;
    f32x16 acc[4];
#pragma unroll
    for (int q = 0; q < 4; ++q)
#pragma unroll
        for (int x = 0; x < 16; ++x) acc[q][x] = 0.f;
#pragma unroll
    for (int ks = 0; ks < 4; ++ks) { const bf16x8 vb = ldfrag_t(V, 136, ks * 16, vt * 32, lane);
#pragma unroll
        for (int q = 0; q < 4; ++q) { const bf16x8 aq = ldfrag_t(KW + dw * 64 * 136, 136, ks * 16, q * 32, lane); acc[q] = MFMA32(aq, vb, acc[q]); } }
    { LAS unsigned char* orow = (LAS unsigned char*)OUT + (dw * 128 + vt * 32 + (lane & 31)) * 144 + 4 * (lane >> 5);
#pragma unroll
        for (int q = 0; q < 4; ++q)
#pragma unroll
            for (int rg = 0; rg < 4; ++rg) *(LAS unsigned*)(orow + q * 32 + 8 * rg) = pk4_fp8(acc[q][4 * rg] * SM_SCALE, acc[q][4 * rg + 1] * SM_SCALE, acc[q][4 * rg + 2] * SM_SCALE, acc[q][4 * rg + 3] * SM_SCALE); }
    __syncthreads();
    STGF(3, 3);
    unsigned char* U = (unsigned char*)(p.ws + WS_UM) + (size_t)(sidx * 2) * 16384;
#pragma unroll
    for (int i = 0; i < 4; ++i) { const int idx = tid + NTHR * i, row = idx >> 3, c = idx & 7; *(u32x4*)(U + (size_t)row * 128 + c * 16) = *(const LAS u32x4*)((const LAS unsigned char*)OUT + row * 144 + c * 16); }
    if (threadIdx.x == 0) *(LAS int*)(lds + LDS_NQ) = qid;
    __syncthreads();
    nn = *(const LAS int*)(lds + LDS_NQ);
    STGF(3, 4);
}

#define DYN_LOOP(REGS, LOADFN, ITEMFN, NITEMS, QW, FN) do { REGS R; unsigned long long tacc = 0ull; unsigned* Qh = (unsigned*)(p.ws + WS_CTL) + CW_Q + 64 * (QW); LAS int* NQ = (LAS int*)(lds + LDS_NQ); \
        const int G_ = gridDim.x; int cur = blockIdx.x; unsigned qv = 0u; \
        if (tid == 0) qv = __hip_atomic_fetch_add(Qh, 1u, __ATOMIC_RELAXED, __HIP_MEMORY_SCOPE_AGENT); \
        if (cur < (NITEMS)) LOADFN(p, cur, tid, R); \
        if (tid == 0) NQ[0] = G_ + (int)qv; \
        __syncthreads(); \
        int nxt = NQ[0]; \
        while (cur < (NITEMS)) { unsigned q2 = 0u; if (tid == 0) q2 = __hip_atomic_fetch_add(Qh, 1u, __ATOMIC_RELAXED, __HIP_MEMORY_SCOPE_AGENT); \
            int nn; ITEMFN(p, lds, cur, R, nxt, tacc, G_ + (int)q2, nn); cur = nxt; nxt = nn; } \
        STG_SPIN(FN); } while (0)

__device__ __forceinline__ void phase4(const P& p, LAS unsigned char* lds) {
    const int tid = threadIdx.x;
    DYN_LOOP(G4Regs, g4_load, p4_gla, NSTATE, 0, 2);
    DYN_LOOP(M4Regs, m4_load, p4_ml, NSTATE, 1, 3);
}

__device__ __forceinline__ int tc_of(int c, int dir) { return dir == 0 ? (c < 4 ? 64 + c : c - 4) : (c < 4 ? 67 - c : 67 - c); }

__device__ __forceinline__ void phase5(const P& p) {
    const int gtid = ((threadIdx.x >> 6) * gridDim.x + blockIdx.x) * 64 + (threadIdx.x & 63), nthr = gridDim.x * NTHR;
    constexpr int PF = 12;
    for (int task = gtid; task < 32768 + 65536 + 512; task += nthr) {
        if (task < 32768) {
            const int chain = task >> 10, e8 = task & 1023, bh = chain >> 1, dir = chain & 1, d0 = (e8 & 7) * 8;
            unsigned char* UG = (unsigned char*)(p.ws + WS_UG); const float* GD = (const float*)(p.ws + WS_GDEC);
            float s[8];
#pragma unroll
            for (int j = 0; j < 8; ++j) s[j] = 0.f;
            u32x2 ub[PF]; f32x4 da[PF], db[PF];
#pragma unroll
            for (int i = 0; i < PF; ++i) { const int si = (bh * NCH + tc_of(i, dir)) * 2 + dir;
                ub[i] = *(const u32x2*)(UG + (size_t)si * 8192 + e8 * 8); da[i] = *(const f32x4*)(GD + si * 64 + d0); db[i] = *(const f32x4*)(GD + si * 64 + d0 + 4); }
            for (int c0 = 0; c0 < NCH; c0 += PF) {
#pragma unroll
                for (int i = 0; i < PF; ++i) { const int c = c0 + i; if (c < NCH) { const int si = (bh * NCH + tc_of(c, dir)) * 2 + dir;
                    const u32x2 u = ub[i]; const f32x4 a = da[i], bq = db[i];
                    if (c + PF < NCH) { const int sn = (bh * NCH + tc_of(c + PF, dir)) * 2 + dir;
                        ub[i] = *(const u32x2*)(UG + (size_t)sn * 8192 + e8 * 8); da[i] = *(const f32x4*)(GD + sn * 64 + d0); db[i] = *(const f32x4*)(GD + sn * 64 + d0 + 4); }
                    u32x2 o; o.x = pk4_fp8(s[0], s[1], s[2], s[3]); o.y = pk4_fp8(s[4], s[5], s[6], s[7]);
                    *(u32x2*)(UG + (size_t)si * 8192 + e8 * 8) = o;
                    float ua[4], uc[4]; up4_fp8(u.x, ua); up4_fp8(u.y, uc);
                    s[0] = a.x * s[0] + ua[0]; s[1] = a.y * s[1] + ua[1]; s[2] = a.z * s[2] + ua[2]; s[3] = a.w * s[3] + ua[3];
                    s[4] = bq.x * s[4] + uc[0]; s[5] = bq.y * s[5] + uc[1]; s[6] = bq.z * s[6] + uc[2]; s[7] = bq.w * s[7] + uc[3]; } }
            }
        } else if (task < 98304) {
            const int tk = task - 32768, chain = tk >> 11, e8 = tk & 2047, bh = chain >> 1, dir = chain & 1;
            unsigned char* UM = (unsigned char*)(p.ws + WS_UM); float* SC = (float*)(p.ws + WS_MSC);
            float s[8];
#pragma unroll
            for (int j = 0; j < 8; ++j) s[j] = 0.f;
            float m = 0.f;
            u32x2 ub[PF]; float ae[PF], ml[PF];
#pragma unroll
            for (int i = 0; i < PF; ++i) { const int si = (bh * NCH + tc_of(i, dir)) * 2 + dir;
                ub[i] = *(const u32x2*)(UM + (size_t)si * 16384 + e8 * 8); ae[i] = SC[si * 4 + 0]; ml[i] = SC[si * 4 + 1]; }
            for (int c0 = 0; c0 < NCH; c0 += PF) {
#pragma unroll
                for (int i = 0; i < PF; ++i) { const int c = c0 + i; if (c < NCH) { const int si = (bh * NCH + tc_of(c, dir)) * 2 + dir;
                    const u32x2 u = ub[i]; const float aend = ae[i], mloc = ml[i];
                    if (c + PF < NCH) { const int sn = (bh * NCH + tc_of(c + PF, dir)) * 2 + dir;
                        ub[i] = *(const u32x2*)(UM + (size_t)sn * 16384 + e8 * 8); ae[i] = SC[sn * 4 + 0]; ml[i] = SC[sn * 4 + 1]; }
                    u32x2 o; o.x = pk4_fp8(s[0], s[1], s[2], s[3]); o.y = pk4_fp8(s[4], s[5], s[6], s[7]);
                    *(u32x2*)(UM + (size_t)si * 16384 + e8 * 8) = o;
                    if (e8 == 0) SC[si * 4 + 2] = m;
                    const float mn = fmaxf(aend + m, mloc), f1 = __expf(aend + m - mn), f2 = __expf(mloc - mn); m = mn;
                    float ua[4], uc[4]; up4_fp8(u.x, ua); up4_fp8(u.y, uc);
                    s[0] = f1 * s[0] + f2 * ua[0]; s[1] = f1 * s[1] + f2 * ua[1]; s[2] = f1 * s[2] + f2 * ua[2]; s[3] = f1 * s[3] + f2 * ua[3];
                    s[4] = f1 * s[4] + f2 * uc[0]; s[5] = f1 * s[5] + f2 * uc[1]; s[6] = f1 * s[6] + f2 * uc[2]; s[7] = f1 * s[7] + f2 * uc[3]; } }
            }
        } else {
            const int tk = task - 98304, chain = tk >> 4, part = tk & 15, bh = chain >> 1, dir = chain & 1;
            float* MN = (float*)(p.ws + WS_MN); const float* SC = (const float*)(p.ws + WS_MSC);
            f32x4 n0 = {0.f, 0.f, 0.f, 0.f}, n1 = {0.f, 0.f, 0.f, 0.f}; float m = 0.f;
            f32x4 p0[PF], p1[PF]; float ae[PF], ml[PF];
#pragma unroll
            for (int i = 0; i < PF; ++i) { const int si = (bh * NCH + tc_of(i, dir)) * 2 + dir; const float* np = MN + (size_t)si * 128 + part * 8;
                p0[i] = *(const f32x4*)np; p1[i] = *(const f32x4*)(np + 4); ae[i] = SC[si * 4 + 0]; ml[i] = SC[si * 4 + 1]; }
            for (int c0 = 0; c0 < NCH; c0 += PF) {
#pragma unroll
                for (int i = 0; i < PF; ++i) { const int c = c0 + i; if (c < NCH) { const int si = (bh * NCH + tc_of(c, dir)) * 2 + dir;
                    const f32x4 u0 = p0[i], u1 = p1[i]; const float aend = ae[i], mloc = ml[i];
                    if (c + PF < NCH) { const int sn = (bh * NCH + tc_of(c + PF, dir)) * 2 + dir; const float* nq = MN + (size_t)sn * 128 + part * 8;
                        p0[i] = *(const f32x4*)nq; p1[i] = *(const f32x4*)(nq + 4); ae[i] = SC[sn * 4 + 0]; ml[i] = SC[sn * 4 + 1]; }
                    float* np = MN + (size_t)si * 128 + part * 8;
                    *(f32x4*)np = n0; *(f32x4*)(np + 4) = n1;
                    const float mn = fmaxf(aend + m, mloc), f1 = __expf(aend + m - mn), f2 = __expf(mloc - mn); m = mn;
                    n0 = n0 * f1 + u0 * f2; n1 = n1 * f1 + u1 * f2; } }
            }
        }
    }
}

template <bool SIG>
__device__ __forceinline__ void head_norm_store(const P& p, const LAS float* O, const LAS bf16_t* GTt, const LAS float* GN, int tok0, int h, int mixcol, int tid) {
    bf16_t* MIX = (bf16_t*)(p.ws + WS_A);
    const int t = tid >> 3, seg = tid & 7;
    float o[16]; float ss = 0.f;
#pragma unroll
    for (int j = 0; j < 16; ++j) { o[j] = O[t * 132 + seg * 16 + j]; ss += o[j] * o[j]; }
    ss += __shfl_xor(ss, 1); ss += __shfl_xor(ss, 2); ss += __shfl_xor(ss, 4);
    const float rstd = __builtin_amdgcn_rsqf(ss * (1.f / 128.f) + EPS);
    const u32x4 g0 = *(const LAS u32x4*)(GTt + t * 128 + seg * 16), g1 = *(const LAS u32x4*)(GTt + t * 128 + seg * 16 + 8);
    float gt[16];
    gt[0] = bflo(g0.x); gt[1] = bfhi(g0.x); gt[2] = bflo(g0.y); gt[3] = bfhi(g0.y); gt[4] = bflo(g0.z); gt[5] = bfhi(g0.z); gt[6] = bflo(g0.w); gt[7] = bfhi(g0.w);
    gt[8] = bflo(g1.x); gt[9] = bfhi(g1.x); gt[10] = bflo(g1.y); gt[11] = bfhi(g1.y); gt[12] = bflo(g1.z); gt[13] = bfhi(g1.z); gt[14] = bflo(g1.w); gt[15] = bfhi(g1.w);
    float r[16];
#pragma unroll
    for (int j = 0; j < 16; ++j) { const float gg = SIG ? sigmf(gt[j]) : siluf(gt[j]); r[j] = o[j] * rstd * GN[seg * 16 + j] * gg; }
    u32x4 w0, w1; w0.x = pk2(r[0], r[1]); w0.y = pk2(r[2], r[3]); w0.z = pk2(r[4], r[5]); w0.w = pk2(r[6], r[7]);
    w1.x = pk2(r[8], r[9]); w1.y = pk2(r[10], r[11]); w1.z = pk2(r[12], r[13]); w1.w = pk2(r[14], r[15]);
    bf16_t* dst = MIX + (size_t)(tok0 + t) * D + mixcol + h * 128 + seg * 16;
    *(u32x4*)dst = w0; *(u32x4*)(dst + 8) = w1;
}
__device__ __forceinline__ void load_gate_tile(const P& p, int tok0, int gcol, int h, const float* gain, LAS bf16_t* GTt, LAS float* GN, int tid) {
    const bf16_t* Z = (const bf16_t*)(p.ws + WS_Z);
#pragma unroll
    for (int i = 0; i < 2; ++i) { const int idx = tid + NTHR * i, t = idx >> 4, c = idx & 15;
        *(LAS u32x4*)(GTt + t * 128 + c * 8) = *(const u32x4*)(Z + (size_t)(tok0 + t) * ZLD + gcol + h * 128 + c * 8); }
    if (tid < 32) *(LAS f32x4*)(GN + tid * 4) = *(const f32x4*)(gain + h * 128 + tid * 4);
}

struct G6Regs { u32x4 v[2]; u32x4 st[2]; u32x4 gt[2]; u32x4 q, k; f32x4 glr, gn; float upw[8]; float upb; };
struct M6Regs { u32x4 q[2], k[2], v[2]; u32x4 gt[2]; f32x4 gn; float gi, gf, nv; };
__device__ __forceinline__ void item_bhj(int it, int& b, int& h, int& j) { b = it >> 8; h = (it >> 6) & 3; j = it & 63; }

__device__ __forceinline__ void g6_load(const P& p, int it, int tid, G6Regs& R) {
    int b, h, j; item_bhj(it, b, h, j); const int tok0 = b * SEQ + j * 64, sidx = (b * 4 + h) * NCH + j;
    const bf16_t* Z = (const bf16_t*)(p.ws + WS_Z); const float* GT = (const float*)(p.ws + WS_GATES);
#pragma unroll
    for (int i = 0; i < 2; ++i) { const int idx = tid + NTHR * i, t = idx >> 4, c = idx & 15;
        R.v[i] = *(const u32x4*)(Z + (size_t)(tok0 + t) * ZLD + 512 + h * 128 + c * 8);
        R.gt[i] = *(const u32x4*)(Z + (size_t)(tok0 + t) * ZLD + 1024 + h * 128 + c * 8); }
    const unsigned char* S = (const unsigned char*)(p.ws + WS_UG) + (size_t)(sidx * 2) * 8192;
#pragma unroll
    for (int i = 0; i < 2; ++i) { const int idx = tid + NTHR * i, row = idx >> 2, c = idx & 3; R.st[i] = *(const u32x4*)(S + (size_t)row * 64 + c * 16); }
    const int t = tid >> 3, c = tid & 7;
    R.q = *(const u32x4*)(Z + (size_t)(tok0 + t) * ZLD + h * 64 + c * 8);
    R.k = *(const u32x4*)(Z + (size_t)(tok0 + t) * ZLD + 256 + h * 64 + c * 8);
    R.glr = *(const f32x4*)(GT + (size_t)(tok0 + t) * 48 + c * 4);
    R.gn = *(const f32x4*)(p.in[10] + h * 128 + (tid & 31) * 4);
    { const int w = tid >> 6, dir = w >> 2, d = (w & 1) * 32 + (tid & 31), hh = (tid >> 5) & 1;
#pragma unroll
        for (int q = 0; q < 8; ++q) R.upw[q] = p.in[8][(dir * 16 + 8 * hh + q) * 256 + h * 64 + d];
        R.upb = p.in[9][dir * 256 + h * 64 + d]; }
}
__device__ __forceinline__ void p6_gla(const P& p, LAS unsigned char* lds, int it, G6Regs& R, int itnext, unsigned long long& tacc, int qid, int& nn) {
    unsigned long long tprev = (STAGE_SEL >= 0) ? __builtin_amdgcn_s_memrealtime() : 0ull;
    const int tid = threadIdx.x, lane = tid & 63, wave = __builtin_amdgcn_readfirstlane(tid >> 6);
    int b, h, j; item_bhj(it, b, h, j);
    const int tok0 = b * SEQ + j * 64;
    LAS bf16_t* QF = (LAS bf16_t*)lds; LAS bf16_t* QB = QF + 64 * 72; LAS bf16_t* KF = QB + 64 * 72; LAS bf16_t* KB = KF + 64 * 72;
    LAS bf16_t* VT = (LAS bf16_t*)(lds + 36864); LAS bf16_t* ST = (LAS bf16_t*)(lds + 55296); LAS bf16_t* PF = (LAS bf16_t*)(lds + 92160); LAS bf16_t* PB = PF + 64 * 72;
    LAS bf16_t* GLRB = (LAS bf16_t*)(lds + 110592); LAS float* QS = (LAS float*)(lds + 118784); LAS float* O = (LAS float*)lds;
    LAS bf16_t* GTt = (LAS bf16_t*)(lds + 120832); LAS float* GN = (LAS float*)(lds + 137216); LAS bf16_t* QR = (LAS bf16_t*)(lds + 137728); LAS bf16_t* KR = (LAS bf16_t*)(lds + 146944);
#pragma unroll
    for (int i = 0; i < 2; ++i) { const int idx = tid + NTHR * i, t = idx >> 4, c = idx & 15; *(LAS u32x4*)(VT + t * 136 + c * 8) = R.v[i]; *(LAS u32x4*)(GTt + t * 128 + c * 8) = R.gt[i]; }
#pragma unroll
    for (int i = 0; i < 2; ++i) { const int idx = tid + NTHR * i, row = idx >> 2, c = idx & 3; const u32x4 w = R.st[i];
        *(LAS u32x4*)(ST + row * 72 + c * 16) = fp8x8_to_bf16((u32x2){w.x, w.y}, 1.f / SG_SCALE); *(LAS u32x4*)(ST + row * 72 + c * 16 + 8) = fp8x8_to_bf16((u32x2){w.z, w.w}, 1.f / SG_SCALE); }
    { const int t = tid >> 3, c = tid & 7; *(LAS u32x4*)(QR + t * 72 + c * 8) = R.q; *(LAS u32x4*)(KR + t * 72 + c * 8) = R.k;
        u32x2 g; g.x = pk2(R.glr.x, R.glr.y); g.y = pk2(R.glr.z, R.glr.w); *(LAS u32x2*)(GLRB + t * 40 + c * 4) = g; }
    if (tid < 32) *(LAS f32x4*)(GN + tid * 4) = R.gn;
    u32x4 upq; upq.x = pk2(R.upw[0], R.upw[1]); upq.y = pk2(R.upw[2], R.upw[3]); upq.z = pk2(R.upw[4], R.upw[5]); upq.w = pk2(R.upw[6], R.upw[7]);
    const float upb = R.upb;
    __syncthreads();
    STGF(1, 0);
    if (itnext < 1024) g6_load(p, itnext, tid, R);
    {
        const int dir = wave >> 2, tt = (wave >> 1) & 1, d = (wave & 1) * 32 + (lane & 31);
        float la[16], incl[16], all;
        gla_gates(GLRB, QS, __builtin_bit_cast(bf16x8, upq), upb, lane, wave, la, incl, all);
        STGF(1, 1);
        LAS bf16_t* Qd = dir == 0 ? QF : QB; LAS bf16_t* Kd = dir == 0 ? KF : KB;
#pragma unroll
        for (int i = 0; i < 16; ++i) { const int t = tt * 32 + 8 * (i >> 2) + 4 * (lane >> 5) + (i & 3);
            const float qx = bf2f(QR[t * 72 + d]) * 0.125f, kx = bf2f(KR[t * 72 + d]);
            const float bb = dir == 0 ? incl[i] : all - (incl[i] - la[i]);
            const float eb = __expf(bb);
            Qd[t * 72 + d] = (bf16_t)f2bf(qx * eb); Kd[t * 72 + d] = (bf16_t)f2bf(kx * rcpf(eb)); }
    }
    __syncthreads();
    STGF(1, 2);
    {
        const int dw = wave >> 2, tt = (wave >> 1) & 1, st = wave & 1;
        const LAS bf16_t* Qd = dw == 0 ? QF : QB; const LAS bf16_t* Kd = dw == 0 ? KF : KB; LAS bf16_t* Pd = dw == 0 ? PF : PB;
        f32x16 acc;
#pragma unroll
        for (int r = 0; r < 16; ++r) acc[r] = 0.f;
#pragma unroll
        for (int ks = 0; ks < 4; ++ks) acc = MFMA32(ldfrag(Kd, 72, st * 32, ks * 16, lane), ldfrag(Qd, 72, tt * 32, ks * 16, lane), acc);
        const int t = tt * 32 + (lane & 31);
#pragma unroll
        for (int rg = 0; rg < 4; ++rg) { const int sb = st * 32 + 8 * rg + 4 * (lane >> 5); float v[4];
#pragma unroll
            for (int x = 0; x < 4; ++x) { const int s1 = sb + x; const bool ok = dw == 0 ? (s1 <= t) : (s1 >= t); v[x] = ok ? acc[4 * rg + x] : 0.f; }
            u32x2 w; w.x = pk2(v[0], v[1]); w.y = pk2(v[2], v[3]); *(LAS u32x2*)(Pd + t * 72 + sb) = w; }
    }
    __syncthreads();
    STGF(1, 3);
    const int tt = wave >> 2, vt = wave & 3;
    f32x16 acc;
#pragma unroll
    for (int r = 0; r < 16; ++r) acc[r] = 0.f;
#pragma unroll
    for (int ks = 0; ks < 4; ++ks) { const bf16x8 va = ldfrag_t(VT, 136, ks * 16, vt * 32, lane);
        acc = MFMA32(va, ldfrag(PF, 72, tt * 32, ks * 16, lane), acc); acc = MFMA32(va, ldfrag(PB, 72, tt * 32, ks * 16, lane), acc); }
#pragma unroll
    for (int ks = 0; ks < 4; ++ks) { acc = MFMA32(ldfrag(ST, 72, vt * 32, ks * 16, lane), ldfrag(QF, 72, tt * 32, ks * 16, lane), acc);
        acc = MFMA32(ldfrag(ST + 128 * 72, 72, vt * 32, ks * 16, lane), ldfrag(QB, 72, tt * 32, ks * 16, lane), acc); }
    __syncthreads();
    STGF(1, 4);
    { LAS float* orow = O + (tt * 32 + (lane & 31)) * 132 + vt * 32 + 4 * (lane >> 5);
#pragma unroll
        for (int rg = 0; rg < 4; ++rg) *(LAS f32x4*)(orow + 8 * rg) = (f32x4){acc[4 * rg], acc[4 * rg + 1], acc[4 * rg + 2], acc[4 * rg + 3]}; }
    __syncthreads();
    STGF(1, 5);
    head_norm_store<false>(p, O, GTt, GN, tok0, h, 0, tid);
    if (threadIdx.x == 0) *(LAS int*)(lds + LDS_NQ) = qid;
    __syncthreads();
    nn = *(const LAS int*)(lds + LDS_NQ);
    STGF(1, 6);
}

__device__ __forceinline__ void m6_load(const P& p, int it, int tid, M6Regs& R) {
    int b, h, j; item_bhj(it, b, h, j); const int tok0 = b * SEQ + j * 64, sidx = (b * 4 + h) * NCH + j;
    const bf16_t* Z = (const bf16_t*)(p.ws + WS_Z); const bf16_t* MQ = (const bf16_t*)(p.ws + WS_MQ); const bf16_t* MK = (const bf16_t*)(p.ws + WS_MK);
#pragma unroll
    for (int i = 0; i < 2; ++i) { const int idx = tid + NTHR * i, t = idx >> 4, c = idx & 15;
        R.q[i] = *(const u32x4*)(MQ + (size_t)(tok0 + t) * 512 + h * 128 + c * 8);
        R.k[i] = *(const u32x4*)(MK + (size_t)(tok0 + t) * 512 + h * 128 + c * 8);
        R.v[i] = *(const u32x4*)(Z + (size_t)(tok0 + t) * ZLD + 2560 + h * 128 + c * 8);
        R.gt[i] = *(const u32x4*)(Z + (size_t)(tok0 + t) * ZLD + 3072 + h * 128 + c * 8); }
    R.gn = *(const f32x4*)(p.in[15] + h * 128 + (tid & 31) * 4);
    R.gi = 0.f; R.gf = 0.f; R.nv = 0.f;
    if (tid < 128) { const int dir = tid >> 6, t = tid & 63; const float* g = (const float*)(p.ws + WS_GATES) + (size_t)(tok0 + t) * 48; R.gi = g[32 + dir * 4 + h] + p.in[13][dir * 4 + h]; R.gf = g[40 + dir * 4 + h] + p.in[14][dir * 4 + h]; }
    else if (tid < 384) R.nv = ((const float*)(p.ws + WS_MN))[(size_t)(sidx * 2) * 128 + (tid - 128)];
    else if (tid < 386) R.nv = ((const float*)(p.ws + WS_MSC))[(size_t)(sidx * 2 + (tid - 384)) * 4 + 2];
}
__device__ __forceinline__ void p6_ml(const P& p, LAS unsigned char* lds, int it, M6Regs& R, int itnext, unsigned long long& tacc, int qid, int& nn) {
    unsigned long long tprev = (STAGE_SEL >= 0) ? __builtin_amdgcn_s_memrealtime() : 0ull;
    const int tid = threadIdx.x, lane = tid & 63, wave = __builtin_amdgcn_readfirstlane(tid >> 6);
    int b, h, j; item_bhj(it, b, h, j);
    const int tok0 = b * SEQ + j * 64;
    LAS bf16_t* Q = (LAS bf16_t*)lds; LAS bf16_t* K = (LAS bf16_t*)(lds + 17408); LAS bf16_t* VT = (LAS bf16_t*)(lds + 34816); LAS bf16_t* ST = (LAS bf16_t*)(lds + 53248);
    LAS bf16_t* PF = (LAS bf16_t*)(lds + 122880); LAS bf16_t* PB = PF + 64 * 72; LAS float* SM = (LAS float*)(lds + 141312); LAS float* O = (LAS float*)lds;
    LAS float* IG = SM; LAS float* LF = SM + 128; LAS float* CT = SM + 256; LAS float* RT = SM + 384; LAS float* WT = SM + 512; LAS float* ET = SM + 640;
    LAS float* NV = SM + 768;
    LAS float* INV = SM + 1024;
    LAS float* MS = SM + 1152;
    LAS bf16_t* GTt = (LAS bf16_t*)(lds + 146432); LAS float* GN = (LAS float*)(lds + 162816);
#pragma unroll
    for (int i = 0; i < 2; ++i) { const int idx = tid + NTHR * i, t = idx >> 4, c = idx & 15;
        *(LAS u32x4*)(Q + t * 136 + c * 8) = R.q[i]; *(LAS u32x4*)(K + t * 136 + c * 8) = R.k[i]; *(LAS u32x4*)(VT + t * 136 + c * 8) = R.v[i]; *(LAS u32x4*)(GTt + t * 128 + c * 8) = R.gt[i]; }
    if (tid < 32) *(LAS f32x4*)(GN + tid * 4) = R.gn;
    if (tid < 128) { const int dir = tid >> 6, t = tid & 63; IG[dir * 64 + t] = R.gi; LF[dir * 64 + t] = logsigf(R.gf); }
    else if (tid < 384) NV[tid - 128] = R.nv;
    else if (tid < 386) MS[tid - 384] = R.nv;
    u32x4 stc[4];
    { const unsigned char* S = (const unsigned char*)(p.ws + WS_UM) + (size_t)(((b * 4 + h) * NCH + j) * 2) * 16384;
#pragma unroll
        for (int i = 0; i < 4; ++i) { const int idx = tid + NTHR * i, row = idx >> 3, c = idx & 7; stc[i] = *(const u32x4*)(S + (size_t)row * 128 + c * 16); } }
    __syncthreads();
    STGF(0, 0);
    if (itnext < 1024) m6_load(p, itnext, tid, R);
    if (tid < 64) {
        const int t = tid; const float ms = MS[0], a = scan_sum_up(LF[t], t), c = IG[t] - a, pm = scan_max_up(c, t), mt = a + fmaxf(ms, pm);
        CT[t] = c; RT[t] = a - mt; WT[t] = __expf(a + ms - mt); ET[t] = __expf(-mt);
    } else if (tid < 128) {
        const int t = tid - 64; const float ms = MS[1], a = scan_sum_down(LF[64 + t], t), c = IG[64 + t] - a, pm = scan_max_down(c, t), mt = a + fmaxf(ms, pm);
        CT[64 + t] = c; RT[64 + t] = a - mt; WT[64 + t] = __expf(a + ms - mt); ET[64 + t] = __expf(-mt);
    }
    __syncthreads();
    STGF(0, 1);
    {
        const int dw = wave >> 2, tt = (wave >> 1) & 1, st = wave & 1; LAS bf16_t* Pd = dw == 0 ? PF : PB;
        f32x16 acc;
#pragma unroll
        for (int r = 0; r < 16; ++r) acc[r] = 0.f;
#pragma unroll
        for (int ks = 0; ks < 8; ++ks) acc = MFMA32(ldfrag(K, 136, st * 32, ks * 16, lane), ldfrag(Q, 136, tt * 32, ks * 16, lane), acc);
        const int t = tt * 32 + (lane & 31); const float rt = RT[dw * 64 + t];
#pragma unroll
        for (int rg = 0; rg < 4; ++rg) { const int sb = st * 32 + 8 * rg + 4 * (lane >> 5); const f32x4 cs = *(const LAS f32x4*)(CT + dw * 64 + sb); float v[4];
#pragma unroll
            for (int x = 0; x < 4; ++x) { const int s1 = sb + x; const bool ok = dw == 0 ? (s1 <= t) : (s1 >= t);
                const float wgt = __expf(fminf(rt + cs[x], 0.f)); v[x] = ok ? acc[4 * rg + x] * wgt : 0.f; }
            u32x2 w; w.x = pk2(v[0], v[1]); w.y = pk2(v[2], v[3]); *(LAS u32x2*)(Pd + t * 72 + sb) = w; }
    }
#pragma unroll
    for (int i = 0; i < 4; ++i) { const int idx = tid + NTHR * i, row = idx >> 3, c = idx & 7; const u32x4 w = stc[i];
        *(LAS u32x4*)(ST + row * 136 + c * 16) = fp8x8_to_bf16((u32x2){w.x, w.y}, 1.f / SM_SCALE); *(LAS u32x4*)(ST + row * 136 + c * 16 + 8) = fp8x8_to_bf16((u32x2){w.z, w.w}, 1.f / SM_SCALE); }
    __syncthreads();
    STGF(0, 2);
    {
        const int t = tid >> 3, seg = tid & 7;
        float rs0 = 0.f, rs1 = 0.f, qn0 = 0.f, qn1 = 0.f;
        { const u32x4 a = *(const LAS u32x4*)(PF + t * 72 + seg * 8), bq = *(const LAS u32x4*)(PB + t * 72 + seg * 8);
            rs0 = (bflo(a.x) + bfhi(a.x)) + (bflo(a.y) + bfhi(a.y)) + (bflo(a.z) + bfhi(a.z)) + (bflo(a.w) + bfhi(a.w));
            rs1 = (bflo(bq.x) + bfhi(bq.x)) + (bflo(bq.y) + bfhi(bq.y)) + (bflo(bq.z) + bfhi(bq.z)) + (bflo(bq.w) + bfhi(bq.w)); }
#pragma unroll
        for (int c = 0; c < 2; ++c) { const u32x4 qv = *(const LAS u32x4*)(Q + t * 136 + seg * 16 + c * 8);
            const f32x4 n0 = *(const LAS f32x4*)(NV + seg * 16 + c * 8), n1 = *(const LAS f32x4*)(NV + seg * 16 + c * 8 + 4), m0 = *(const LAS f32x4*)(NV + 128 + seg * 16 + c * 8), m1 = *(const LAS f32x4*)(NV + 128 + seg * 16 + c * 8 + 4);
            const float q0 = bflo(qv.x), q1 = bfhi(qv.x), q2 = bflo(qv.y), q3 = bfhi(qv.y), q4 = bflo(qv.z), q5 = bfhi(qv.z), q6 = bflo(qv.w), q7 = bfhi(qv.w);
            qn0 += q0 * n0.x + q1 * n0.y + q2 * n0.z + q3 * n0.w + q4 * n1.x + q5 * n1.y + q6 * n1.z + q7 * n1.w;
            qn1 += q0 * m0.x + q1 * m0.y + q2 * m0.z + q3 * m0.w + q4 * m1.x + q5 * m1.y + q6 * m1.z + q7 * m1.w; }
#pragma unroll
        for (int o = 1; o < 8; o <<= 1) { rs0 += __shfl_xor(rs0, o); rs1 += __shfl_xor(rs1, o); qn0 += __shfl_xor(qn0, o); qn1 += __shfl_xor(qn1, o); }
        if (seg == 0) { const float d0 = rs0 + WT[t] * qn0, d1 = rs1 + WT[64 + t] * qn1;
            INV[t] = rcpf(fmaxf(fabsf(d0), ET[t])); INV[64 + t] = rcpf(fmaxf(fabsf(d1), ET[64 + t])); }
    }
    const int tt = wave >> 2, vt = wave & 3;
    f32x16 af_, ab_;
#pragma unroll
    for (int r = 0; r < 16; ++r) { af_[r] = 0.f; ab_[r] = 0.f; }
#pragma unroll
    for (int ks = 0; ks < 4; ++ks) { const bf16x8 va = ldfrag_t(VT, 136, ks * 16, vt * 32, lane);
        af_ = MFMA32(va, ldfrag(PF, 72, tt * 32, ks * 16, lane), af_); ab_ = MFMA32(va, ldfrag(PB, 72, tt * 32, ks * 16, lane), ab_); }
    const int tl = tt * 32 + (lane & 31);
    { const float wf = WT[tl], wb = WT[64 + tl];
#pragma unroll
        for (int ks = 0; ks < 8; ++ks) { const u32x4 qa = __builtin_bit_cast(u32x4, ldfrag(Q, 136, tt * 32, ks * 16, lane));
            u32x4 qf, qb;
            qf.x = pk2(bflo(qa.x) * wf, bfhi(qa.x) * wf); qf.y = pk2(bflo(qa.y) * wf, bfhi(qa.y) * wf); qf.z = pk2(bflo(qa.z) * wf, bfhi(qa.z) * wf); qf.w = pk2(bflo(qa.w) * wf, bfhi(qa.w) * wf);
            qb.x = pk2(bflo(qa.x) * wb, bfhi(qa.x) * wb); qb.y = pk2(bflo(qa.y) * wb, bfhi(qa.y) * wb); qb.z = pk2(bflo(qa.z) * wb, bfhi(qa.z) * wb); qb.w = pk2(bflo(qa.w) * wb, bfhi(qa.w) * wb);
            af_ = MFMA32(ldfrag(ST, 136, vt * 32, ks * 16, lane), __builtin_bit_cast(bf16x8, qf), af_);
            ab_ = MFMA32(ldfrag(ST + 128 * 136, 136, vt * 32, ks * 16, lane), __builtin_bit_cast(bf16x8, qb), ab_); } }
    __syncthreads();
    STGF(0, 3);
    { const float i0 = INV[tl], i1 = INV[64 + tl]; LAS float* orow = O + tl * 132 + vt * 32 + 4 * (lane >> 5);
#pragma unroll
        for (int rg = 0; rg < 4; ++rg) *(LAS f32x4*)(orow + 8 * rg) = (f32x4){i0 * af_[4 * rg] + i1 * ab_[4 * rg], i0 * af_[4 * rg + 1] + i1 * ab_[4 * rg + 1], i0 * af_[4 * rg + 2] + i1 * ab_[4 * rg + 2], i0 * af_[4 * rg + 3] + i1 * ab_[4 * rg + 3]}; }
    __syncthreads();
    STGF(0, 4);
    head_norm_store<true>(p, O, GTt, GN, tok0, h, 512, tid);
    if (threadIdx.x == 0) *(LAS int*)(lds + LDS_NQ) = qid;
    __syncthreads();
    nn = *(const LAS int*)(lds + LDS_NQ);
    STGF(0, 5);
}

__device__ __forceinline__ void phase6(const P& p, LAS unsigned char* lds) {
    const int tid = threadIdx.x;
#ifndef P6_SKIP_GLA
    DYN_LOOP(G6Regs, g6_load, p6_gla, 1024, 2, 1);
#endif
#ifndef P6_SKIP_ML
    DYN_LOOP(M6Regs, m6_load, p6_ml, 1024, 3, 0);
#endif
}

__device__ __forceinline__ void phase8(const P& p, LAS unsigned char* lds) {
    const int tid = threadIdx.x, lane = tid & 63, wave = tid >> 6;
    LAS bf16_t* RWB = (LAS bf16_t*)lds; LAS float* AB = (LAS float*)(lds + 99072); LAS float* LG = (LAS float*)(lds + 131840) + wave * 768;
    const float* mod = (const float*)(p.ws + WS_MOD);
    for (int k = tid; k < 1024; k += NTHR) {
        const f32x4 g = *(const f32x4*)(p.in[18] + k * 4);
        RWB[0 * 1032 + k] = (bf16_t)f2bf(g.x); RWB[1 * 1032 + k] = (bf16_t)f2bf(g.y); RWB[2 * 1032 + k] = (bf16_t)f2bf(g.z); RWB[3 * 1032 + k] = (bf16_t)f2bf(g.w);
#pragma unroll
        for (int q = 0; q < 8; ++q) { const f32x4 e = *(const f32x4*)(p.in[20] + k * 32 + q * 4);
            RWB[(4 + q * 4 + 0) * 1032 + k] = (bf16_t)f2bf(e.x); RWB[(4 + q * 4 + 1) * 1032 + k] = (bf16_t)f2bf(e.y); RWB[(4 + q * 4 + 2) * 1032 + k] = (bf16_t)f2bf(e.z); RWB[(4 + q * 4 + 3) * 1032 + k] = (bf16_t)f2bf(e.w); }
#pragma unroll
        for (int r = 36; r < 48; ++r) RWB[r * 1032 + k] = (bf16_t)0;
    }
    for (int i = tid; i < 4096; i += NTHR) { const int b = i >> 10, k = i & 1023;
        AB[(b * 2 + 0) * 1024 + k] = p.in[17][k] * (1.f + mod[b * 6144 + 4096 + k]); AB[(b * 2 + 1) * 1024 + k] = mod[b * 6144 + 3072 + k]; }
    __syncthreads();
    bf16_t* H2 = (bf16_t*)(p.ws + WS_MQ);
    int* RT = (int*)(p.ws + WS_ROUTE); unsigned* CNT = (unsigned*)(p.ws + WS_CTL) + CW_CNT;
    const float* PSS = (const float*)(p.ws + WS_PSS);
    LAS float* LGA = (LAS float*)(lds + 131840);
    LAS int* LC = (LAS int*)(lds + 156416); LAS int* LB = LC + 32;
    const int r16 = lane & 15, kq = lane >> 4, gsub = wave & 3, kh = wave >> 2;
    for (int blk = blockIdx.x; blk < MX / 64; blk += gridDim.x) {
        const int grp = blk * 4 + gsub, row = grp * 16 + r16, b = grp >> 8;
        const f32x4 pq = *(const f32x4*)(PSS + (size_t)row * 16 + kq * 4);
        float ss = pq.x + pq.y + pq.z + pq.w;
        ss += __shfl_xor(ss, 16); ss += __shfl_xor(ss, 32);
        const float rstd = 1.f / sqrtf(ss * (1.f / D) + EPS);
        const bf16_t* src = (const bf16_t*)(p.ws + WS_X1) + (size_t)row * D + kh * 512 + kq * 8;
        const LAS float* al = AB + (b * 2) * 1024 + kh * 512 + kq * 8; const LAS float* be = al + 1024;
        bf16_t* hdst = H2 + (size_t)row * D + kh * 512 + kq * 8;
        f32x4 acc[3];
#pragma unroll
        for (int nt = 0; nt < 3; ++nt) acc[nt] = (f32x4){0.f, 0.f, 0.f, 0.f};
#pragma unroll 8
        for (int ks = 0; ks < 16; ++ks) {
            const u32x4 xr = *(const u32x4*)(src + ks * 32);
            const f32x4 x0 = {bflo(xr.x), bfhi(xr.x), bflo(xr.y), bfhi(xr.y)}, x1 = {bflo(xr.z), bfhi(xr.z), bflo(xr.w), bfhi(xr.w)};
            const f32x4 a0 = *(const LAS f32x4*)(al + ks * 32), a1 = *(const LAS f32x4*)(al + ks * 32 + 4), b0 = *(const LAS f32x4*)(be + ks * 32), b1 = *(const LAS f32x4*)(be + ks * 32 + 4);
            const f32x4 h0 = x0 * rstd * a0 + b0, h1 = x1 * rstd * a1 + b1;
            u32x4 hw; hw.x = pk2(h0.x, h0.y); hw.y = pk2(h0.z, h0.w); hw.z = pk2(h1.x, h1.y); hw.w = pk2(h1.z, h1.w);
            *(u32x4*)(hdst + ks * 32) = hw;
            const bf16x8 af = __builtin_bit_cast(bf16x8, hw);
#pragma unroll
            for (int nt = 0; nt < 3; ++nt) { const bf16x8 bfr = *(const LAS bf16x8*)(RWB + (nt * 16 + r16) * 1032 + kh * 512 + ks * 32 + kq * 8);
                acc[nt] = __builtin_amdgcn_mfma_f32_16x16x32_bf16(af, bfr, acc[nt], 0, 0, 0); }
        }
        LAS float* LG = LGA + (kh * 4 + gsub) * 768;
#pragma unroll
        for (int nt = 0; nt < 3; ++nt)
#pragma unroll
            for (int r = 0; r < 4; ++r) LG[(kq * 4 + r) * 48 + nt * 16 + r16] = acc[nt][r];
        if (tid < 32) LC[tid] = 0;
        __syncthreads();
        int ea = 0, eb = 0, la = 0, lb = 0; float w0 = 0.f, w1 = 0.f;
        const bool sel = wave < 4 && lane < 16;
        if (sel) {
            const LAS float* lg0 = LGA + gsub * 768 + lane * 48; const LAS float* lg1 = lg0 + 4 * 768;
            float gl[4];
#pragma unroll
            for (int q = 0; q < 4; ++q) gl[q] = lg0[q] + lg1[q] + p.in[19][q];
            int gi = 0; float gm = gl[0];
#pragma unroll
            for (int q = 1; q < 4; ++q) if (gl[q] > gm) { gm = gl[q]; gi = q; }
            float den = 0.f;
#pragma unroll
            for (int q = 0; q < 4; ++q) den += __expf(gl[q] - gm);
            const float gwt = 1.f / den;
            float el[8];
#pragma unroll
            for (int q = 0; q < 8; ++q) el[q] = lg0[4 + gi * 8 + q] + lg1[4 + gi * 8 + q] + p.in[21][gi * 8 + q];
            int i0 = 0; float v0 = el[0];
#pragma unroll
            for (int q = 1; q < 8; ++q) if (el[q] > v0) { v0 = el[q]; i0 = q; }
            int i1 = -1; float v1 = -3.0e38f;
#pragma unroll
            for (int q = 0; q < 8; ++q) if (q != i0 && el[q] > v1) { v1 = el[q]; i1 = q; }
            const float e1 = __expf(v1 - v0); w0 = gwt / (1.f + e1); w1 = gwt * e1 / (1.f + e1);
            ea = gi * 8 + i0; eb = gi * 8 + i1;
            la = __hip_atomic_fetch_add(&LC[ea], 1, __ATOMIC_RELAXED, __HIP_MEMORY_SCOPE_WORKGROUP); lb = __hip_atomic_fetch_add(&LC[eb], 1, __ATOMIC_RELAXED, __HIP_MEMORY_SCOPE_WORKGROUP);
        }
        __syncthreads();
        if (tid < 32) { const int c = LC[tid]; LB[tid] = c > 0 ? (int)atomicAdd(&CNT[tid * 64], (unsigned)c) : 0; }
        __syncthreads();
        if (sel) { const int trow = grp * 16 + lane, ra = LB[ea] + la, rb = LB[eb] + lb; int* r = RT + (size_t)trow * 8; r[0] = ea; r[1] = eb; r[2] = ra; r[3] = rb; ((float*)r)[4] = w0; ((float*)r)[5] = w1;
            int* TOK = (int*)(p.ws + WS_TOK); TOK[ea * 16384 + ra] = trow; TOK[eb * 16384 + rb] = trow; }
        __syncthreads();
    }
}

__device__ __forceinline__ int build_tables(const P& p, LAS int* PST, LAS int* TEX) {
    const unsigned* CNT = (const unsigned*)(p.ws + WS_CTL) + CW_CNT;
    if (threadIdx.x < 32) PST[40 + threadIdx.x] = (int)__hip_atomic_load(&CNT[threadIdx.x * 64], __ATOMIC_RELAXED, __HIP_MEMORY_SCOPE_AGENT);
    __syncthreads();
    if (threadIdx.x == 0) { int acc = 0;
        for (int e = 0; e < 32; ++e) { PST[e] = acc; const int nt = (PST[40 + e] + 255) >> 8;
            for (int t = 0; t < nt; ++t) TEX[(acc >> 8) + t] = e;
            acc += nt << 8; }
        PST[32] = acc; }
    __syncthreads();
    return PST[32] >> 8;
}

__device__ __forceinline__ void phase12(const P& p, LAS unsigned char* lds, float* dstbase) {
    const int tid = threadIdx.x, lane = tid & 63, wave = tid >> 6;
    LAS int* PST = (LAS int*)lds; (void)build_tables(p, PST, PST + 128);
    const float* mod = (const float*)(p.ws + WS_MOD); const bf16_t* Y = (const bf16_t*)(p.ws + WS_Z); const int* RT = (const int*)(p.ws + WS_ROUTE);
    const int gw = blockIdx.x * 8 + wave, NGW = gridDim.x * 8;
    for (int r0 = gw * 2; r0 < MX; r0 += NGW * 2) {
        int s0[2], s1[2]; float w0[2], w1[2];
#pragma unroll
        for (int q = 0; q < 2; ++q) { const int* r = RT + (size_t)(r0 + q) * 8; s0[q] = PST[r[0]] + r[2]; s1[q] = PST[r[1]] + r[3]; w0[q] = ((const float*)r)[4]; w1[q] = ((const float*)r)[5]; }
        f32x4 x1[2][4]; u32x2 ya[2][4], yb[2][4];
#pragma unroll
        for (int q = 0; q < 2; ++q)
#pragma unroll
            for (int j = 0; j < 4; ++j) { const int k = 4 * lane + 256 * j;
                { const u32x2 xr = *(const u32x2*)((const bf16_t*)(p.ws + WS_X1) + (size_t)(r0 + q) * D + k); x1[q][j] = (f32x4){bflo(xr.x), bfhi(xr.x), bflo(xr.y), bfhi(xr.y)}; }
                ya[q][j] = *(const u32x2*)(Y + (size_t)s0[q] * D + k); yb[q][j] = *(const u32x2*)(Y + (size_t)s1[q] * D + k); }
#pragma unroll
        for (int q = 0; q < 2; ++q) { const int row = r0 + q; const float* g2 = mod + (size_t)(row >> 12) * 6144 + 5120;
            f32x4 v[4]; float ss = 0.f;
#pragma unroll
            for (int j = 0; j < 4; ++j) { const int k = 4 * lane + 256 * j; const f32x4 g = *(const f32x4*)(g2 + k);
                f32x4 m; m.x = w0[q] * bflo(ya[q][j].x) + w1[q] * bflo(yb[q][j].x); m.y = w0[q] * bfhi(ya[q][j].x) + w1[q] * bfhi(yb[q][j].x);
                m.z = w0[q] * bflo(ya[q][j].y) + w1[q] * bflo(yb[q][j].y); m.w = w0[q] * bfhi(ya[q][j].y) + w1[q] * bfhi(yb[q][j].y);
                v[j] = x1[q][j] + g * m; ss += v[j].x * v[j].x + v[j].y * v[j].y + v[j].z * v[j].z + v[j].w * v[j].w; }
            const float rstd = 1.f / sqrtf(wave_sum(ss) * (1.f / D) + EPS);
#pragma unroll
            for (int j = 0; j < 4; ++j) { const int k = 4 * lane + 256 * j; const f32x4 g = *(const f32x4*)(p.in[24] + k); *(f32x4*)(dstbase + (size_t)row * D + k) = v[j] * rstd * g; } }
    }
}

constexpr int NPH = 13;
__global__ void __launch_bounds__(NTHR, 2) mega(P p) {
    extern __shared__ __attribute__((aligned(16))) unsigned char lds_raw[];
    LAS unsigned char* lds = (LAS unsigned char*)lds_raw;
    volatile LAS unsigned* xst = (volatile LAS unsigned*)(lds + LDS_XB);
    if (threadIdx.x < 2) xst[threadIdx.x] = 0u;
    __syncthreads();
    XcdBarrier xb = xcd_barrier_post((unsigned*)(p.ws + WS_CTL) + CW_BAR, xst);
    const int lo = p.ph_lo, hi = p.ph_hi;
    const int G = gridDim.x, bx = blockIdx.x;
    const int vcu = (G % 8 == 0) ? (bx % 8) * (G / 8) + bx / 8 : bx;
#ifndef PHASE_MASK
#define PHASE_MASK 0x1fff
#endif
#define IN(k) (((PHASE_MASK >> (k)) & 1) && lo <= (k) && (k) < hi)
#define SEAM(k) do { if ((k) + 1 < hi) xcd_barrier(xb); } while (0)
#define REPN(k) (1 + ((REP_MASK >> (k)) & 1))
    if (IN(0)) { _Pragma("nounroll") for (int rep = 0; rep < REPN(0); ++rep) { if (rep) xcd_barrier(xb); phase0(p, lds); } for (int q = 0; q < EXTRA_SYNCS; ++q) xcd_barrier(xb); if (!(FUSE01 && N_LAUNCH_MODE == 1)) SEAM(0); }
    if (IN(1)) { _Pragma("nounroll") for (int rep = 0; rep < REPN(1); ++rep) { if (rep) xcd_barrier(xb); phase1(p); } SEAM(1); }
    if (IN(2)) {
        pg8::SchedDense S; S.nM = MT / 256; S.nN = NPADW / 256; S.nwg = S.nM * S.nN; S.G = G; S.c = bx; S.K = 1024; S.A = (const char*)(p.ws + WS_A); S.Bt = (const char*)(p.ws + WS_WINT);
        EpiZ E; E.Z = (bf16_t*)(p.ws + WS_Z); E.G = (float*)(p.ws + WS_GATES);
        _Pragma("nounroll") for (int rep = 0; rep < REPN(2); ++rep) { if (rep) xcd_barrier(xb); pg8::gemm_phase(lds, 1024, S, E); } SEAM(2); }
    if (IN(3)) { _Pragma("nounroll") for (int rep = 0; rep < REPN(3); ++rep) { if (rep) xcd_barrier(xb); phase3(p, lds); } SEAM(3); }
    if (IN(4)) { _Pragma("nounroll") for (int rep = 0; rep < REPN(4); ++rep) { if (rep) xcd_barrier(xb); phase4(p, lds); } SEAM(4); }
    if (IN(5)) { _Pragma("nounroll") for (int rep = 0; rep < REPN(5); ++rep) { if (rep) { xcd_barrier(xb); phase4(p, lds); xcd_barrier(xb); } phase5(p); } SEAM(5); }
    if (IN(6)) { _Pragma("nounroll") for (int rep = 0; rep < REPN(6); ++rep) { if (rep) xcd_barrier(xb); phase6(p, lds); } SEAM(6); }
    if (IN(7)) {
        pg8::SchedDense S; S.nM = MX / 256; S.nN = 4; S.nwg = S.nM * S.nN; S.G = G; S.c = bx; S.K = 1024; S.A = (const char*)(p.ws + WS_A); S.Bt = (const char*)(p.ws + WS_WOUTT);
        EpiX1 E; E.x = p.in[0]; E.mod = (const float*)(p.ws + WS_MOD); E.x1 = (bf16_t*)(p.ws + WS_X1); E.pss = (float*)(p.ws + WS_PSS);
        _Pragma("nounroll") for (int rep = 0; rep < REPN(7); ++rep) { if (rep) xcd_barrier(xb); pg8::gemm_phase(lds, 1024, S, E); } SEAM(7); }
    if (IN(8)) { _Pragma("nounroll") for (int rep = 0; rep < REPN(8); ++rep) { if (rep) { xcd_barrier(xb); if (bx == 0 && threadIdx.x < 32) ((unsigned*)(p.ws + WS_CTL))[CW_CNT + threadIdx.x * 64] = 0u; xcd_barrier(xb); } phase8(p, lds); } if (10 < hi) xcd_barrier(xb); }
    if (IN(10)) {
        LAS int* PST = (LAS int*)(lds + pg8::STAGE_BYTES); LAS int* TEX = PST + 128;
        const int ntiles = build_tables(p, PST, TEX);
        pg8::SchedMoE S; S.ntiles = ntiles; S.G = G; S.c = vcu; S.K = 1024; S.tex = TEX; S.pst = PST; S.cnt = PST + 40; S.tok = (const int*)(p.ws + WS_TOK); S.gather = true;
        S.A = (const char*)(p.ws + WS_MQ); S.Bt = (const char*)(p.ws + WS_E1T); S.bstride = (size_t)1024 * 1024 * 2;
        EpiH E; E.H = (bf16_t*)(p.ws + WS_UM);
        unsigned long long tacc = 0ull, tprev = (STAGE_SEL >= 0) ? __builtin_amdgcn_s_memrealtime() : 0ull;
        _Pragma("nounroll") for (int rep = 0; rep < REPN(10); ++rep) { if (rep) xcd_barrier(xb); pg8::gemm_phase<EpiH, pg8::SchedMoE, true>(lds, 1024, S, E); }
        STGF(4, 0);
        {
            const int rem = (ntiles * 4) % G, nslack = rem ? G - rem : G, sidx = rem ? vcu - rem : vcu;
            if (sidx >= 0) { const int wave = threadIdx.x >> 6, lane = threadIdx.x & 63; LAS float* scr = (LAS float*)(lds + wave * 16384); bf16_t* E2T = (bf16_t*)(p.ws + WS_E2T);
                for (int r = sidx * 8 + wave; r < 32 * 8 * 32; r += nslack * 8) { const int e = r >> 8, q = r & 255;
                    transpose_item(p.in[23] + (size_t)e * 512 * 1024, 512, 1024, E2T + (size_t)e * 1024 * 512, scr, q >> 5, q & 31, lane, RmId()); } } }
        STGF(4, 1);
        STG_SPIN(4);
        SEAM(10); }
    if (IN(11)) {
        LAS int* PST = (LAS int*)(lds + pg8::STAGE_BYTES); LAS int* TEX = PST + 128;
        const int ntiles = build_tables(p, PST, TEX);
        pg8::SchedMoE S; S.ntiles = ntiles; S.G = G; S.c = vcu; S.K = 512; S.tex = TEX; S.pst = PST; S.cnt = PST + 40; S.tok = nullptr; S.gather = false; S.A = (const char*)(p.ws + WS_UM); S.Bt = (const char*)(p.ws + WS_E2T); S.bstride = (size_t)1024 * 512 * 2;
        EpiY E; E.Y = (bf16_t*)(p.ws + WS_Z);
        _Pragma("nounroll") for (int rep = 0; rep < REPN(11); ++rep) { if (rep) xcd_barrier(xb); pg8::gemm_phase(lds, 512, S, E); } SEAM(11); }
    if (IN(12)) { for (int rep = 1; rep < REPN(12); ++rep) { phase12(p, lds, (float*)(p.ws + WS_MQ)); xcd_barrier(xb); } phase12(p, lds, p.out); }
#undef IN
#undef SEAM
}

extern "C" void kernel_launch(void* const* d_in, const int* in_sizes, int n_in, void* d_out, int out_size, void* d_ws, size_t ws_size, hipStream_t stream) {
    static int grid = 0;
    if (grid == 0) {
        if (n_in != 25 || out_size != MX * D || ws_size < WS_END) { fprintf(stderr, "kernel_launch: unexpected problem (n_in %d out %d ws %zu)\n", n_in, out_size, ws_size); grid = -1; return; }
        int dev = 0, cus = 0, per_cu = 0;
        hipGetDevice(&dev); hipDeviceGetAttribute(&cus, hipDeviceAttributeMultiprocessorCount, dev);
        if (hipFuncSetAttribute((const void*)mega, hipFuncAttributeMaxDynamicSharedMemorySize, LDS_BYTES) != hipSuccess) { fprintf(stderr, "kernel_launch: hipFuncSetAttribute failed\n"); grid = -1; return; }
        if (hipOccupancyMaxActiveBlocksPerMultiprocessor(&per_cu, (const void*)mega, NTHR, LDS_BYTES) != hipSuccess || per_cu < 1) { fprintf(stderr, "kernel_launch: occupancy query says %d\n", per_cu); per_cu = 1; }
        (void)hipGetLastError();
        grid = cus & ~7;
    }
    if (grid < 0) return;
    P a{};
    for (int i = 0; i < 25; ++i) a.in[i] = (const float*)d_in[i];
    a.out = (float*)d_out; a.ws = (unsigned char*)d_ws;
#if N_LAUNCH_MODE == 1
    a.ph_lo = 0; a.ph_hi = NPH;
    for (int rep = 0; rep < FWD_REPS; ++rep) {
        hipMemsetAsync((char*)d_ws + WS_CTL, 0, 64 * 1024, stream);
        void* args[] = {&a};
        hipError_t e = hipLaunchCooperativeKernel((const void*)mega, dim3(grid), dim3(NTHR), args, LDS_BYTES, stream);
        if (e != hipSuccess) fprintf(stderr, "cooperative launch failed: %s (grid %d)\n", hipGetErrorString(e), grid);
    }
#else
    hipMemsetAsync((char*)d_ws + WS_CTL, 0, 64 * 1024, stream);
    for (int ph = 0; ph < NPH; ++ph) { a.ph_lo = ph; a.ph_hi = ph + 1; hipLaunchKernelGGL(mega, dim3(grid), dim3(NTHR), LDS_BYTES, stream, a); }
#endif
}
```

```cpp
#include <hip/hip_runtime.h>
#include <hip/hip_cooperative_groups.h>
#include <cstdio>
namespace cg = cooperative_groups;

#ifndef N_LAUNCH_MODE
#define CONV_BLOCKS 57
#define SPLIT34 1
#define P5_PF 34
#define N_LAUNCH_MODE 1
#endif

#ifndef REP_MASK
#define REP_MASK 0
#endif
#ifndef FWD_REPS
#define FWD_REPS 1
#endif
#ifndef ITEM_REP3
#define ITEM_REP3 1
#endif
#ifndef ITEM_REP6
#define ITEM_REP6 1
#endif
#ifndef USE_TR_READ
#define USE_TR_READ 1
#endif
#ifndef STAGE_SEL
#define STAGE_SEL -1
#endif
#ifndef STAGE_FN
#define STAGE_FN 0
#endif
#ifndef STAGE_K
#define STAGE_K 8
#endif
#ifndef FUSE01
#define FUSE01 1
#endif
#ifndef TL_SEL
#define TL_SEL -1
#endif
#ifndef USE_SC1_STORES
#define USE_SC1_STORES 1
#endif
#ifndef EXTRA_SYNCS
#define EXTRA_SYNCS 0
#endif
#define LAS __attribute__((address_space(3)))
typedef unsigned short bf16_t;
typedef short bf16x8 __attribute__((ext_vector_type(8)));
typedef float f32x4 __attribute__((ext_vector_type(4)));
typedef float f32x16 __attribute__((ext_vector_type(16)));
typedef unsigned u32x2 __attribute__((ext_vector_type(2)));
typedef unsigned u32x4 __attribute__((ext_vector_type(4)));

constexpr int D = 1024, NB = 4, SEQ = 4096, CTXL = 256;
constexpr int MX = NB * SEQ, MC = NB * CTXL, MT = MX + MC;
constexpr int INW = 3632, ZLD = 3584, NPADW = 3840;
__host__ __device__ __forceinline__ size_t zoff(int tok, int col) { return ((size_t)(col >> 6) * MT + (size_t)tok) * 64 + (size_t)(col & 63); }
constexpr int NCH = 68;
constexpr int NSTATE = NB * 4 * NCH;
constexpr float EPS = 1e-6f;
constexpr int NTHR = 512;
constexpr int LDS_BYTES = 160 * 1024;

constexpr size_t MiB = 1u << 20;
constexpr size_t WS_CTL = 0;
constexpr size_t WS_MOD = 1 * MiB;
constexpr size_t WS_ROUTE = 2 * MiB;
constexpr size_t WS_GDEC = 3 * MiB;
constexpr size_t WS_MN = 4 * MiB;
constexpr size_t WS_MSC = 6 * MiB;
constexpr size_t WS_GATES = 7 * MiB;
constexpr size_t WS_WINT = 11 * MiB;
constexpr size_t WS_WOUTT = 19 * MiB;
constexpr size_t WS_E1T = 21 * MiB;
constexpr size_t WS_E2T = 85 * MiB;
constexpr size_t WS_A = 117 * MiB;
constexpr size_t WS_Z = 151 * MiB;
constexpr size_t WS_MQ = 270 * MiB;
constexpr size_t WS_MK = 287 * MiB;
constexpr size_t WS_X1 = 304 * MiB;
constexpr size_t WS_UG = 304 * MiB;
constexpr size_t WS_UM = 338 * MiB;
constexpr size_t WS_PSS = 406 * MiB;
constexpr size_t WS_TOK = 408 * MiB;
constexpr size_t WS_END = 410 * MiB;
constexpr int CW_CNT = 64;
constexpr int MOE_TAB = 135168;
constexpr int CW_TD = 10240;
constexpr int CW_E2 = 12800;
constexpr int CW_Q = 3200;
constexpr int CW_MODF = 3072;
constexpr int CW_BAR = 4096;
constexpr int LDS_NQ = LDS_BYTES - 128;
constexpr int LDS_XB = LDS_BYTES - 64;

struct P { const float* in[25]; float* out; unsigned char* ws; int ph_lo, ph_hi; };

typedef float f32x2 __attribute__((ext_vector_type(2)));
typedef __bf16 bf16x2_t __attribute__((ext_vector_type(2)));
__device__ __forceinline__ unsigned pk2(float lo, float hi) { const f32x2 v = {lo, hi}; const bf16x2_t b = __builtin_convertvector(v, bf16x2_t); return __builtin_bit_cast(unsigned, b); }
__device__ __forceinline__ unsigned f2bf(float f) { return pk2(f, 0.f) & 0xffffu; }
__device__ __forceinline__ float bf2f(unsigned b) { return __uint_as_float(b << 16); }
__device__ __forceinline__ float bflo(unsigned w) { return __uint_as_float(w << 16); }
__device__ __forceinline__ float bfhi(unsigned w) { return __uint_as_float(w & 0xffff0000u); }

constexpr float SG_SCALE = 2.f, SM_SCALE = 64.f, Y_SCALE = 16.f;
__device__ __forceinline__ unsigned pk4_fp8(float a, float b, float c, float d) {
    a = __builtin_amdgcn_fmed3f(a, -448.f, 448.f); b = __builtin_amdgcn_fmed3f(b, -448.f, 448.f); c = __builtin_amdgcn_fmed3f(c, -448.f, 448.f); d = __builtin_amdgcn_fmed3f(d, -448.f, 448.f);
    int w = 0; w = __builtin_amdgcn_cvt_pk_fp8_f32(a, b, w, false); w = __builtin_amdgcn_cvt_pk_fp8_f32(c, d, w, true); return (unsigned)w;
}
__device__ __forceinline__ void up4_fp8(unsigned w, float (&o)[4]) {
    const f32x2 lo = __builtin_amdgcn_cvt_pk_f32_fp8((int)w, false), hi = __builtin_amdgcn_cvt_pk_f32_fp8((int)w, true); o[0] = lo.x; o[1] = lo.y; o[2] = hi.x; o[3] = hi.y;
}
__device__ __forceinline__ u32x4 fp8x8_to_bf16(u32x2 w, float inv) {
    float a[4], b[4]; up4_fp8(w.x, a); up4_fp8(w.y, b);
    u32x4 o; o.x = pk2(a[0] * inv, a[1] * inv); o.y = pk2(a[2] * inv, a[3] * inv); o.z = pk2(b[0] * inv, b[1] * inv); o.w = pk2(b[2] * inv, b[3] * inv); return o;
}
__device__ __forceinline__ float wave_sum(float v) {
#pragma unroll
    for (int o = 32; o >= 1; o >>= 1) v += __shfl_xor(v, o);
    return v;
}
__device__ __forceinline__ float rcpf(float x) { return __builtin_amdgcn_rcpf(x); }
__device__ __forceinline__ float siluf(float x) { return x * rcpf(1.f + __expf(-x)); }
__device__ __forceinline__ float sigmf(float x) { return rcpf(1.f + __expf(-x)); }
__device__ __forceinline__ float logsigf(float x) { return fminf(x, 0.f) - __logf(1.f + __expf(-fabsf(x))); }


#define DPP_F(old, src, ctrl, rmask) __builtin_bit_cast(float, __builtin_amdgcn_update_dpp(__builtin_bit_cast(int, (float)(old)), __builtin_bit_cast(int, (float)(src)), (ctrl), (rmask), 0xf, false))
__device__ __forceinline__ float scan_sum_up(float v, int lane) {
    (void)lane;
    v += DPP_F(0.f, v, 0x111, 0xf); v += DPP_F(0.f, v, 0x112, 0xf); v += DPP_F(0.f, v, 0x114, 0xf); v += DPP_F(0.f, v, 0x118, 0xf);
    v += DPP_F(0.f, v, 0x142, 0xa); v += DPP_F(0.f, v, 0x143, 0xc);
    return v;
}
__device__ __forceinline__ float scan_max_up(float v, int lane) {
    (void)lane; const float ninf = -3.0e38f;
    v = fmaxf(v, DPP_F(ninf, v, 0x111, 0xf)); v = fmaxf(v, DPP_F(ninf, v, 0x112, 0xf)); v = fmaxf(v, DPP_F(ninf, v, 0x114, 0xf)); v = fmaxf(v, DPP_F(ninf, v, 0x118, 0xf));
    v = fmaxf(v, DPP_F(ninf, v, 0x142, 0xa)); v = fmaxf(v, DPP_F(ninf, v, 0x143, 0xc));
    return v;
}
__device__ __forceinline__ float scan_sum_down(float v, int lane) { return __shfl(scan_sum_up(__shfl(v, 63 - lane), lane), 63 - lane); }
__device__ __forceinline__ float scan_max_down(float v, int lane) { return __shfl(scan_max_up(__shfl(v, 63 - lane), lane), 63 - lane); }
__device__ __forceinline__ float wave_max(float v) {
#pragma unroll
    for (int o = 32; o >= 1; o >>= 1) v = fmaxf(v, __shfl_xor(v, o));
    return v;
}

__device__ __forceinline__ bf16x8 ldfrag(const LAS bf16_t* T, int ld, int row0, int k0, int lane) {
    return *(const LAS bf16x8*)(T + (row0 + (lane & 31)) * ld + k0 + 8 * (lane >> 5));
}
#define MFMA32(a, b, c) __builtin_amdgcn_mfma_f32_32x32x16_bf16((a), (b), (c), 0, 0, 0)
__device__ __forceinline__ int crow(int r, int lane) { return (r & 3) + 8 * (r >> 2) + 4 * (lane >> 5); }


#define XB_TMO      128
#define XB_XCNT(j)  (256  + 64 * (j))
#define XB_XSUB(j)  (1280 + 64 * (j))
#define XB_XGEN(j)  (2304 + 64 * (j))
#define XB_TOP      3328
#define XB_TOPGEN   3392
#define XCD_BAR_WORDS 3456
#define XB_SPIN_CAP (1u << 22)
__device__ __forceinline__ unsigned xb_ld(unsigned* p)              { return __hip_atomic_load(p, __ATOMIC_RELAXED, __HIP_MEMORY_SCOPE_AGENT); }
__device__ __forceinline__ unsigned xb_add(unsigned* p, unsigned v) { return __hip_atomic_fetch_add(p, v, __ATOMIC_RELAXED, __HIP_MEMORY_SCOPE_AGENT); }
__device__ __forceinline__ unsigned xb_xcc_id() { return (unsigned)__builtin_amdgcn_s_getreg((3 << 11) | 20) & 0xFu; }
#define XB_SPIN(cond, bar) do { unsigned _sp = 0; while (cond) { __builtin_amdgcn_s_sleep(1); \
    if ((++_sp & 255u) == 0u) { if (xb_ld(&(bar)[XB_TMO])) break; if (_sp > XB_SPIN_CAP) { atomicAdd(&(bar)[XB_TMO], 1u); break; } } } } while (0)
struct XcdBarrier { unsigned* bar; unsigned x; volatile LAS unsigned* st; };
__device__ __forceinline__ XcdBarrier xcd_barrier_post(unsigned* bar, volatile LAS unsigned* st) {
    XcdBarrier b; b.bar = bar; b.x = xb_xcc_id(); b.st = st;
    if (threadIdx.x == 0) (void)xb_add(&bar[XB_XCNT(b.x)], 1u);
    return b;
}
__device__ __forceinline__ void xcd_barrier_complete(unsigned* bar, unsigned x, unsigned& nloc, unsigned& nx) {
    const unsigned G = gridDim.x * gridDim.y * gridDim.z;
    unsigned sum, cnt, mine, sp = 0u;
    for (;;) {
        sum = 0u; cnt = 0u; mine = 0u;
#pragma unroll
        for (unsigned j = 0; j < 16; ++j) { const unsigned c = xb_ld(&bar[XB_XCNT(j)]); sum += c; cnt += (c > 0u) ? 1u : 0u; mine = (j == x) ? c : mine; }
        if (sum == G) break;
        __builtin_amdgcn_s_sleep(1);
        if ((++sp & 255u) == 0u) { if (xb_ld(&bar[XB_TMO])) break; if (sp > XB_SPIN_CAP) { atomicAdd(&bar[XB_TMO], 1u); break; } }
    }
    nloc = mine > 0u ? mine : 1u; nx = cnt > 0u ? cnt : 1u;
}
__device__ __forceinline__ void xcd_barrier(const XcdBarrier& b) {
    asm volatile("s_waitcnt vmcnt(0)" ::: "memory");
    __syncthreads();
    if (threadIdx.x == 0) {
        unsigned* bar = b.bar;
        __builtin_amdgcn_s_waitcnt(0);
        unsigned nloc = b.st[0], nx = b.st[1];
        if (nloc == 0u) { xcd_barrier_complete(bar, b.x, nloc, nx); b.st[0] = nloc; b.st[1] = nx; }
        const unsigned old = xb_add(&bar[XB_XSUB(b.x)], 1u);
        const unsigned gen = old / nloc;
        if (old + 1u == (gen + 1u) * nloc) {
            __builtin_amdgcn_fence(__ATOMIC_RELEASE, "agent");
            asm volatile("s_waitcnt vmcnt(0)" ::: "memory");
            const unsigned og = xb_add(&bar[XB_TOP], 1u);
            const unsigned tg = og / nx;
            if (og + 1u == (tg + 1u) * nx) xb_add(&bar[XB_TOPGEN], 1u);
            else XB_SPIN(xb_ld(&bar[XB_TOPGEN]) <= tg, bar);
            __builtin_amdgcn_fence(__ATOMIC_ACQUIRE, "agent");
            xb_add(&bar[XB_XGEN(b.x)], 1u);
            asm volatile("s_waitcnt vmcnt(0)" ::: "memory");
        } else {
            XB_SPIN(xb_ld(&bar[XB_XGEN(b.x)]) <= gen, bar);
            __builtin_amdgcn_fence(__ATOMIC_ACQUIRE, "agent");
            asm volatile("s_waitcnt vmcnt(0)" ::: "memory");
        }
    }
    __syncthreads();
}

struct XbTok { unsigned gen, tg; int role; };
__device__ __forceinline__ XbTok xcd_arrive(const XcdBarrier& b) {
    asm volatile("s_waitcnt vmcnt(0)" ::: "memory");
    __syncthreads();
    XbTok t; t.gen = 0u; t.tg = 0u; t.role = 0;
    if (threadIdx.x == 0) {
        unsigned* bar = b.bar;
        __builtin_amdgcn_s_waitcnt(0);
        unsigned nloc = b.st[0], nx = b.st[1];
        if (nloc == 0u) { xcd_barrier_complete(bar, b.x, nloc, nx); b.st[0] = nloc; b.st[1] = nx; }
        const unsigned old = xb_add(&bar[XB_XSUB(b.x)], 1u);
        t.gen = old / nloc;
        if (old + 1u == (t.gen + 1u) * nloc) {
            __builtin_amdgcn_fence(__ATOMIC_RELEASE, "agent");
            asm volatile("s_waitcnt vmcnt(0)" ::: "memory");
            const unsigned og = xb_add(&bar[XB_TOP], 1u);
            t.tg = og / nx;
            if (og + 1u == (t.tg + 1u) * nx) { xb_add(&bar[XB_TOPGEN], 1u); t.role = 2; } else t.role = 1;
        }
    }
    return t;
}
__device__ __forceinline__ void xcd_wait(const XcdBarrier& b, const XbTok& t) {
    if (threadIdx.x == 0) {
        unsigned* bar = b.bar;
        if (t.role) {
            if (t.role == 1) XB_SPIN(xb_ld(&bar[XB_TOPGEN]) <= t.tg, bar);
            __builtin_amdgcn_fence(__ATOMIC_ACQUIRE, "agent");
            xb_add(&bar[XB_XGEN(b.x)], 1u);
            asm volatile("s_waitcnt vmcnt(0)" ::: "memory");
        } else {
            XB_SPIN(xb_ld(&bar[XB_XGEN(b.x)]) <= t.gen, bar);
            __builtin_amdgcn_fence(__ATOMIC_ACQUIRE, "agent");
            asm volatile("s_waitcnt vmcnt(0)" ::: "memory");
        }
    }
    __syncthreads();
}
__device__ __forceinline__ void xcd_wait_long(const XcdBarrier& b, const XbTok& t) {
    if (threadIdx.x == 0) {
        unsigned* bar = b.bar;
        XB_SPIN(xb_ld(&bar[XB_TOPGEN]) <= t.gen, bar);
        __builtin_amdgcn_fence(__ATOMIC_ACQUIRE, "agent");
        if (t.role) xb_add(&bar[XB_XGEN(b.x)], 1u);
        asm volatile("s_waitcnt vmcnt(0)" ::: "memory");
    }
    __syncthreads();
}

namespace pg8 {
constexpr int BM = 256, BK = 64, HALF = 128, HTB = HALF * BK * 2, STAGE_BYTES = 8 * HTB;
__device__ __forceinline__ int lds_byte(int r, int c) { const int st = (r >> 4) * 2 + (c >> 5), rr = r & 15, cc = c & 31, ob = rr * 64 + cc * 2; return st * 1024 + (ob ^ (((ob >> 9) & 1) << 5)); }
__device__ __forceinline__ void stage_rc(int b, int& R, int& C) { const int st = b / 1024, sb = b % 1024, swz = sb ^ (((sb >> 9) & 1) << 5); R = (st >> 1) * 16 + swz / 64; C = (st & 1) * 32 + (swz % 64) / 2; }
__device__ __forceinline__ int perm32(int rho) { const int n = rho >> 4, i = rho & 15; return 8 * (i >> 2) + 4 * n + (i & 3); }
struct Unit { int pm, pn, sh, e; const char* a; const char* b; };

template <class Epi, class Sched, bool GATHER = false, bool ALIGN_EPI = true, bool SP2 = true>
__device__ __forceinline__ void gemm_phase(LAS unsigned char* lds, const int K, const Sched& S, const Epi& E) {
    const int tid = threadIdx.x, wid = __builtin_amdgcn_readfirstlane(tid >> 6), lane = tid & 63, wr = wid >> 2, wc = wid & 3, fr = lane & 15, fq = lane >> 4;
    const int nt = K / BK;
    unsigned voffA[2], voffB[2];
#pragma unroll
    for (int i = 0; i < 2; ++i) { int R, C; stage_rc(tid * 16 + i * 8192, R, C); const int Rb = Epi::PERM ? ((R & ~31) + perm32(R & 31)) : R;
        voffA[i] = (unsigned)(R * K + C) * 2u; voffB[i] = (unsigned)(Rb * 64 + C) * 2u; }
    unsigned ca[2][2], na[2][2];
#define PG8_GOFF(dst, u) do { if constexpr (GATHER) { _Pragma("unroll") for (int _h = 0; _h < 2; ++_h) _Pragma("unroll") for (int _i = 0; _i < 2; ++_i) { int _R, _C; stage_rc(tid * 16 + _i * 8192, _R, _C); \
        dst[_h][_i] = S.row_off(u, _h * HALF + _R) + (unsigned)_C * 2u; } } } while (0)
    const size_t kstep = (size_t)(BK * 2);
    const size_t hstep = (size_t)HALF * K * 2;
    const size_t hstepA = GATHER ? 0 : hstep;
    const size_t kstepB = (size_t)S.brows * 128, hstepB = (size_t)HALF * 128;
    const unsigned ldsw = (unsigned)wid * 1024u;
    const int aoff = lds_byte(wr * 64 + fr, fq * 8), boff = lds_byte(wc * 32 + fr, fq * 8);
#define PG8_SA(b, h) (((b) * 2 + (h)) * HTB)
#define PG8_SB(b, h) ((4 + (b) * 2 + (h)) * HTB)
#define PG8_STAGE(bufoff, gbase, voff) do { _Pragma("unroll") for (int _i = 0; _i < 2; ++_i) \
        __builtin_amdgcn_global_load_lds((const unsigned*)((const char*)(gbase) + (voff)[_i]), (LAS unsigned*)(lds + (bufoff) + ldsw + _i * 8192), 16, 0, 0); } while (0)
#define PG8_STAGEA(bufoff, gbase, h, nx) do { _Pragma("unroll") for (int _i = 0; _i < 2; ++_i) { const unsigned _vo = GATHER ? ((nx) ? na[h][_i] : ca[h][_i]) : voffA[_i]; \
        __builtin_amdgcn_global_load_lds((const unsigned*)((const char*)(gbase) + (size_t)(h) * hstepA + _vo), (LAS unsigned*)(lds + (bufoff) + ldsw + _i * 8192), 16, 0, 0); } } while (0)
#define PG8_LDA(dst, b, h) do { _Pragma("unroll") for (int m = 0; m < 4; ++m) _Pragma("unroll") for (int k = 0; k < 2; ++k) dst[m][k] = *(const LAS bf16x8*)(lds + PG8_SA(b, h) + aoff + m * 2048 + k * 1024); } while (0)
#define PG8_LDB(dst, b, h) do { _Pragma("unroll") for (int n = 0; n < 2; ++n) _Pragma("unroll") for (int k = 0; k < 2; ++k) dst[n][k] = *(const LAS bf16x8*)(lds + PG8_SB(b, h) + boff + n * 2048 + k * 1024); } while (0)
#define PG8_MMA(ai, bj, At, Bt) do { __builtin_amdgcn_s_setprio(1); _Pragma("unroll") for (int m = 0; m < 4; ++m) _Pragma("unroll") for (int n = 0; n < 2; ++n) _Pragma("unroll") for (int k = 0; k < 2; ++k) \
        acc[ai][bj][m][n] = __builtin_amdgcn_mfma_f32_16x16x32_bf16(Bt[n][k], At[m][k], acc[ai][bj][m][n], 0, 0, 0); __builtin_amdgcn_s_setprio(0); } while (0)
#define PG8_WAIT_V(n) asm volatile("s_waitcnt vmcnt(" #n ")" ::: "memory")
#define PG8_WAIT_L(n) asm volatile("s_waitcnt lgkmcnt(" #n ")" ::: "memory")
#define PG8_BAR __builtin_amdgcn_s_barrier()
#define PG8_SCHED __builtin_amdgcn_sched_barrier(0)
    Unit cur, nxt; int ui = 0;
    if (!S.next(0, cur)) return;
    f32x4 acc[2][2][4][2];
#pragma unroll
    for (int a = 0; a < 2; ++a)
#pragma unroll
        for (int b = 0; b < 2; ++b)
#pragma unroll
            for (int m = 0; m < 4; ++m)
#pragma unroll
                for (int n = 0; n < 2; ++n) acc[a][b][m][n] = (f32x4){0.f, 0.f, 0.f, 0.f};
    bf16x8 At[4][2], B0[2][2], B1[2][2];
    const char* cA = cur.a; const char* cB = cur.b;
    S.a_ready(cur);
    PG8_GOFF(ca, cur);
    if constexpr (SP2) {
        PG8_STAGE(PG8_SB(0, 0), cB, voffB); PG8_STAGE(PG8_SB(0, 1), cB + hstepB, voffB); PG8_STAGEA(PG8_SA(0, 0), cA, 0, false); PG8_STAGEA(PG8_SA(0, 1), cA, 1, false);
        if (wr == 1) PG8_BAR;
        PG8_WAIT_V(2); PG8_BAR;
        PG8_STAGE(PG8_SB(1, 0), cB + kstepB, voffB); PG8_STAGEA(PG8_SA(1, 0), cA + kstep, 0, false); PG8_STAGE(PG8_SB(1, 1), cB + hstepB + kstepB, voffB);
        PG8_WAIT_V(6); PG8_BAR;
    } else {
        PG8_STAGE(PG8_SB(0, 0), cB, voffB); PG8_STAGEA(PG8_SA(0, 0), cA, 0, false); PG8_STAGE(PG8_SB(0, 1), cB + hstepB, voffB); PG8_STAGEA(PG8_SA(0, 1), cA, 1, false);
        if (wr == 1) PG8_BAR;
        PG8_WAIT_V(4); PG8_BAR;
        PG8_STAGE(PG8_SB(1, 0), cB + kstepB, voffB); PG8_STAGEA(PG8_SA(1, 0), cA + kstep, 0, false); PG8_STAGE(PG8_SB(1, 1), cB + hstepB + kstepB, voffB);
        PG8_WAIT_V(6); PG8_BAR;
    }
    for (;;) {
        const bool has_next = S.next(ui + 1, nxt);
        const bool csh = __builtin_amdgcn_readfirstlane(cur.sh) != 0;
        const char* nA = has_next ? nxt.a : cA; const char* nB = has_next ? nxt.b : cB;
        if constexpr (GATHER) { if (has_next) PG8_GOFF(na, nxt); else { _Pragma("unroll") for (int _h = 0; _h < 2; ++_h) _Pragma("unroll") for (int _i = 0; _i < 2; ++_i) na[_h][_i] = ca[_h][_i]; } }
        for (int t = 0; t < nt; t += 2) {
            const bool last = (t == nt - 2);
            const char* a1 = cA + (size_t)(t + 1) * kstep;
            const char* a2 = last ? nA : cA + (size_t)(t + 2) * kstep; const char* b2 = last ? nB : cB + (size_t)(t + 2) * kstepB;
            const char* a3 = a2 + kstep; const char* b3 = b2 + kstepB;
            if (last && has_next) S.a_ready(nxt);
            if constexpr (SP2) {
            PG8_LDB(B0, 0, 0); PG8_LDB(B1, 0, 1); PG8_SCHED; PG8_LDA(At, 0, 0); PG8_STAGEA(PG8_SA(1, 1), a1, 1, false);
            PG8_WAIT_V(8); PG8_WAIT_L(0); PG8_BAR; PG8_MMA(0, 0, At, B0); PG8_MMA(0, 1, At, B1); PG8_BAR; PG8_SCHED;
            if (!csh) PG8_LDA(At, 0, 1); PG8_STAGE(PG8_SB(0, 0), b2, voffB); PG8_STAGE(PG8_SB(0, 1), b2 + hstepB, voffB); PG8_STAGEA(PG8_SA(0, 0), a2, 0, last);
            PG8_WAIT_V(8); PG8_WAIT_L(0); PG8_BAR; if (!csh) { PG8_MMA(1, 0, At, B0); PG8_MMA(1, 1, At, B1); } PG8_BAR; PG8_SCHED;
            PG8_LDB(B0, 1, 0); PG8_LDB(B1, 1, 1); PG8_SCHED; PG8_LDA(At, 1, 0); PG8_STAGEA(PG8_SA(0, 1), a2, 1, last);
            PG8_WAIT_V(8); PG8_WAIT_L(0); PG8_BAR; PG8_MMA(0, 0, At, B0); PG8_MMA(0, 1, At, B1); PG8_BAR; PG8_SCHED;
            if (!csh) PG8_LDA(At, 1, 1); PG8_STAGE(PG8_SB(1, 0), b3, voffB); PG8_STAGE(PG8_SB(1, 1), b3 + hstepB, voffB); PG8_STAGEA(PG8_SA(1, 0), a3, 0, last);
            PG8_WAIT_V(8); PG8_WAIT_L(0); PG8_BAR; if (!csh) { PG8_MMA(1, 0, At, B0); PG8_MMA(1, 1, At, B1); } PG8_BAR; PG8_SCHED;
            } else {
            PG8_LDB(B0, 0, 0); PG8_SCHED; PG8_LDA(At, 0, 0); PG8_STAGEA(PG8_SA(1, 1), a1, 1, false);
            PG8_WAIT_L(8); PG8_BAR; PG8_WAIT_L(0); PG8_MMA(0, 0, At, B0); PG8_BAR; PG8_SCHED;
            PG8_LDB(B1, 0, 1); PG8_STAGE(PG8_SB(0, 0), b2, voffB);
            PG8_BAR; PG8_WAIT_L(0); PG8_MMA(0, 1, At, B1); PG8_BAR;
            PG8_LDA(At, 0, 1); PG8_STAGEA(PG8_SA(0, 0), a2, 0, last);
            PG8_BAR; PG8_WAIT_L(0); PG8_MMA(1, 0, At, B0); PG8_BAR; PG8_SCHED;
            PG8_STAGE(PG8_SB(0, 1), b2 + hstepB, voffB);
            PG8_WAIT_V(6); PG8_BAR; PG8_MMA(1, 1, At, B1); PG8_BAR;
            PG8_LDB(B0, 1, 0); PG8_SCHED; PG8_LDA(At, 1, 0); PG8_STAGEA(PG8_SA(0, 1), a2, 1, last);
            PG8_WAIT_L(8); PG8_BAR; PG8_WAIT_L(0); PG8_MMA(0, 0, At, B0); PG8_BAR; PG8_SCHED;
            PG8_LDB(B1, 1, 1); PG8_STAGE(PG8_SB(1, 0), b3, voffB);
            PG8_BAR; PG8_WAIT_L(0); PG8_MMA(0, 1, At, B1); PG8_BAR;
            PG8_LDA(At, 1, 1); PG8_STAGEA(PG8_SA(1, 0), a3, 0, last);
            PG8_BAR; PG8_WAIT_L(0); PG8_MMA(1, 0, At, B0); PG8_BAR; PG8_SCHED;
            PG8_STAGE(PG8_SB(1, 1), b3 + hstepB, voffB);
            PG8_WAIT_V(6); PG8_BAR; PG8_MMA(1, 1, At, B1); PG8_BAR;
            }
        }
        if constexpr (ALIGN_EPI) { if (wr == 0) PG8_BAR; }
        E(acc, cur, wr, wc, fr, fq); S.done(cur);
        if (!has_next) break;
#pragma unroll
        for (int a = 0; a < 2; ++a)
#pragma unroll
            for (int b = 0; b < 2; ++b)
#pragma unroll
                for (int m = 0; m < 4; ++m)
#pragma unroll
                    for (int n = 0; n < 2; ++n) acc[a][b][m][n] = (f32x4){0.f, 0.f, 0.f, 0.f};
        cur = nxt; cA = nA; cB = nB; ++ui;
        if constexpr (GATHER) { _Pragma("unroll") for (int _h = 0; _h < 2; ++_h) _Pragma("unroll") for (int _i = 0; _i < 2; ++_i) ca[_h][_i] = na[_h][_i]; }
        if constexpr (ALIGN_EPI) { if (wr == 1) PG8_BAR; }
    }
    PG8_WAIT_V(0);
    if constexpr (!ALIGN_EPI) { if (wr == 0) PG8_BAR; }
    PG8_BAR;
#undef PG8_SA
#undef PG8_SB
#undef PG8_STAGE
#undef PG8_STAGEA
#undef PG8_GOFF
#undef PG8_LDA
#undef PG8_LDB
#undef PG8_MMA
#undef PG8_WAIT_V
#undef PG8_WAIT_L
#undef PG8_BAR
#undef PG8_SCHED
}

struct SchedDense {
    int nM, nN, nwg, G, c, K, brows, nx; const char* A; const char* Bt;
    __device__ __forceinline__ bool next(int i, Unit& u) const {
        const long L = (long)i * G + c; if (L >= nwg + nx) return false;
        u.sh = 0; u.e = 0;
        if (L >= nwg) { const int j = (int)L - nwg, cc = j & 7;
            u.pm = nM + (j >> 3); u.pn = cc < 3 ? 1 + cc : (cc < 7 ? 5 + cc : 14); }
        else {
        int wgid = (int)L; { const int q = nwg / 8, r = nwg % 8, xcd = wgid % 8, off = wgid / 8; wgid = (xcd < r ? xcd * (q + 1) : r * (q + 1) + (xcd - r) * q) + off; }
        const int nig = 8 * nN, gid = wgid / nig, fm = gid * 8, gsz = (nM - fm) < 8 ? (nM - fm) : 8;
        u.pm = fm + ((wgid % nig) % gsz); u.pn = (wgid % nig) / gsz; }
        u.a = A + (size_t)u.pm * 256 * K * 2; u.b = Bt + (size_t)u.pn * 256 * 128; return true;
    }
    __device__ __forceinline__ void a_ready(const Unit&) const {}
    __device__ __forceinline__ void done(const Unit&) const {}
};
struct SchedMoE {
    int mode; unsigned* ctl;
    int ntiles, G, c, K, brows; const LAS int* ord; const LAS int* tex; const LAS int* pst; const LAS int* cnt; const int* tok; const char* A; const char* Bt; size_t bstride; bool gather;
    __device__ __forceinline__ bool next(int i, Unit& u) const {
        const int L = i * G + c; const int pos = L >> 2; if (pos >= ntiles) return false;
        const int ent = ord[pos], rt = ent & 0xffff;
        u.pm = rt; u.pn = L & 3; u.sh = ent >> 16; const int e = tex[rt]; u.e = e;
        u.a = gather ? A : A + (size_t)rt * 256 * K * 2; u.b = Bt + (size_t)e * bstride + (size_t)u.pn * 256 * 128; return true;
    }
    __device__ __forceinline__ unsigned row_off(const Unit& u, int r) const {
        const int e = tex[u.pm], idx = (u.pm - (pst[e] >> 8)) * 256 + r;
        const int t = idx < cnt[e] ? tok[e * 16384 + idx] : 0;
        return (unsigned)t * (unsigned)(K * 2);
    }
    __device__ __forceinline__ void a_ready(const Unit& u) const {
        if (mode != 2) return;
        if (threadIdx.x < 64) {
            const unsigned* td = ctl + CW_TD + 16 * u.pm; const unsigned* e2 = ctl + CW_E2 + 16 * u.e; unsigned sp = 0;
            while ((unsigned)__builtin_amdgcn_readfirstlane(__hip_atomic_load(td, __ATOMIC_RELAXED, __HIP_MEMORY_SCOPE_AGENT)) < 32u ||
                   (unsigned)__builtin_amdgcn_readfirstlane(__hip_atomic_load(e2, __ATOMIC_RELAXED, __HIP_MEMORY_SCOPE_AGENT)) < 128u) {
                __builtin_amdgcn_s_sleep(2); if (++sp > (1u << 22)) break; }
            __builtin_amdgcn_fence(__ATOMIC_ACQUIRE, "agent");
            asm volatile("s_waitcnt vmcnt(0)" ::: "memory");
        }
        asm volatile("" ::: "memory"); __builtin_amdgcn_s_barrier(); asm volatile("" ::: "memory");
    }
    __device__ __forceinline__ void done(const Unit& u) const {
        if (mode != 1) return;
        asm volatile("s_waitcnt vmcnt(0)" ::: "memory");
        if ((threadIdx.x & 63) == 0) __hip_atomic_fetch_add(ctl + CW_TD + 16 * u.pm, 1u, __ATOMIC_RELAXED, __HIP_MEMORY_SCOPE_AGENT);
    }
};
}

typedef const f32x4 (&AccRef)[2][2][4][2];
__device__ __forceinline__ void store16_wt(void* ptr, u32x4 v) {
#if USE_SC1_STORES
    asm volatile("global_store_dwordx4 %0, %1, off sc1\n\ts_nop 1" :: "v"(ptr), "v"(v) : "memory");
#else
    *(u32x4*)ptr = v;
#endif
}
struct EpiZ {
    static constexpr bool PERM = true; bf16_t* Z; float* G;
    __device__ __forceinline__ void operator()(AccRef acc, const pg8::Unit& u, int wr, int wc, int fr, int fq) const {
        const int row0 = u.pm * 256 + wr * 64 + fr;
        if (u.pn < 14) {
            const int col0 = u.pn * 256 + wc * 32 + 8 * fq;
#pragma unroll
            for (int ai = 0; ai < 2; ++ai)
#pragma unroll
                for (int m = 0; m < 4; ++m) { bf16_t* rowp = Z + zoff(row0 + ai * 128 + m * 16, col0);
#pragma unroll
                    for (int bj = 0; bj < 2; ++bj) { const f32x4 v0 = acc[ai][bj][m][0], v1 = acc[ai][bj][m][1];
                        u32x4 o; o.x = pk2(v0[0], v0[1]); o.y = pk2(v0[2], v0[3]); o.z = pk2(v1[0], v1[1]); o.w = pk2(v1[2], v1[3]);
                        store16_wt(rowp + (size_t)bj * (2 * MT * 64), o); } }
        } else {
            const int c0 = wc * 32 + 8 * fq;
            if (c0 < 48) {
#pragma unroll
                for (int ai = 0; ai < 2; ++ai)
#pragma unroll
                    for (int m = 0; m < 4; ++m) { float* rowp = G + (size_t)(row0 + ai * 128 + m * 16) * 48 + c0;
                        *(f32x4*)rowp = acc[ai][0][m][0]; *(f32x4*)(rowp + 4) = acc[ai][0][m][1]; }
            }
        }
    }
};
struct EpiX1 {
    static constexpr bool PERM = true; const float* x; const float* mod; bf16_t* x1; float* pss;
    __device__ __forceinline__ void operator()(AccRef acc, const pg8::Unit& u, int wr, int wc, int fr, int fq) const {
        const int row0 = u.pm * 256 + wr * 64 + fr, col0 = u.pn * 256 + wc * 32 + 8 * fq;
        const float* g1 = mod + (size_t)(u.pm >> 4) * 6144 + 2048;
        f32x4 gv[2][2];
#pragma unroll
        for (int bj = 0; bj < 2; ++bj)
#pragma unroll
            for (int n = 0; n < 2; ++n) gv[bj][n] = *(const f32x4*)(g1 + col0 + bj * 128 + n * 4);
#pragma unroll
        for (int ai = 0; ai < 2; ++ai)
#pragma unroll
            for (int m = 0; m < 4; ++m) { const int row = row0 + ai * 128 + m * 16; const size_t off = (size_t)row * D + col0; float ss = 0.f;
#pragma unroll
                for (int bj = 0; bj < 2; ++bj) { const f32x4 xa = __builtin_nontemporal_load((const f32x4*)(x + off + bj * 128)), xb = __builtin_nontemporal_load((const f32x4*)(x + off + bj * 128 + 4));
                    const f32x4 oa = xa + gv[bj][0] * acc[ai][bj][m][0], ob = xb + gv[bj][1] * acc[ai][bj][m][1];
                    ss += oa.x * oa.x + oa.y * oa.y + oa.z * oa.z + oa.w * oa.w + ob.x * ob.x + ob.y * ob.y + ob.z * ob.z + ob.w * ob.w;
                    u32x4 o; o.x = pk2(oa.x, oa.y); o.y = pk2(oa.z, oa.w); o.z = pk2(ob.x, ob.y); o.w = pk2(ob.z, ob.w);
                    *(u32x4*)(x1 + off + bj * 128) = o; }
                ss += __shfl_xor(ss, 16); ss += __shfl_xor(ss, 32);
                if (fq == 0) pss[(size_t)row * 16 + u.pn * 4 + wc] = ss; }
    }
};
struct EpiH {
    static constexpr bool PERM = true; bf16_t* H;
    __device__ __forceinline__ void operator()(AccRef acc, const pg8::Unit& u, int wr, int wc, int fr, int fq) const {
        const int row0 = u.pm * 256 + wr * 64 + fr, col0 = u.pn * 128 + wc * 32 + 8 * fq;
#pragma unroll
        for (int ai = 0; ai < 2; ++ai)
#pragma unroll
            for (int m = 0; m < 4; ++m) { bf16_t* rowp = H + (size_t)(row0 + ai * 128 + m * 16) * 512 + col0;
                float h[8];
#pragma unroll
                for (int n = 0; n < 2; ++n)
#pragma unroll
                    for (int j = 0; j < 4; ++j) { const float g = acc[ai][0][m][n][j], up = acc[ai][1][m][n][j]; h[n * 4 + j] = siluf(g) * up; }
                u32x4 o; o.x = pk2(h[0], h[1]); o.y = pk2(h[2], h[3]); o.z = pk2(h[4], h[5]); o.w = pk2(h[6], h[7]);
                store16_wt(rowp, o); }
    }
};
struct EpiY {
    static constexpr bool PERM = true; unsigned char* Y;
    __device__ __forceinline__ void operator()(AccRef acc, const pg8::Unit& u, int wr, int wc, int fr, int fq) const {
        const int row0 = u.pm * 256 + wr * 64 + fr, col0 = u.pn * 256 + wc * 32 + 8 * fq;
#pragma unroll
        for (int ai = 0; ai < 2; ++ai)
#pragma unroll
            for (int m = 0; m < 4; ++m) { unsigned char* rowp = Y + (size_t)(row0 + ai * 128 + m * 16) * D + col0;
#pragma unroll
                for (int bj = 0; bj < 2; ++bj) { const f32x4 v0 = acc[ai][bj][m][0] * Y_SCALE, v1 = acc[ai][bj][m][1] * Y_SCALE;
                    u32x2 o; o.x = pk4_fp8(v0[0], v0[1], v0[2], v0[3]); o.y = pk4_fp8(v1[0], v1[1], v1[2], v1[3]);
                    *(u32x2*)(rowp + bj * 128) = o; } }
    }
};

__device__ __forceinline__ void p0_mod_item(const P& p, LAS unsigned char* lds, int item) {
    LAS float* SV = (LAS float*)lds; LAS float* PS = (LAS float*)(lds + 20480);
    const int tid = threadIdx.x;
    for (int i = tid; i < 5 * 1024; i += NTHR) { const int v = i >> 10, k = i & 1023; const float c = v < 4 ? p.in[1][v * 1024 + k] : p.in[3][k]; SV[i] = c / (1.f + expf(-c)); }
    __syncthreads();
    const int col = tid & 31, kq = tid >> 5, n = item * 32 + col;
    float acc[5] = {0.f, 0.f, 0.f, 0.f, 0.f};
    const float* W = p.in[4] + (size_t)(kq * 64) * 6144 + n;
    float wv[64];
#pragma unroll
    for (int k = 0; k < 64; ++k) wv[k] = __builtin_nontemporal_load(&W[(size_t)k * 6144]);
#pragma unroll
    for (int k = 0; k < 64; ++k) { const int kk = kq * 64 + k;
#pragma unroll
        for (int v = 0; v < 5; ++v) acc[v] += SV[v * 1024 + kk] * wv[k]; }
#pragma unroll
    for (int v = 0; v < 5; ++v) PS[(kq * 5 + v) * 32 + col] = acc[v];
    __syncthreads();
    if (tid < 160) { const int v = tid >> 5, c = tid & 31; float s = 0.f;
#pragma unroll
        for (int q = 0; q < 16; ++q) s += PS[(q * 5 + v) * 32 + c];
        ((float*)(p.ws + WS_MOD))[v * 6144 + item * 32 + c] = s + p.in[5][item * 32 + c]; }
    asm volatile("s_waitcnt vmcnt(0)" ::: "memory");
    __syncthreads();
    if (tid == 0) { __builtin_amdgcn_fence(__ATOMIC_RELEASE, "agent"); asm volatile("s_waitcnt vmcnt(0)" ::: "memory");
        (void)__hip_atomic_fetch_add((unsigned*)(p.ws + WS_CTL) + CW_MODF, 1u, __ATOMIC_RELAXED, __HIP_MEMORY_SCOPE_AGENT); }
    __syncthreads();
}
constexpr int TR_SCR = 64 * 65 * 4;
template <bool WTHRU = false, class RowMap>
__device__ __forceinline__ void transpose_item(const float* W, int K, int N, int NR, bf16_t* WT, LAS float* scr, int kb, int nb, int lane, RowMap rm) {
    const int k0 = 64 * kb, n0 = 64 * nb; const bool nok = n0 + lane < N;
    float v[64];
#pragma unroll
    for (int i = 0; i < 64; ++i) v[i] = nok ? __builtin_nontemporal_load(&W[(size_t)(k0 + i) * N + n0 + lane]) : 0.f;
#pragma unroll
    for (int i = 0; i < 64; ++i) scr[i * 65 + lane] = v[i];
    asm volatile("s_waitcnt lgkmcnt(0)" ::: "memory");
    const int c = lane & 7;
#pragma unroll
    for (int j = 0; j < 8; ++j) { const int nl = (lane >> 3) + 8 * j, n = n0 + nl;
        if (n < N) { const LAS float* q = scr + (8 * c) * 65 + nl;
            u32x4 o; o.x = pk2(q[0 * 65], q[1 * 65]); o.y = pk2(q[2 * 65], q[3 * 65]); o.z = pk2(q[4 * 65], q[5 * 65]); o.w = pk2(q[6 * 65], q[7 * 65]);
            if constexpr (WTHRU) store16_wt(WT + ((size_t)kb * NR + rm(n)) * 64 + 8 * c, o); else *(u32x4*)(WT + ((size_t)kb * NR + rm(n)) * 64 + 8 * c) = o; } }
    asm volatile("s_waitcnt lgkmcnt(0)" ::: "memory");
}
struct RmIn { __device__ __forceinline__ int operator()(int n) const { return n < 1536 ? n : (n < 1568 ? n + 2048 : (n < 3616 ? n - 32 : n)); } };
struct RmId { __device__ __forceinline__ int operator()(int n) const { return n; } };
struct RmE1 { __device__ __forceinline__ int operator()(int n) const { const int half = n >> 9, r = n & 511; return (r >> 7) * 256 + half * 128 + (r & 127); } };

__device__ __forceinline__ void phase0(const P& p, LAS unsigned char* lds, const bool with_e1) {
    const int tid = threadIdx.x, lane = tid & 63, wave = tid >> 6;
    for (int it = blockIdx.x; it < 192; it += gridDim.x) p0_mod_item(p, lds, it);
    LAS float* scr = (LAS float*)(lds + wave * TR_SCR);
    const int gw = blockIdx.x * 8 + wave, NGW = gridDim.x * 8;
    constexpr int I_IN = 16 * 57, I_OUT = 16 * 16, I_E1 = 32 * 16 * 16, NIT = I_IN + I_OUT + I_E1;
    bf16_t* WINT = (bf16_t*)(p.ws + WS_WINT); bf16_t* WOUTT = (bf16_t*)(p.ws + WS_WOUTT); bf16_t* E1T = (bf16_t*)(p.ws + WS_E1T);
    for (int it = gw; it < (with_e1 ? NIT : I_IN + I_OUT); it += NGW) {
        int r = it;
        if (r < I_IN) { transpose_item(p.in[7], 1024, INW, NPADW, WINT, scr, r / 57, r % 57, lane, RmIn()); continue; } r -= I_IN;
        if (r < I_OUT) { transpose_item(p.in[16], 1024, 1024, 1024, WOUTT, scr, r >> 4, r & 15, lane, RmId()); continue; } r -= I_OUT;
        { const int e = r >> 8, q = r & 255; transpose_item(p.in[22] + (size_t)e * 1024 * 1024, 1024, 1024, 1024, E1T + (size_t)e * 1024 * 1024, scr, q >> 4, q & 15, lane, RmE1()); }
    }
    for (int i = blockIdx.x * NTHR + tid; i < 208 * 128; i += gridDim.x * NTHR) { const int kb = i / (208 * 8), rem = i % (208 * 8);
        ((u32x4*)(WINT + ((size_t)kb * NPADW + INW) * 64))[rem] = (u32x4){0u, 0u, 0u, 0u}; }
}
__device__ __forceinline__ void convert_experts(const P& p, LAS unsigned char* lds, const int cv, const int ncv) {
    const int lane = threadIdx.x & 63, wave = threadIdx.x >> 6;
    LAS float* scr = (LAS float*)(lds + wave * TR_SCR); bf16_t* E1T = (bf16_t*)(p.ws + WS_E1T);
    for (int r = cv * 8 + wave; r < 32 * 16 * 16; r += ncv * 8) { const int e = r >> 8, q = r & 255;
        transpose_item<true>(p.in[22] + (size_t)e * 1024 * 1024, 1024, 1024, 1024, E1T + (size_t)e * 1024 * 1024, scr, q >> 4, q & 15, lane, RmE1()); }
}

__device__ __forceinline__ void p1_load(const P& p, const int r0, const int lane, f32x4 (&v)[2][4]) {
#pragma unroll
    for (int q = 0; q < 2; ++q) { const int row = r0 + q; const float* src = row < MX ? p.in[0] + (size_t)row * D : p.in[2] + (size_t)(row - MX) * D;
#pragma unroll
        for (int j = 0; j < 4; ++j) v[q][j] = __builtin_nontemporal_load((const f32x4*)(src + 4 * lane + 256 * j)); }
}
__device__ __forceinline__ void phase1(const P& p) {
    const int tid = threadIdx.x, lane = tid & 63, wave = tid >> 6;
    const float* mod = (const float*)(p.ws + WS_MOD); bf16_t* A = (bf16_t*)(p.ws + WS_A);
    const int NGW = gridDim.x * 8, gw = NGW - 1 - (blockIdx.x * 8 + wave);
    int r0 = gw * 2;
    f32x4 v[2][4];
    if (r0 < MT) p1_load(p, r0, lane, v);
    if (FUSE01) {
        if (tid == 0) { unsigned* f = (unsigned*)(p.ws + WS_CTL) + CW_MODF; unsigned sp = 0;
            while (__hip_atomic_load(f, __ATOMIC_RELAXED, __HIP_MEMORY_SCOPE_AGENT) < 192u) { __builtin_amdgcn_s_sleep(2); if (++sp > (1u << 24)) break; }
            __builtin_amdgcn_fence(__ATOMIC_ACQUIRE, "agent"); asm volatile("s_waitcnt vmcnt(0)" ::: "memory"); }
        __syncthreads();
    }
    for (; r0 < MT; r0 += NGW * 2) {
        float ss[2];
#pragma unroll
        for (int q = 0; q < 2; ++q) { float s0 = 0.f;
#pragma unroll
            for (int j = 0; j < 4; ++j) s0 += v[q][j].x * v[q][j].x + v[q][j].y * v[q][j].y + v[q][j].z * v[q][j].z + v[q][j].w * v[q][j].w;
            ss[q] = wave_sum(s0); }
        f32x4 nv[2][4]; const int rn = r0 + NGW * 2;
        if (rn < MT) p1_load(p, rn, lane, nv);
#pragma unroll
        for (int q = 0; q < 2; ++q) { const int row = r0 + q; const float rstd = 1.f / sqrtf(ss[q] * (1.f / D) + EPS);
            const float* mv = mod + (size_t)(row < MX ? (row >> 12) : 4) * 6144;
#pragma unroll
            for (int j = 0; j < 4; ++j) { const int k = 4 * lane + 256 * j;
                const f32x4 g = *(const f32x4*)(p.in[6] + k), sh = *(const f32x4*)(mv + k), sc = *(const f32x4*)(mv + 1024 + k);
                const f32x4 o = (v[q][j] * rstd * g) * (sc + 1.f) + sh;
                u32x2 w; w.x = pk2(o.x, o.y); w.y = pk2(o.z, o.w);
                *(u32x2*)(A + (size_t)row * D + k) = w; } }
#pragma unroll
        for (int q = 0; q < 2; ++q)
#pragma unroll
            for (int j = 0; j < 4; ++j) v[q][j] = nv[q][j];
    }
}

#define STGF(fn, k) do { if (STAGE_SEL >= 0 && STAGE_FN == (fn)) { const unsigned long long _n = __builtin_amdgcn_s_memrealtime(); if (STAGE_SEL == (k) || STAGE_SEL == 99) tacc += _n - tprev; tprev = _n; } } while (0)
#define STG_SPIN(fn) do { if (STAGE_SEL >= 0 && STAGE_FN == (fn) && (blockIdx.x == 0 || STAGE_SEL == 99) && threadIdx.x == 0) { const unsigned long long t0 = __builtin_amdgcn_s_memrealtime(); while (__builtin_amdgcn_s_memrealtime() - t0 < tacc * STAGE_K) __builtin_amdgcn_s_sleep(8); } } while (0)
struct ConvItem { int rowbase, y, H, W, x0, valid; };
__device__ __forceinline__ ConvItem conv_item(int it) {
    ConvItem c; const int r = it >> 3; c.valid = it < 2176;
    if (r < 256) { c.rowbase = (r >> 6) * 4096; c.y = r & 63; c.H = 64; c.W = 64; c.x0 = 0; }
    else { const int ci = r - 256; c.rowbase = MX + (ci >> 2) * 256; c.y = 0; c.H = 1; c.W = 256; c.x0 = (ci & 3) * 64; }
    return c;
}
__device__ __forceinline__ void conv_load(const bf16_t* Z, const ConvItem& c, int sl, int tid, u32x4 (&rg)[6], u32x4& halo) {
    const u32x4 z4 = {0u, 0u, 0u, 0u};
#pragma unroll
    for (int i = 0; i < 6; ++i) { const int q = tid + NTHR * i, dy = q >> 10, x = (q >> 4) & 63, cg = q & 15, yy = c.y + dy - 1;
        rg[i] = (c.valid && yy >= 0 && yy < c.H) ? *(const u32x4*)(Z + zoff(c.rowbase + yy * c.W + c.x0 + x, 1536 + sl * 128 + cg * 8)) : z4; }
    halo = z4;
    if (tid < 32 && c.valid) { const int side = tid >> 4, cg = tid & 15, xx = side ? c.x0 + 64 : c.x0 - 1;
        if (xx >= 0 && xx < c.W) halo = *(const u32x4*)(Z + zoff(c.rowbase + c.y * c.W + xx, 1536 + sl * 128 + cg * 8)); }
}
__device__ __forceinline__ void conv_raw_row(const bf16_t* Z, int rowbase, int yy, int H, int W, int x, int coff, u32x4 (&raw)[3]) {
    const u32x4 z4 = {0u, 0u, 0u, 0u};
#pragma unroll
    for (int dx = 0; dx < 3; ++dx) { const int xx = x + dx - 1;
        raw[dx] = (yy >= 0 && yy < H && xx >= 0 && xx < W) ? *(const u32x4*)(Z + zoff(rowbase + yy * W + xx, coff)) : z4; }
}
__device__ __forceinline__ void conv_unpack(const u32x4 (&raw)[3], float (&dst)[3][8]) {
#pragma unroll
    for (int dx = 0; dx < 3; ++dx) { dst[dx][0] = bflo(raw[dx].x); dst[dx][1] = bfhi(raw[dx].x); dst[dx][2] = bflo(raw[dx].y); dst[dx][3] = bfhi(raw[dx].y);
        dst[dx][4] = bflo(raw[dx].z); dst[dx][5] = bfhi(raw[dx].z); dst[dx][6] = bflo(raw[dx].w); dst[dx][7] = bfhi(raw[dx].w); }
}
__device__ __forceinline__ void phase3(const P& p, LAS unsigned char* lds) {
    (void)lds;
    const bf16_t* Z = (const bf16_t*)(p.ws + WS_Z); bf16_t* MQ = (bf16_t*)(p.ws + WS_MQ); bf16_t* MK = (bf16_t*)(p.ws + WS_MK);
    const int tid = threadIdx.x, cg = tid & 15, xl = tid >> 4;
    unsigned long long tacc = 0ull, tprev = (STAGE_SEL >= 0) ? __builtin_amdgcn_s_memrealtime() : 0ull;
    for (int it = blockIdx.x; it < 768; it += gridDim.x) {
        int sl, x, y0, ny, W, H, rowbase;
        if (it < 512) { sl = (it >> 4) & 7; x = ((it >> 3) & 1) * 32 + xl; y0 = (it & 7) * 8; ny = 8; W = 64; H = 64; rowbase = (it >> 7) * 4096; }
        else { const int c = it - 512; sl = (c >> 3) & 7; x = (c & 7) * 32 + xl; y0 = 0; ny = 1; W = 256; H = 1; rowbase = MX + (c >> 6) * 256; }
        const int coff = 1536 + sl * 128 + cg * 8;
        float w[9][8], bias[8];
#pragma unroll
        for (int a = 0; a < 9; ++a) { const f32x4 w0 = *(const f32x4*)(p.in[11] + a * 1024 + sl * 128 + cg * 8), w1 = *(const f32x4*)(p.in[11] + a * 1024 + sl * 128 + cg * 8 + 4);
            w[a][0] = w0.x; w[a][1] = w0.y; w[a][2] = w0.z; w[a][3] = w0.w; w[a][4] = w1.x; w[a][5] = w1.y; w[a][6] = w1.z; w[a][7] = w1.w; }
        { const f32x4 b0 = *(const f32x4*)(p.in[12] + sl * 128 + cg * 8), b1 = *(const f32x4*)(p.in[12] + sl * 128 + cg * 8 + 4);
            bias[0] = b0.x; bias[1] = b0.y; bias[2] = b0.z; bias[3] = b0.w; bias[4] = b1.x; bias[5] = b1.y; bias[6] = b1.z; bias[7] = b1.w; }
        const float osc = sl >= 4 ? 0.08838834764831845f : 1.f;
        bf16_t* dst = (sl >= 4 ? MK : MQ) + (sl & 3) * 128 + cg * 8;
        float win[3][3][8]; u32x4 raw[3];
        conv_raw_row(Z, rowbase, y0 - 1, H, W, x, coff, raw); conv_unpack(raw, win[0]);
        conv_raw_row(Z, rowbase, y0, H, W, x, coff, raw); conv_unpack(raw, win[1]);
        conv_raw_row(Z, rowbase, y0 + 1, H, W, x, coff, raw);
        for (int yi = 0; yi < ny; ++yi) { const int y = y0 + yi;
            conv_unpack(raw, win[2]);
            conv_raw_row(Z, rowbase, y + 2, H, W, x, coff, raw);
            float acc[8];
#pragma unroll
            for (int j = 0; j < 8; ++j) acc[j] = bias[j];
#pragma unroll
            for (int dy = 0; dy < 3; ++dy)
#pragma unroll
                for (int dx = 0; dx < 3; ++dx)
#pragma unroll
                    for (int j = 0; j < 8; ++j) acc[j] += w[dy * 3 + dx][j] * win[dy][dx][j];
#pragma unroll
            for (int j = 0; j < 8; ++j) acc[j] = siluf(acc[j]) * osc;
            u32x4 o; o.x = pk2(acc[0], acc[1]); o.y = pk2(acc[2], acc[3]); o.z = pk2(acc[4], acc[5]); o.w = pk2(acc[6], acc[7]);
            *(u32x4*)(dst + (size_t)(rowbase + y * W + x) * 512) = o;
#pragma unroll
            for (int dx = 0; dx < 3; ++dx)
#pragma unroll
                for (int j = 0; j < 8; ++j) { win[0][dx][j] = win[1][dx][j]; win[1][dx][j] = win[2][dx][j]; }
        }
    }
    STGF(5, 0);
    STG_SPIN(5);
}

__device__ __forceinline__ int chunk_tok0(int b, int tc) { return tc < 64 ? b * SEQ + tc * 64 : MX + b * CTXL + (tc - 64) * 64; }

__device__ __forceinline__ void load_v(const bf16_t* Z, int tok0, int col0, LAS bf16_t* V, int tid) {
#pragma unroll
    for (int i = 0; i < 2; ++i) { const int idx = tid + NTHR * i, t = idx >> 4, c = idx & 15;
        *(LAS u32x4*)(V + t * 136 + c * 8) = *(const u32x4*)(Z + zoff(tok0 + t, col0 + c * 8)); }
}
__device__ __forceinline__ bf16x8 ldfrag_t(const LAS bf16_t* T, int ld, int k0, int n0, int lane) {
#if USE_TR_READ
    typedef short v4s __attribute__((ext_vector_type(4)));
    const int q = (lane >> 2) & 3, pp = lane & 3, g = lane >> 4;
    const LAS bf16_t* a0 = T + (k0 + 8 * (g >> 1) + q) * ld + n0 + 16 * (g & 1) + 4 * pp;
    const v4s lo = __builtin_bit_cast(v4s, __builtin_amdgcn_ds_read_tr16_b64_v4i16((LAS v4s*)a0));
    const v4s hi = __builtin_bit_cast(v4s, __builtin_amdgcn_ds_read_tr16_b64_v4i16((LAS v4s*)(a0 + 4 * ld)));
    bf16x8 f; f[0] = lo[0]; f[1] = lo[1]; f[2] = lo[2]; f[3] = lo[3]; f[4] = hi[0]; f[5] = hi[1]; f[6] = hi[2]; f[7] = hi[3];
    return f;
#else
    const LAS bf16_t* q = T + (k0 + 8 * (lane >> 5)) * ld + n0 + (lane & 31);
    bf16x8 f;
#pragma unroll
    for (int j = 0; j < 8; ++j) f[j] = (short)q[j * ld];
    return f;
#endif
}

__device__ __forceinline__ void gla_gates(const LAS bf16_t* GLRB, LAS float* QS, bf16x8 upf, float upb, int lane, int wave, float (&la)[16], float (&incl)[16], float& all) {
    const int dir = wave >> 2, tt = (wave >> 1) & 1, dt = wave & 1, hh = lane >> 5, d = dt * 32 + (lane & 31);
    f32x16 acc;
#pragma unroll
    for (int r = 0; r < 16; ++r) acc[r] = 0.f;
    acc = MFMA32(*(const LAS bf16x8*)(GLRB + (tt * 32 + (lane & 31)) * 40 + dir * 16 + 8 * hh), upf, acc);
    float ss[4];
#pragma unroll
    for (int rg = 0; rg < 4; ++rg) { ss[rg] = 0.f;
#pragma unroll
        for (int x = 0; x < 4; ++x) { la[4 * rg + x] = logsigf(acc[4 * rg + x] + upb) * 0.0625f; ss[rg] += la[4 * rg + x]; } }
    float ps[4];
#pragma unroll
    for (int rg = 0; rg < 4; ++rg) ps[rg] = __shfl_xor(ss[rg], 32);
    float before[4]; float run = 0.f;
#pragma unroll
    for (int rg = 0; rg < 4; ++rg) { before[rg] = run + (hh ? ps[rg] : 0.f); run += ss[rg] + ps[rg]; }
    if (hh == 0) QS[(dir * 2 + tt) * 64 + d] = run;
    __syncthreads();
    const float t0 = QS[(dir * 2 + 0) * 64 + d], t1 = QS[(dir * 2 + 1) * 64 + d];
    all = t0 + t1; const float base = tt ? t0 : 0.f;
#pragma unroll
    for (int rg = 0; rg < 4; ++rg) { float c = base + before[rg];
#pragma unroll
        for (int x = 0; x < 4; ++x) { c += la[4 * rg + x]; incl[4 * rg + x] = c; } }
}

struct G4Regs { u32x4 v[2]; u32x4 k; f32x4 glr; float upw[8]; float upb; };
struct M4Regs { u32x4 v[2]; u32x4 k[2]; float gi, gf; };
__device__ __forceinline__ void item_bhc(int r, int& b, int& h, int& tc) { b = r / (4 * NCH); h = (r / NCH) & 3; tc = r % NCH; }

__device__ __forceinline__ void g4_load(const P& p, int r, int tid, G4Regs& R) {
    int b, h, tc; item_bhc(r, b, h, tc); const int tok0 = chunk_tok0(b, tc);
    const bf16_t* Z = (const bf16_t*)(p.ws + WS_Z); const float* GT = (const float*)(p.ws + WS_GATES);
#pragma unroll
    for (int i = 0; i < 2; ++i) { const int idx = tid + NTHR * i, t = idx >> 4, c = idx & 15; R.v[i] = *(const u32x4*)(Z + zoff(tok0 + t, 512 + h * 128 + c * 8)); }
    const int t = tid >> 3, c = tid & 7;
    R.glr = *(const f32x4*)(GT + (size_t)(tok0 + t) * 48 + c * 4);
    R.k = *(const u32x4*)(Z + zoff(tok0 + t, 256 + h * 64 + c * 8));
    { const int w = tid >> 6, dir = w >> 2, d = (w & 1) * 32 + (tid & 31), hh = (tid >> 5) & 1;
#pragma unroll
        for (int q = 0; q < 8; ++q) R.upw[q] = p.in[8][(dir * 16 + 8 * hh + q) * 256 + h * 64 + d];
        R.upb = p.in[9][dir * 256 + h * 64 + d]; }
}
__device__ __forceinline__ void p4_gla(const P& p, LAS unsigned char* lds, int r, G4Regs& R, int rnext, unsigned long long& tacc, int qid, int& nn) {
    unsigned long long tprev = (STAGE_SEL >= 0) ? __builtin_amdgcn_s_memrealtime() : 0ull;
    const int tid = threadIdx.x, lane = tid & 63, wave = __builtin_amdgcn_readfirstlane(tid >> 6);
    int b, h, tc; item_bhc(r, b, h, tc);
    const int sidx = (b * 4 + h) * NCH + tc;
    LAS bf16_t* V = (LAS bf16_t*)lds; LAS bf16_t* KW = (LAS bf16_t*)(lds + 17408); LAS bf16_t* GLRB = (LAS bf16_t*)(lds + 35840); LAS float* QS = (LAS float*)(lds + 44032);
    LAS bf16_t* KR = (LAS bf16_t*)(lds + 46080); LAS bf16_t* OUT = (LAS bf16_t*)(lds + 55296);
#pragma unroll
    for (int i = 0; i < 2; ++i) { const int idx = tid + NTHR * i, t = idx >> 4, c = idx & 15; *(LAS u32x4*)(V + t * 136 + c * 8) = R.v[i]; }
    { const int t = tid >> 3, c = tid & 7; u32x2 g; g.x = pk2(R.glr.x, R.glr.y); g.y = pk2(R.glr.z, R.glr.w); *(LAS u32x2*)(GLRB + t * 40 + c * 4) = g; *(LAS u32x4*)(KR + t * 72 + c * 8) = R.k; }
    u32x4 upq; upq.x = pk2(R.upw[0], R.upw[1]); upq.y = pk2(R.upw[2], R.upw[3]); upq.z = pk2(R.upw[4], R.upw[5]); upq.w = pk2(R.upw[6], R.upw[7]);
    const float upb = R.upb;
    __syncthreads();
    STGF(2, 0);
    if (rnext < NSTATE) g4_load(p, rnext, tid, R);
    const int dir = wave >> 2, tt = (wave >> 1) & 1, d = (wave & 1) * 32 + (lane & 31);
    float la[16], incl[16], all;
    gla_gates(GLRB, QS, __builtin_bit_cast(bf16x8, upq), upb, lane, wave, la, incl, all);
    STGF(2, 1);
#pragma unroll
    for (int i = 0; i < 16; ++i) { const int t = tt * 32 + 8 * (i >> 2) + 4 * (lane >> 5) + (i & 3);
        const float kx = bf2f(KR[t * 72 + d]);
        const float e = dir == 0 ? all - incl[i] : incl[i] - la[i];
        KW[(dir * 64 + t) * 72 + d] = (bf16_t)f2bf(kx * __expf(e)); }
    const int tq = tt * 2 + (lane >> 5);
    if (tq == 0) ((float*)(p.ws + WS_GDEC))[(sidx * 2 + dir) * 64 + d] = __expf(all);
    __syncthreads();
    STGF(2, 2);
    const int dw = wave >> 2, vt = wave & 3;
    f32x16 acc0, acc1;
#pragma unroll
    for (int q = 0; q < 16; ++q) { acc0[q] = 0.f; acc1[q] = 0.f; }
#pragma unroll
    for (int ks = 0; ks < 4; ++ks) { const bf16x8 vb = ldfrag_t(V, 136, ks * 16, vt * 32, lane);
        const bf16x8 a0 = ldfrag_t(KW + dw * 64 * 72, 72, ks * 16, 0, lane), a1 = ldfrag_t(KW + dw * 64 * 72, 72, ks * 16, 32, lane);
        acc0 = MFMA32(a0, vb, acc0); acc1 = MFMA32(a1, vb, acc1); }
    { LAS unsigned char* orow = (LAS unsigned char*)OUT + (dw * 128 + vt * 32 + (lane & 31)) * 80 + 4 * (lane >> 5);
#pragma unroll
        for (int rg = 0; rg < 4; ++rg) {
            *(LAS unsigned*)(orow + 8 * rg) = pk4_fp8(acc0[4 * rg] * SG_SCALE, acc0[4 * rg + 1] * SG_SCALE, acc0[4 * rg + 2] * SG_SCALE, acc0[4 * rg + 3] * SG_SCALE);
            *(LAS unsigned*)(orow + 32 + 8 * rg) = pk4_fp8(acc1[4 * rg] * SG_SCALE, acc1[4 * rg + 1] * SG_SCALE, acc1[4 * rg + 2] * SG_SCALE, acc1[4 * rg + 3] * SG_SCALE); } }
    __syncthreads();
    STGF(2, 3);
    unsigned char* U = (unsigned char*)(p.ws + WS_UG) + (size_t)(sidx * 2) * 8192;
#pragma unroll
    for (int i = 0; i < 2; ++i) { const int idx = tid + NTHR * i, row = idx >> 2, c = idx & 3; *(u32x4*)(U + (size_t)row * 64 + c * 16) = *(const LAS u32x4*)((const LAS unsigned char*)OUT + row * 80 + c * 16); }
    if (threadIdx.x == 0) *(LAS int*)(lds + LDS_NQ) = (int)gridDim.x + qid;
    __syncthreads();
    nn = *(const LAS int*)(lds + LDS_NQ);
    STGF(2, 4);
}

__device__ __forceinline__ void m4_load(const P& p, int r, int tid, M4Regs& R) {
    int b, h, tc; item_bhc(r, b, h, tc); const int tok0 = chunk_tok0(b, tc);
    const bf16_t* Z = (const bf16_t*)(p.ws + WS_Z); const bf16_t* MK = (const bf16_t*)(p.ws + WS_MK);
#pragma unroll
    for (int i = 0; i < 2; ++i) { const int idx = tid + NTHR * i, t = idx >> 4, c = idx & 15;
        R.v[i] = *(const u32x4*)(Z + zoff(tok0 + t, 2560 + h * 128 + c * 8));
        R.k[i] = *(const u32x4*)(MK + (size_t)(tok0 + t) * 512 + h * 128 + c * 8); }
    R.gi = 0.f; R.gf = 0.f;
    if (tid < 128) { const int dir = tid >> 6, t = tid & 63; const float* g = (const float*)(p.ws + WS_GATES) + (size_t)(tok0 + t) * 48; R.gi = g[32 + dir * 4 + h] + p.in[13][dir * 4 + h]; R.gf = g[40 + dir * 4 + h] + p.in[14][dir * 4 + h]; }
}
__device__ __forceinline__ void p4_ml(const P& p, LAS unsigned char* lds, int r, M4Regs& R, int rnext, unsigned long long& tacc, int qid, int& nn) {
    unsigned long long tprev = (STAGE_SEL >= 0) ? __builtin_amdgcn_s_memrealtime() : 0ull;
    const int tid = threadIdx.x, lane = tid & 63, wave = __builtin_amdgcn_readfirstlane(tid >> 6);
    int b, h, tc; item_bhc(r, b, h, tc);
    const int sidx = (b * 4 + h) * NCH + tc;
    LAS bf16_t* V = (LAS bf16_t*)lds; LAS bf16_t* KW = (LAS bf16_t*)(lds + 17408);
    LAS float* KG = (LAS float*)(lds + 52224) + 256;
    LAS bf16_t* KR = (LAS bf16_t*)(lds + 53760); LAS bf16_t* OUT = (LAS bf16_t*)(lds + 71168); LAS float* NP = (LAS float*)(lds + 144384);
#pragma unroll
    for (int i = 0; i < 2; ++i) { const int idx = tid + NTHR * i, t = idx >> 4, c = idx & 15; *(LAS u32x4*)(V + t * 136 + c * 8) = R.v[i]; *(LAS u32x4*)(KR + t * 136 + c * 8) = R.k[i]; }
    if (tid < 128) { const int dir = tid >> 6, t = tid & 63;
        const float ig = R.gi, lf = logsigf(R.gf), a = scan_sum_up(lf, t), tot = __shfl(a, 63);
        const float g = (dir == 0 ? tot - a : a - lf) + ig;
        const float ml = wave_max(g);
        KG[dir * 64 + t] = __expf(g - ml);
        if (t == 0) { float* sc = (float*)(p.ws + WS_MSC) + (size_t)(sidx * 2 + dir) * 4; sc[0] = tot; sc[1] = ml; } }
    __syncthreads();
    STGF(3, 0);
    if (rnext < NSTATE) m4_load(p, rnext, tid, R);
    STGF(3, 1);
    { const int dir = tid >> 8, tq = (tid >> 4) & 15, c = tid & 15;
        const f32x4 kg = *(const LAS f32x4*)(KG + dir * 64 + tq * 4);
        float ns[8];
#pragma unroll
        for (int j = 0; j < 8; ++j) ns[j] = 0.f;
#pragma unroll
        for (int i = 0; i < 4; ++i) { const int t = tq * 4 + i; const u32x4 kr = *(const LAS u32x4*)(KR + t * 136 + c * 8); const float g = kg[i];
            u32x4 o; o.x = pk2(bflo(kr.x) * g, bfhi(kr.x) * g); o.y = pk2(bflo(kr.y) * g, bfhi(kr.y) * g); o.z = pk2(bflo(kr.z) * g, bfhi(kr.z) * g); o.w = pk2(bflo(kr.w) * g, bfhi(kr.w) * g);
            *(LAS u32x4*)(KW + (dir * 64 + t) * 136 + c * 8) = o;
            ns[0] += bflo(o.x); ns[1] += bfhi(o.x); ns[2] += bflo(o.y); ns[3] += bfhi(o.y); ns[4] += bflo(o.z); ns[5] += bfhi(o.z); ns[6] += bflo(o.w); ns[7] += bfhi(o.w); }
        LAS float* np = NP + (dir * 16 + tq) * 128 + c * 8;
        *(LAS f32x4*)np = (f32x4){ns[0], ns[1], ns[2], ns[3]}; *(LAS f32x4*)(np + 4) = (f32x4){ns[4], ns[5], ns[6], ns[7]}; }
    __syncthreads();
    STGF(3, 2);
    if (tid < 256) { const int dir = tid >> 7, d = tid & 127; float a = 0.f;
#pragma unroll
        for (int q = 0; q < 16; ++q) a += NP[(dir * 16 + q) * 128 + d];
        ((float*)(p.ws + WS_MN))[(size_t)(sidx * 2 + dir) * 128 + d] = a; }
    const int dw = wave >> 2, vt = wave & 3;
    f32x16 acc[4];
#pragma unroll
    for (int q = 0; q < 4; ++q)
#pragma unroll
        for (int x = 0; x < 16; ++x) acc[q][x] = 0.f;
#pragma unroll
    for (int ks = 0; ks < 4; ++ks) { const bf16x8 vb = ldfrag_t(V, 136, ks * 16, vt * 32, lane);
#pragma unroll
        for (int q = 0; q < 4; ++q) { const bf16x8 aq = ldfrag_t(KW + dw * 64 * 136, 136, ks * 16, q * 32, lane); acc[q] = MFMA32(aq, vb, acc[q]); } }
    { LAS unsigned char* orow = (LAS unsigned char*)OUT + (dw * 128 + vt * 32 + (lane & 31)) * 144 + 4 * (lane >> 5);
#pragma unroll
        for (int q = 0; q < 4; ++q)
#pragma unroll
            for (int rg = 0; rg < 4; ++rg) *(LAS unsigned*)(orow + q * 32 + 8 * rg) = pk4_fp8(acc[q][4 * rg] * SM_SCALE, acc[q][4 * rg + 1] * SM_SCALE, acc[q][4 * rg + 2] * SM_SCALE, acc[q][4 * rg + 3] * SM_SCALE); }
    __syncthreads();
    STGF(3, 3);
    unsigned char* U = (unsigned char*)(p.ws + WS_UM) + (size_t)(sidx * 2) * 16384;
#pragma unroll
    for (int i = 0; i < 4; ++i) { const int idx = tid + NTHR * i, row = idx >> 3, c = idx & 7; *(u32x4*)(U + (size_t)row * 128 + c * 16) = *(const LAS u32x4*)((const LAS unsigned char*)OUT + row * 144 + c * 16); }
    if (threadIdx.x == 0) *(LAS int*)(lds + LDS_NQ) = (int)gridDim.x + qid;
    __syncthreads();
    nn = *(const LAS int*)(lds + LDS_NQ);
    STGF(3, 4);
}

#define DYN_LOOP_R(RV, PRE, LOADFN, ITEMFN, NITEMS, QW, FN) do { unsigned long long tacc = 0ull; unsigned* Qh = (unsigned*)(p.ws + WS_CTL) + CW_Q + 64 * (QW); LAS int* NQ = (LAS int*)(lds + LDS_NQ); \
        const int G_ = gridDim.x; int cur = blockIdx.x; unsigned qv = 0u; \
        if (tid == 0) qv = __hip_atomic_fetch_add(Qh, 1u, __ATOMIC_RELAXED, __HIP_MEMORY_SCOPE_AGENT); \
        if (!(PRE) && cur < (NITEMS)) LOADFN(p, cur, tid, RV); \
        if (tid == 0) NQ[0] = G_ + (int)qv; \
        __syncthreads(); \
        int nxt = NQ[0]; \
        while (cur < (NITEMS)) { int q2 = 0; if (tid == 0) q2 = (int)__builtin_amdgcn_atomic_inc32(Qh, 0x7fffffffu, __ATOMIC_RELAXED, "agent");   \
            int nn; ITEMFN(p, lds, cur, RV, nxt, tacc, q2, nn); cur = nxt; nxt = nn; } \
        STG_SPIN(FN); } while (0)
#define DYN_LOOP(REGS, LOADFN, ITEMFN, NITEMS, QW, FN) do { REGS R; DYN_LOOP_R(R, false, LOADFN, ITEMFN, NITEMS, QW, FN); } while (0)

__device__ __forceinline__ void phase4_gla(const P& p, LAS unsigned char* lds) {
    const int tid = threadIdx.x;
    DYN_LOOP(G4Regs, g4_load, p4_gla, NSTATE, 0, 2);
}
__device__ __forceinline__ void phase4_ml(const P& p, LAS unsigned char* lds) {
    const int tid = threadIdx.x;
    DYN_LOOP(M4Regs, m4_load, p4_ml, NSTATE, 1, 3);
}

__device__ __forceinline__ int tc_of(int c, int dir) { return dir == 0 ? (c < 4 ? 64 + c : c - 4) : (c < 4 ? 67 - c : 67 - c); }

__device__ __forceinline__ void phase5(const P& p, LAS unsigned char* lds) {
    const int lane = threadIdx.x & 63, wv = threadIdx.x >> 6;
    const int gtid = (wv * gridDim.x + blockIdx.x) * 64 + lane, nthr = gridDim.x * NTHR;
    constexpr int PFS = P5_PF, PFN = 12;
    LAS float* WT = (LAS float*)(lds + wv * 17408);
    for (int task = gtid; task < 32768 + 65536 + 512; task += nthr) {
        int ln = threadIdx.x & 63; asm volatile("" : "+v"(ln));
        if (task < 32768) {
            const int chain = task >> 10, e8 = task & 1023, bh = chain >> 1, dir = chain & 1, d0 = (e8 & 7) * 8;
            unsigned char* UG = (unsigned char*)(p.ws + WS_UG); const float* GD = (const float*)(p.ws + WS_GDEC);
            asm volatile("s_waitcnt lgkmcnt(0)" ::: "memory");
#pragma unroll
            for (int c4 = 0; c4 < 17; ++c4) { const int c = c4 * 4 + (ln >> 4), si = (bh * NCH + tc_of(c, dir)) * 2 + dir;
                *(LAS f32x4*)(WT + c * 64 + (ln & 15) * 4) = *(const f32x4*)(GD + si * 64 + (ln & 15) * 4); }
            asm volatile("s_waitcnt lgkmcnt(0)" ::: "memory");
            float s[8];
#pragma unroll
            for (int j = 0; j < 8; ++j) s[j] = 0.f;
            u32x2 ub[PFS];
#pragma unroll
            for (int i = 0; i < PFS; ++i) { const int si = (bh * NCH + tc_of(i, dir)) * 2 + dir;
                ub[i] = __builtin_nontemporal_load((const u32x2*)(UG + (size_t)si * 8192 + e8 * 8)); }
            for (int c0 = 0; c0 < NCH; c0 += PFS) {
#pragma unroll
                for (int i = 0; i < PFS; ++i) { const int c = c0 + i; if (c < NCH) { const int si = (bh * NCH + tc_of(c, dir)) * 2 + dir;
                    const u32x2 u = ub[i]; const f32x4 a = *(const LAS f32x4*)(WT + c * 64 + d0), bq = *(const LAS f32x4*)(WT + c * 64 + d0 + 4);
                    if (c + PFS < NCH) { const int sn = (bh * NCH + tc_of(c + PFS, dir)) * 2 + dir;
                        ub[i] = __builtin_nontemporal_load((const u32x2*)(UG + (size_t)sn * 8192 + e8 * 8)); }
                    u32x2 o; o.x = pk4_fp8(s[0], s[1], s[2], s[3]); o.y = pk4_fp8(s[4], s[5], s[6], s[7]);
                    *(u32x2*)(UG + (size_t)si * 8192 + e8 * 8) = o;
                    float ua[4], uc[4]; up4_fp8(u.x, ua); up4_fp8(u.y, uc);
                    s[0] = a.x * s[0] + ua[0]; s[1] = a.y * s[1] + ua[1]; s[2] = a.z * s[2] + ua[2]; s[3] = a.w * s[3] + ua[3];
                    s[4] = bq.x * s[4] + uc[0]; s[5] = bq.y * s[5] + uc[1]; s[6] = bq.z * s[6] + uc[2]; s[7] = bq.w * s[7] + uc[3]; } }
            }
        } else if (task < 98304) {
            const int tk = task - 32768, chain = tk >> 11, e8 = tk & 2047, bh = chain >> 1, dir = chain & 1;
            unsigned char* UM = (unsigned char*)(p.ws + WS_UM); float* SC = (float*)(p.ws + WS_MSC);
            asm volatile("s_waitcnt lgkmcnt(0)" ::: "memory");
            { const int si = (bh * NCH + tc_of(ln, dir)) * 2 + dir; const f32x2 sv = *(const f32x2*)(SC + si * 4); *(LAS f32x2*)(WT + ln * 2) = sv;
              if (ln < 4) { const int s2 = (bh * NCH + tc_of(64 + ln, dir)) * 2 + dir; const f32x2 s3 = *(const f32x2*)(SC + s2 * 4); *(LAS f32x2*)(WT + (64 + ln) * 2) = s3; } }
            asm volatile("s_waitcnt lgkmcnt(0)" ::: "memory");
            float s[8];
#pragma unroll
            for (int j = 0; j < 8; ++j) s[j] = 0.f;
            float m = 0.f;
            u32x2 ub[PFS];
#pragma unroll
            for (int i = 0; i < PFS; ++i) { const int si = (bh * NCH + tc_of(i, dir)) * 2 + dir;
                ub[i] = __builtin_nontemporal_load((const u32x2*)(UM + (size_t)si * 16384 + e8 * 8)); }
            for (int c0 = 0; c0 < NCH; c0 += PFS) {
#pragma unroll
                for (int i = 0; i < PFS; ++i) { const int c = c0 + i; if (c < NCH) { const int si = (bh * NCH + tc_of(c, dir)) * 2 + dir;
                    const u32x2 u = ub[i]; const f32x2 am = *(const LAS f32x2*)(WT + c * 2); const float aend = am.x, mloc = am.y;
                    if (c + PFS < NCH) { const int sn = (bh * NCH + tc_of(c + PFS, dir)) * 2 + dir;
                        ub[i] = __builtin_nontemporal_load((const u32x2*)(UM + (size_t)sn * 16384 + e8 * 8)); }
                    u32x2 o; o.x = pk4_fp8(s[0], s[1], s[2], s[3]); o.y = pk4_fp8(s[4], s[5], s[6], s[7]);
                    *(u32x2*)(UM + (size_t)si * 16384 + e8 * 8) = o;
                    if (e8 == 0) SC[si * 4 + 2] = m;
                    const float mn = fmaxf(aend + m, mloc), f1 = __expf(aend + m - mn), f2 = __expf(mloc - mn); m = mn;
                    float ua[4], uc[4]; up4_fp8(u.x, ua); up4_fp8(u.y, uc);
                    s[0] = f1 * s[0] + f2 * ua[0]; s[1] = f1 * s[1] + f2 * ua[1]; s[2] = f1 * s[2] + f2 * ua[2]; s[3] = f1 * s[3] + f2 * ua[3];
                    s[4] = f1 * s[4] + f2 * uc[0]; s[5] = f1 * s[5] + f2 * uc[1]; s[6] = f1 * s[6] + f2 * uc[2]; s[7] = f1 * s[7] + f2 * uc[3]; } }
            }
        } else {
            const int tk = task - 98304, chain = tk >> 4, part = tk & 15, bh = chain >> 1, dir = chain & 1;
            float* MN = (float*)(p.ws + WS_MN); const float* SC = (const float*)(p.ws + WS_MSC);
            f32x4 n0 = {0.f, 0.f, 0.f, 0.f}, n1 = {0.f, 0.f, 0.f, 0.f}; float m = 0.f;
            f32x4 p0[PFN], p1[PFN]; float ae[PFN], ml[PFN];
#pragma unroll
            for (int i = 0; i < PFN; ++i) { const int si = (bh * NCH + tc_of(i, dir)) * 2 + dir; const float* np = MN + (size_t)si * 128 + part * 8;
                p0[i] = *(const f32x4*)np; p1[i] = *(const f32x4*)(np + 4); ae[i] = SC[si * 4 + 0]; ml[i] = SC[si * 4 + 1]; }
            for (int c0 = 0; c0 < NCH; c0 += PFN) {
#pragma unroll
                for (int i = 0; i < PFN; ++i) { const int c = c0 + i; if (c < NCH) { const int si = (bh * NCH + tc_of(c, dir)) * 2 + dir;
                    const f32x4 u0 = p0[i], u1 = p1[i]; const float aend = ae[i], mloc = ml[i];
                    if (c + PFN < NCH) { const int sn = (bh * NCH + tc_of(c + PFN, dir)) * 2 + dir; const float* nq = MN + (size_t)sn * 128 + part * 8;
                        p0[i] = *(const f32x4*)nq; p1[i] = *(const f32x4*)(nq + 4); ae[i] = SC[sn * 4 + 0]; ml[i] = SC[sn * 4 + 1]; }
                    float* np = MN + (size_t)si * 128 + part * 8;
                    *(f32x4*)np = n0; *(f32x4*)(np + 4) = n1;
                    const float mn = fmaxf(aend + m, mloc), f1 = __expf(aend + m - mn), f2 = __expf(mloc - mn); m = mn;
                    n0 = n0 * f1 + u0 * f2; n1 = n1 * f1 + u1 * f2; } }
            }
        }
    }
}

template <bool SIG>
__device__ __forceinline__ void head_norm_store(const P& p, const LAS float* O, const LAS bf16_t* GTt, const LAS float* GN, int tok0, int h, int mixcol, int tid) {
    bf16_t* MIX = (bf16_t*)(p.ws + WS_A);
    const int t = tid >> 3, seg = tid & 7;
    float o[16]; float ss = 0.f;
#pragma unroll
    for (int j = 0; j < 16; ++j) { o[j] = O[t * 132 + seg * 16 + j]; ss += o[j] * o[j]; }
    ss += __shfl_xor(ss, 1); ss += __shfl_xor(ss, 2); ss += __shfl_xor(ss, 4);
    const float rstd = __builtin_amdgcn_rsqf(ss * (1.f / 128.f) + EPS);
    const u32x4 g0 = *(const LAS u32x4*)(GTt + t * 128 + seg * 16), g1 = *(const LAS u32x4*)(GTt + t * 128 + seg * 16 + 8);
    float gt[16];
    gt[0] = bflo(g0.x); gt[1] = bfhi(g0.x); gt[2] = bflo(g0.y); gt[3] = bfhi(g0.y); gt[4] = bflo(g0.z); gt[5] = bfhi(g0.z); gt[6] = bflo(g0.w); gt[7] = bfhi(g0.w);
    gt[8] = bflo(g1.x); gt[9] = bfhi(g1.x); gt[10] = bflo(g1.y); gt[11] = bfhi(g1.y); gt[12] = bflo(g1.z); gt[13] = bfhi(g1.z); gt[14] = bflo(g1.w); gt[15] = bfhi(g1.w);
    float r[16];
#pragma unroll
    for (int j = 0; j < 16; ++j) { const float gg = SIG ? sigmf(gt[j]) : siluf(gt[j]); r[j] = o[j] * rstd * GN[seg * 16 + j] * gg; }
    u32x4 w0, w1; w0.x = pk2(r[0], r[1]); w0.y = pk2(r[2], r[3]); w0.z = pk2(r[4], r[5]); w0.w = pk2(r[6], r[7]);
    w1.x = pk2(r[8], r[9]); w1.y = pk2(r[10], r[11]); w1.z = pk2(r[12], r[13]); w1.w = pk2(r[14], r[15]);
    bf16_t* dst = MIX + (size_t)(tok0 + t) * D + mixcol + h * 128 + seg * 16;
    *(u32x4*)dst = w0; *(u32x4*)(dst + 8) = w1;
}
__device__ __forceinline__ void load_gate_tile(const P& p, int tok0, int gcol, int h, const float* gain, LAS bf16_t* GTt, LAS float* GN, int tid) {
    const bf16_t* Z = (const bf16_t*)(p.ws + WS_Z);
#pragma unroll
    for (int i = 0; i < 2; ++i) { const int idx = tid + NTHR * i, t = idx >> 4, c = idx & 15;
        *(LAS u32x4*)(GTt + t * 128 + c * 8) = *(const u32x4*)(Z + zoff(tok0 + t, gcol + h * 128 + c * 8)); }
    if (tid < 32) *(LAS f32x4*)(GN + tid * 4) = *(const f32x4*)(gain + h * 128 + tid * 4);
}

struct G6Regs { u32x4 v[2]; u32x4 gt[2]; u32x4 q, k; f32x4 glr, gn; float upw[8]; float upb; };
struct M6Regs { u32x4 q[2], k[2], v[2]; u32x4 gt[2]; f32x4 gn; float gi, gf, nv, ms; };
__device__ __forceinline__ void item_bhj(int it, int& b, int& h, int& j) { b = it >> 8; h = (it >> 6) & 3; j = it & 63; }

__device__ __forceinline__ void g6_load(const P& p, int it, int tid, G6Regs& R) {
    int b, h, j; item_bhj(it, b, h, j); const int tok0 = b * SEQ + j * 64;
    const bf16_t* Z = (const bf16_t*)(p.ws + WS_Z); const float* GT = (const float*)(p.ws + WS_GATES);
#pragma unroll
    for (int i = 0; i < 2; ++i) { const int idx = tid + NTHR * i, t = idx >> 4, c = idx & 15;
        R.v[i] = *(const u32x4*)(Z + zoff(tok0 + t, 512 + h * 128 + c * 8));
        R.gt[i] = *(const u32x4*)(Z + zoff(tok0 + t, 1024 + h * 128 + c * 8)); }
    const int t = tid >> 3, c = tid & 7;
    R.q = *(const u32x4*)(Z + zoff(tok0 + t, h * 64 + c * 8));
    R.k = *(const u32x4*)(Z + zoff(tok0 + t, 256 + h * 64 + c * 8));
    R.glr = *(const f32x4*)(GT + (size_t)(tok0 + t) * 48 + c * 4);
    R.gn = *(const f32x4*)(p.in[10] + h * 128 + (tid & 31) * 4);
    { const int w = tid >> 6, dir = w >> 2, d = (w & 1) * 32 + (tid & 31), hh = (tid >> 5) & 1;
#pragma unroll
        for (int q = 0; q < 8; ++q) R.upw[q] = p.in[8][(dir * 16 + 8 * hh + q) * 256 + h * 64 + d];
        R.upb = p.in[9][dir * 256 + h * 64 + d]; }
}
__device__ __forceinline__ void p6_gla(const P& p, LAS unsigned char* lds, int it, G6Regs& R, int itnext, unsigned long long& tacc, int qid, int& nn) {
    unsigned long long tprev = (STAGE_SEL >= 0) ? __builtin_amdgcn_s_memrealtime() : 0ull;
    const int tid = threadIdx.x, lane = tid & 63, wave = __builtin_amdgcn_readfirstlane(tid >> 6);
    int b, h, j; item_bhj(it, b, h, j);
    const int tok0 = b * SEQ + j * 64;
    LAS bf16_t* QF = (LAS bf16_t*)lds; LAS bf16_t* QB = QF + 64 * 72; LAS bf16_t* KF = QB + 64 * 72; LAS bf16_t* KB = KF + 64 * 72;
    LAS bf16_t* VT = (LAS bf16_t*)(lds + 36864); LAS bf16_t* ST = (LAS bf16_t*)(lds + 55296); LAS bf16_t* PF = (LAS bf16_t*)(lds + 92160); LAS bf16_t* PB = PF + 64 * 72;
    LAS bf16_t* GLRB = (LAS bf16_t*)(lds + 110592); LAS float* QS = (LAS float*)(lds + 118784); LAS float* O = (LAS float*)lds;
    LAS bf16_t* GTt = (LAS bf16_t*)(lds + 120832); LAS float* GN = (LAS float*)(lds + 137216); LAS bf16_t* QR = (LAS bf16_t*)(lds + 137728); LAS bf16_t* KR = (LAS bf16_t*)(lds + 146944);
    u32x4 stc[2];
    { const unsigned char* S = (const unsigned char*)(p.ws + WS_UG) + (size_t)(((b * 4 + h) * NCH + j) * 2) * 8192;
#pragma unroll
        for (int i = 0; i < 2; ++i) { const int idx = tid + NTHR * i, row = idx >> 2, c = idx & 3; stc[i] = __builtin_nontemporal_load((const u32x4*)(S + (size_t)row * 64 + c * 16)); } }
#pragma unroll
    for (int i = 0; i < 2; ++i) { const int idx = tid + NTHR * i, t = idx >> 4, c = idx & 15; *(LAS u32x4*)(VT + t * 136 + c * 8) = R.v[i]; *(LAS u32x4*)(GTt + t * 128 + c * 8) = R.gt[i]; }
    { const int t = tid >> 3, c = tid & 7; *(LAS u32x4*)(QR + t * 72 + c * 8) = R.q; *(LAS u32x4*)(KR + t * 72 + c * 8) = R.k;
        u32x2 g; g.x = pk2(R.glr.x, R.glr.y); g.y = pk2(R.glr.z, R.glr.w); *(LAS u32x2*)(GLRB + t * 40 + c * 4) = g; }
    if (tid < 32) *(LAS f32x4*)(GN + tid * 4) = R.gn;
    u32x4 upq; upq.x = pk2(R.upw[0], R.upw[1]); upq.y = pk2(R.upw[2], R.upw[3]); upq.z = pk2(R.upw[4], R.upw[5]); upq.w = pk2(R.upw[6], R.upw[7]);
    const float upb = R.upb;
    __syncthreads();
    STGF(1, 0);
    if (itnext < 1024) g6_load(p, itnext, tid, R);
    {
        const int dir = wave >> 2, tt = (wave >> 1) & 1, d = (wave & 1) * 32 + (lane & 31);
        float la[16], incl[16], all;
        gla_gates(GLRB, QS, __builtin_bit_cast(bf16x8, upq), upb, lane, wave, la, incl, all);
        STGF(1, 1);
        LAS bf16_t* Qd = dir == 0 ? QF : QB; LAS bf16_t* Kd = dir == 0 ? KF : KB;
#pragma unroll
        for (int i = 0; i < 16; ++i) { const int t = tt * 32 + 8 * (i >> 2) + 4 * (lane >> 5) + (i & 3);
            const float qx = bf2f(QR[t * 72 + d]) * 0.125f, kx = bf2f(KR[t * 72 + d]);
            const float bb = dir == 0 ? incl[i] : all - (incl[i] - la[i]);
            const float eb = __expf(bb);
            Qd[t * 72 + d] = (bf16_t)f2bf(qx * eb); Kd[t * 72 + d] = (bf16_t)f2bf(kx * rcpf(eb)); }
    }
    __syncthreads();
    STGF(1, 2);
    {
        const int dw = wave >> 2, tt = (wave >> 1) & 1, st = wave & 1;
        const LAS bf16_t* Qd = dw == 0 ? QF : QB; const LAS bf16_t* Kd = dw == 0 ? KF : KB; LAS bf16_t* Pd = dw == 0 ? PF : PB;
        f32x16 acc;
#pragma unroll
        for (int r = 0; r < 16; ++r) acc[r] = 0.f;
#pragma unroll
        for (int ks = 0; ks < 4; ++ks) acc = MFMA32(ldfrag(Kd, 72, st * 32, ks * 16, lane), ldfrag(Qd, 72, tt * 32, ks * 16, lane), acc);
        const int t = tt * 32 + (lane & 31);
#pragma unroll
        for (int rg = 0; rg < 4; ++rg) { const int sb = st * 32 + 8 * rg + 4 * (lane >> 5); float v[4];
#pragma unroll
            for (int x = 0; x < 4; ++x) { const int s1 = sb + x; const bool ok = dw == 0 ? (s1 <= t) : (s1 >= t); v[x] = ok ? acc[4 * rg + x] : 0.f; }
            u32x2 w; w.x = pk2(v[0], v[1]); w.y = pk2(v[2], v[3]); *(LAS u32x2*)(Pd + t * 72 + sb) = w; }
    }
#pragma unroll
    for (int i = 0; i < 2; ++i) { const int idx = tid + NTHR * i, row = idx >> 2, c = idx & 3; const u32x4 w = stc[i];
        *(LAS u32x4*)(ST + row * 72 + c * 16) = fp8x8_to_bf16((u32x2){w.x, w.y}, 1.f / SG_SCALE); *(LAS u32x4*)(ST + row * 72 + c * 16 + 8) = fp8x8_to_bf16((u32x2){w.z, w.w}, 1.f / SG_SCALE); }
    __syncthreads();
    STGF(1, 3);
    const int tt = wave >> 2, vt = wave & 3;
    f32x16 acc;
#pragma unroll
    for (int r = 0; r < 16; ++r) acc[r] = 0.f;
#pragma unroll
    for (int ks = 0; ks < 4; ++ks) { const bf16x8 va = ldfrag_t(VT, 136, ks * 16, vt * 32, lane);
        acc = MFMA32(va, ldfrag(PF, 72, tt * 32, ks * 16, lane), acc); acc = MFMA32(va, ldfrag(PB, 72, tt * 32, ks * 16, lane), acc); }
#pragma unroll
    for (int ks = 0; ks < 4; ++ks) { acc = MFMA32(ldfrag(ST, 72, vt * 32, ks * 16, lane), ldfrag(QF, 72, tt * 32, ks * 16, lane), acc);
        acc = MFMA32(ldfrag(ST + 128 * 72, 72, vt * 32, ks * 16, lane), ldfrag(QB, 72, tt * 32, ks * 16, lane), acc); }
    __syncthreads();
    STGF(1, 4);
    { LAS float* orow = O + (tt * 32 + (lane & 31)) * 132 + vt * 32 + 4 * (lane >> 5);
#pragma unroll
        for (int rg = 0; rg < 4; ++rg) *(LAS f32x4*)(orow + 8 * rg) = (f32x4){acc[4 * rg], acc[4 * rg + 1], acc[4 * rg + 2], acc[4 * rg + 3]}; }
    __syncthreads();
    STGF(1, 5);
    head_norm_store<false>(p, O, GTt, GN, tok0, h, 0, tid);
    if (threadIdx.x == 0) *(LAS int*)(lds + LDS_NQ) = (int)gridDim.x + qid;
    __syncthreads();
    nn = *(const LAS int*)(lds + LDS_NQ);
    STGF(1, 6);
}

__device__ __forceinline__ void m6_load(const P& p, int it, int tid, M6Regs& R) {
    int b, h, j; item_bhj(it, b, h, j); const int tok0 = b * SEQ + j * 64, sidx = (b * 4 + h) * NCH + j;
    const bf16_t* Z = (const bf16_t*)(p.ws + WS_Z); const bf16_t* MQ = (const bf16_t*)(p.ws + WS_MQ); const bf16_t* MK = (const bf16_t*)(p.ws + WS_MK);
#pragma unroll
    for (int i = 0; i < 2; ++i) { const int idx = tid + NTHR * i, t = idx >> 4, c = idx & 15;
        R.q[i] = *(const u32x4*)(MQ + (size_t)(tok0 + t) * 512 + h * 128 + c * 8);
        R.k[i] = *(const u32x4*)(MK + (size_t)(tok0 + t) * 512 + h * 128 + c * 8);
        R.v[i] = *(const u32x4*)(Z + zoff(tok0 + t, 2560 + h * 128 + c * 8));
        R.gt[i] = *(const u32x4*)(Z + zoff(tok0 + t, 3072 + h * 128 + c * 8)); }
    R.gn = *(const f32x4*)(p.in[15] + h * 128 + (tid & 31) * 4);
    R.gi = 0.f; R.gf = 0.f; R.nv = 0.f; R.ms = 0.f;
    if (tid < 128) { const int dir = tid >> 6, t = tid & 63; const float* g = (const float*)(p.ws + WS_GATES) + (size_t)(tok0 + t) * 48; R.gi = g[32 + dir * 4 + h] + p.in[13][dir * 4 + h]; R.gf = g[40 + dir * 4 + h] + p.in[14][dir * 4 + h];
        R.ms = ((const float*)(p.ws + WS_MSC))[(size_t)(sidx * 2 + dir) * 4 + 2]; }
    else if (tid < 384) R.nv = ((const float*)(p.ws + WS_MN))[(size_t)(sidx * 2) * 128 + (tid - 128)];
}
__device__ __forceinline__ void p6_ml(const P& p, LAS unsigned char* lds, int it, M6Regs& R, int itnext, unsigned long long& tacc, int qid, int& nn) {
    unsigned long long tprev = (STAGE_SEL >= 0) ? __builtin_amdgcn_s_memrealtime() : 0ull;
    const int tid = threadIdx.x, lane = tid & 63, wave = __builtin_amdgcn_readfirstlane(tid >> 6);
    int b, h, j; item_bhj(it, b, h, j);
    const int tok0 = b * SEQ + j * 64;
    LAS bf16_t* Q = (LAS bf16_t*)lds; LAS bf16_t* K = (LAS bf16_t*)(lds + 17408); LAS bf16_t* VT = (LAS bf16_t*)(lds + 34816); LAS bf16_t* ST = (LAS bf16_t*)(lds + 53248);
    LAS bf16_t* PF = (LAS bf16_t*)(lds + 122880); LAS bf16_t* PB = PF + 64 * 72; LAS float* SM = (LAS float*)(lds + 141312); LAS float* O = (LAS float*)lds;
    LAS float* IG = SM; LAS float* LF = SM + 128; LAS float* CT = SM + 256; LAS float* RT = SM + 384; LAS float* WT = SM + 512; LAS float* ET = SM + 640;
    LAS float* NV = SM + 768;
    LAS float* INV = SM + 1024;
    LAS float* MS = SM + 1152;
    LAS bf16_t* GTt = (LAS bf16_t*)(lds + 146432); LAS float* GN = (LAS float*)(lds + 162816);
    u32x4 stc[4];
    { const unsigned char* S = (const unsigned char*)(p.ws + WS_UM) + (size_t)(((b * 4 + h) * NCH + j) * 2) * 16384;
#pragma unroll
        for (int i = 0; i < 4; ++i) { const int idx = tid + NTHR * i, row = idx >> 3, c = idx & 7; stc[i] = __builtin_nontemporal_load((const u32x4*)(S + (size_t)row * 128 + c * 16)); } }
#pragma unroll
    for (int i = 0; i < 2; ++i) { const int idx = tid + NTHR * i, t = idx >> 4, c = idx & 15;
        *(LAS u32x4*)(Q + t * 136 + c * 8) = R.q[i]; *(LAS u32x4*)(K + t * 136 + c * 8) = R.k[i]; *(LAS u32x4*)(VT + t * 136 + c * 8) = R.v[i]; *(LAS u32x4*)(GTt + t * 128 + c * 8) = R.gt[i]; }
    if (tid < 32) *(LAS f32x4*)(GN + tid * 4) = R.gn;
    if (tid < 64) {
        const int t = tid; const float ms = R.ms, a = scan_sum_up(logsigf(R.gf), t), c = R.gi - a, pm = scan_max_up(c, t), mt = a + fmaxf(ms, pm);
        CT[t] = c; RT[t] = a - mt; WT[t] = __expf(a + ms - mt); ET[t] = __expf(-mt);
    } else if (tid < 128) {
        const int t = tid - 64; const float ms = R.ms, a = scan_sum_down(logsigf(R.gf), t), c = R.gi - a, pm = scan_max_down(c, t), mt = a + fmaxf(ms, pm);
        CT[64 + t] = c; RT[64 + t] = a - mt; WT[64 + t] = __expf(a + ms - mt); ET[64 + t] = __expf(-mt);
    } else if (tid < 384) NV[tid - 128] = R.nv;
    __syncthreads();
    STGF(0, 0);
    if (itnext < 1024) m6_load(p, itnext, tid, R);
    STGF(0, 1);
    {
        const int dw = wave >> 2, tt = (wave >> 1) & 1, st = wave & 1; LAS bf16_t* Pd = dw == 0 ? PF : PB;
        f32x16 acc;
#pragma unroll
        for (int r = 0; r < 16; ++r) acc[r] = 0.f;
#pragma unroll
        for (int ks = 0; ks < 8; ++ks) acc = MFMA32(ldfrag(K, 136, st * 32, ks * 16, lane), ldfrag(Q, 136, tt * 32, ks * 16, lane), acc);
        const int t = tt * 32 + (lane & 31); const float rt = RT[dw * 64 + t];
#pragma unroll
        for (int rg = 0; rg < 4; ++rg) { const int sb = st * 32 + 8 * rg + 4 * (lane >> 5); const f32x4 cs = *(const LAS f32x4*)(CT + dw * 64 + sb); float v[4];
#pragma unroll
            for (int x = 0; x < 4; ++x) { const int s1 = sb + x; const bool ok = dw == 0 ? (s1 <= t) : (s1 >= t);
                const float wgt = __expf(fminf(rt + cs[x], 0.f)); v[x] = ok ? acc[4 * rg + x] * wgt : 0.f; }
            u32x2 w; w.x = pk2(v[0], v[1]); w.y = pk2(v[2], v[3]); *(LAS u32x2*)(Pd + t * 72 + sb) = w; }
    }
#pragma unroll
    for (int i = 0; i < 4; ++i) { const int idx = tid + NTHR * i, row = idx >> 3, c = idx & 7; const u32x4 w = stc[i];
        *(LAS u32x4*)(ST + row * 136 + c * 16) = fp8x8_to_bf16((u32x2){w.x, w.y}, 1.f / SM_SCALE); *(LAS u32x4*)(ST + row * 136 + c * 16 + 8) = fp8x8_to_bf16((u32x2){w.z, w.w}, 1.f / SM_SCALE); }
    __syncthreads();
    STGF(0, 2);
    {
        const int t = tid >> 3, seg = tid & 7;
        float rs0 = 0.f, rs1 = 0.f, qn0 = 0.f, qn1 = 0.f;
        { const u32x4 a = *(const LAS u32x4*)(PF + t * 72 + seg * 8), bq = *(const LAS u32x4*)(PB + t * 72 + seg * 8);
            rs0 = (bflo(a.x) + bfhi(a.x)) + (bflo(a.y) + bfhi(a.y)) + (bflo(a.z) + bfhi(a.z)) + (bflo(a.w) + bfhi(a.w));
            rs1 = (bflo(bq.x) + bfhi(bq.x)) + (bflo(bq.y) + bfhi(bq.y)) + (bflo(bq.z) + bfhi(bq.z)) + (bflo(bq.w) + bfhi(bq.w)); }
#pragma unroll
        for (int c = 0; c < 2; ++c) { const u32x4 qv = *(const LAS u32x4*)(Q + t * 136 + seg * 16 + c * 8);
            const f32x4 n0 = *(const LAS f32x4*)(NV + seg * 16 + c * 8), n1 = *(const LAS f32x4*)(NV + seg * 16 + c * 8 + 4), m0 = *(const LAS f32x4*)(NV + 128 + seg * 16 + c * 8), m1 = *(const LAS f32x4*)(NV + 128 + seg * 16 + c * 8 + 4);
            const float q0 = bflo(qv.x), q1 = bfhi(qv.x), q2 = bflo(qv.y), q3 = bfhi(qv.y), q4 = bflo(qv.z), q5 = bfhi(qv.z), q6 = bflo(qv.w), q7 = bfhi(qv.w);
            qn0 += q0 * n0.x + q1 * n0.y + q2 * n0.z + q3 * n0.w + q4 * n1.x + q5 * n1.y + q6 * n1.z + q7 * n1.w;
            qn1 += q0 * m0.x + q1 * m0.y + q2 * m0.z + q3 * m0.w + q4 * m1.x + q5 * m1.y + q6 * m1.z + q7 * m1.w; }
#pragma unroll
        for (int o = 1; o < 8; o <<= 1) { rs0 += __shfl_xor(rs0, o); rs1 += __shfl_xor(rs1, o); qn0 += __shfl_xor(qn0, o); qn1 += __shfl_xor(qn1, o); }
        if (seg == 0) { const float d0 = rs0 + WT[t] * qn0, d1 = rs1 + WT[64 + t] * qn1;
            INV[t] = rcpf(fmaxf(fabsf(d0), ET[t])); INV[64 + t] = rcpf(fmaxf(fabsf(d1), ET[64 + t])); }
    }
    const int tt = wave >> 2, vt = wave & 3;
    f32x16 af_, ab_;
#pragma unroll
    for (int r = 0; r < 16; ++r) { af_[r] = 0.f; ab_[r] = 0.f; }
#pragma unroll
    for (int ks = 0; ks < 4; ++ks) { const bf16x8 va = ldfrag_t(VT, 136, ks * 16, vt * 32, lane);
        af_ = MFMA32(va, ldfrag(PF, 72, tt * 32, ks * 16, lane), af_); ab_ = MFMA32(va, ldfrag(PB, 72, tt * 32, ks * 16, lane), ab_); }
    const int tl = tt * 32 + (lane & 31);
    { const float wf = WT[tl], wb = WT[64 + tl];
#pragma unroll
        for (int ks = 0; ks < 8; ++ks) { const u32x4 qa = __builtin_bit_cast(u32x4, ldfrag(Q, 136, tt * 32, ks * 16, lane));
            u32x4 qf, qb;
            qf.x = pk2(bflo(qa.x) * wf, bfhi(qa.x) * wf); qf.y = pk2(bflo(qa.y) * wf, bfhi(qa.y) * wf); qf.z = pk2(bflo(qa.z) * wf, bfhi(qa.z) * wf); qf.w = pk2(bflo(qa.w) * wf, bfhi(qa.w) * wf);
            qb.x = pk2(bflo(qa.x) * wb, bfhi(qa.x) * wb); qb.y = pk2(bflo(qa.y) * wb, bfhi(qa.y) * wb); qb.z = pk2(bflo(qa.z) * wb, bfhi(qa.z) * wb); qb.w = pk2(bflo(qa.w) * wb, bfhi(qa.w) * wb);
            af_ = MFMA32(ldfrag(ST, 136, vt * 32, ks * 16, lane), __builtin_bit_cast(bf16x8, qf), af_);
            ab_ = MFMA32(ldfrag(ST + 128 * 136, 136, vt * 32, ks * 16, lane), __builtin_bit_cast(bf16x8, qb), ab_); } }
    __syncthreads();
    STGF(0, 3);
    { const float i0 = INV[tl], i1 = INV[64 + tl]; LAS float* orow = O + tl * 132 + vt * 32 + 4 * (lane >> 5);
#pragma unroll
        for (int rg = 0; rg < 4; ++rg) *(LAS f32x4*)(orow + 8 * rg) = (f32x4){i0 * af_[4 * rg] + i1 * ab_[4 * rg], i0 * af_[4 * rg + 1] + i1 * ab_[4 * rg + 1], i0 * af_[4 * rg + 2] + i1 * ab_[4 * rg + 2], i0 * af_[4 * rg + 3] + i1 * ab_[4 * rg + 3]}; }
    __syncthreads();
    STGF(0, 4);
    head_norm_store<true>(p, O, GTt, GN, tok0, h, 512, tid);
    if (threadIdx.x == 0) *(LAS int*)(lds + LDS_NQ) = (int)gridDim.x + qid;
    __syncthreads();
    nn = *(const LAS int*)(lds + LDS_NQ);
    STGF(0, 5);
}

__device__ __forceinline__ void phase6(const P& p, LAS unsigned char* lds, G6Regs& R6, const bool pre) {
    const int tid = threadIdx.x;
    M6Regs RM;
    if ((int)blockIdx.x < 1024) m6_load(p, blockIdx.x, tid, RM);
    DYN_LOOP_R(R6, pre, g6_load, p6_gla, 1024, 2, 1);
    DYN_LOOP_R(RM, true, m6_load, p6_ml, 1024, 3, 0);
}

__device__ __forceinline__ void phase8_pre(const P& p, LAS unsigned char* lds) {
    const int tid = threadIdx.x;
    LAS bf16_t* RWB = (LAS bf16_t*)lds; LAS float* AB = (LAS float*)(lds + 99072);
    const float* mod = (const float*)(p.ws + WS_MOD);
    for (int k = tid; k < 1024; k += NTHR) {
        const f32x4 g = *(const f32x4*)(p.in[18] + k * 4);
        RWB[0 * 1032 + k] = (bf16_t)f2bf(g.x); RWB[1 * 1032 + k] = (bf16_t)f2bf(g.y); RWB[2 * 1032 + k] = (bf16_t)f2bf(g.z); RWB[3 * 1032 + k] = (bf16_t)f2bf(g.w);
#pragma unroll
        for (int q = 0; q < 8; ++q) { const f32x4 e = *(const f32x4*)(p.in[20] + k * 32 + q * 4);
            RWB[(4 + q * 4 + 0) * 1032 + k] = (bf16_t)f2bf(e.x); RWB[(4 + q * 4 + 1) * 1032 + k] = (bf16_t)f2bf(e.y); RWB[(4 + q * 4 + 2) * 1032 + k] = (bf16_t)f2bf(e.z); RWB[(4 + q * 4 + 3) * 1032 + k] = (bf16_t)f2bf(e.w); }
#pragma unroll
        for (int r = 36; r < 48; ++r) RWB[r * 1032 + k] = (bf16_t)0;
    }
    for (int i = tid; i < 4096; i += NTHR) { const int b = i >> 10, k = i & 1023;
        AB[(b * 2 + 0) * 1024 + k] = p.in[17][k] * (1.f + mod[b * 6144 + 4096 + k]); AB[(b * 2 + 1) * 1024 + k] = mod[b * 6144 + 3072 + k]; }
    __syncthreads();
}
__device__ __forceinline__ void phase8(const P& p, LAS unsigned char* lds, const bool pre_done) {
    const int tid = threadIdx.x, lane = tid & 63, wave = tid >> 6;
    LAS bf16_t* RWB = (LAS bf16_t*)lds; LAS float* AB = (LAS float*)(lds + 99072); LAS float* LG = (LAS float*)(lds + 131840) + wave * 768;
    const float* mod = (const float*)(p.ws + WS_MOD);
    if (!pre_done) phase8_pre(p, lds);
    bf16_t* H2 = (bf16_t*)(p.ws + WS_MQ);
    int* RT = (int*)(p.ws + WS_ROUTE); unsigned* CNT = (unsigned*)(p.ws + WS_CTL) + CW_CNT;
    const float* PSS = (const float*)(p.ws + WS_PSS);
    LAS float* LGA = (LAS float*)(lds + 131840);
    LAS int* LC = (LAS int*)(lds + 156416); LAS int* LB = LC + 32;
    const int r16 = lane & 15, kq = lane >> 4, gsub = wave & 3, kh = wave >> 2;
    for (int blk = blockIdx.x; blk < MX / 64; blk += gridDim.x) {
        const int grp = blk * 4 + gsub, row = grp * 16 + r16, b = grp >> 8;
        const f32x4 pq = *(const f32x4*)(PSS + (size_t)row * 16 + kq * 4);
        float ss = pq.x + pq.y + pq.z + pq.w;
        ss += __shfl_xor(ss, 16); ss += __shfl_xor(ss, 32);
        const float rstd = 1.f / sqrtf(ss * (1.f / D) + EPS);
        const bf16_t* src = (const bf16_t*)(p.ws + WS_X1) + (size_t)row * D + kh * 512 + kq * 8;
        const LAS float* al = AB + (b * 2) * 1024 + kh * 512 + kq * 8; const LAS float* be = al + 1024;
        bf16_t* hdst = H2 + (size_t)row * D + kh * 512 + kq * 8;
        f32x4 acc[3];
#pragma unroll
        for (int nt = 0; nt < 3; ++nt) acc[nt] = (f32x4){0.f, 0.f, 0.f, 0.f};
#pragma unroll 8
        for (int ks = 0; ks < 16; ++ks) {
            const u32x4 xr = __builtin_nontemporal_load((const u32x4*)(src + ks * 32));
            const f32x4 x0 = {bflo(xr.x), bfhi(xr.x), bflo(xr.y), bfhi(xr.y)}, x1 = {bflo(xr.z), bfhi(xr.z), bflo(xr.w), bfhi(xr.w)};
            const f32x4 a0 = *(const LAS f32x4*)(al + ks * 32), a1 = *(const LAS f32x4*)(al + ks * 32 + 4), b0 = *(const LAS f32x4*)(be + ks * 32), b1 = *(const LAS f32x4*)(be + ks * 32 + 4);
            const f32x4 h0 = x0 * rstd * a0 + b0, h1 = x1 * rstd * a1 + b1;
            u32x4 hw; hw.x = pk2(h0.x, h0.y); hw.y = pk2(h0.z, h0.w); hw.z = pk2(h1.x, h1.y); hw.w = pk2(h1.z, h1.w);
            *(u32x4*)(hdst + ks * 32) = hw;
            const bf16x8 af = __builtin_bit_cast(bf16x8, hw);
#pragma unroll
            for (int nt = 0; nt < 3; ++nt) { const bf16x8 bfr = *(const LAS bf16x8*)(RWB + (nt * 16 + r16) * 1032 + kh * 512 + ks * 32 + kq * 8);
                acc[nt] = __builtin_amdgcn_mfma_f32_16x16x32_bf16(af, bfr, acc[nt], 0, 0, 0); }
        }
        LAS float* LG = LGA + (kh * 4 + gsub) * 768;
#pragma unroll
        for (int nt = 0; nt < 3; ++nt)
#pragma unroll
            for (int r = 0; r < 4; ++r) LG[(kq * 4 + r) * 48 + nt * 16 + r16] = acc[nt][r];
        if (tid < 32) LC[tid] = 0;
        __syncthreads();
        int ea = 0, eb = 0, la = 0, lb = 0; float w0 = 0.f, w1 = 0.f;
        const bool sel = wave < 4 && lane < 16;
        if (sel) {
            const LAS float* lg0 = LGA + gsub * 768 + lane * 48; const LAS float* lg1 = lg0 + 4 * 768;
            float gl[4];
#pragma unroll
            for (int q = 0; q < 4; ++q) gl[q] = lg0[q] + lg1[q] + p.in[19][q];
            int gi = 0; float gm = gl[0];
#pragma unroll
            for (int q = 1; q < 4; ++q) if (gl[q] > gm) { gm = gl[q]; gi = q; }
            float den = 0.f;
#pragma unroll
            for (int q = 0; q < 4; ++q) den += __expf(gl[q] - gm);
            const float gwt = 1.f / den;
            float el[8];
#pragma unroll
            for (int q = 0; q < 8; ++q) el[q] = lg0[4 + gi * 8 + q] + lg1[4 + gi * 8 + q] + p.in[21][gi * 8 + q];
            int i0 = 0; float v0 = el[0];
#pragma unroll
            for (int q = 1; q < 8; ++q) if (el[q] > v0) { v0 = el[q]; i0 = q; }
            int i1 = -1; float v1 = -3.0e38f;
#pragma unroll
            for (int q = 0; q < 8; ++q) if (q != i0 && el[q] > v1) { v1 = el[q]; i1 = q; }
            const float e1 = __expf(v1 - v0); w0 = gwt / (1.f + e1); w1 = gwt * e1 / (1.f + e1);
            ea = gi * 8 + i0; eb = gi * 8 + i1;
            la = __hip_atomic_fetch_add(&LC[ea], 1, __ATOMIC_RELAXED, __HIP_MEMORY_SCOPE_WORKGROUP); lb = __hip_atomic_fetch_add(&LC[eb], 1, __ATOMIC_RELAXED, __HIP_MEMORY_SCOPE_WORKGROUP);
        }
        __syncthreads();
        if (tid < 32) { const int c = LC[tid]; LB[tid] = c > 0 ? (int)atomicAdd(&CNT[tid * 64], (unsigned)c) : 0; }
        __syncthreads();
        if (sel) { const int trow = grp * 16 + lane, ra = LB[ea] + la, rb = LB[eb] + lb; int* r = RT + (size_t)trow * 8; r[0] = ea; r[1] = eb; r[2] = ra; r[3] = rb; ((float*)r)[4] = w0; ((float*)r)[5] = w1;
            int* TOK = (int*)(p.ws + WS_TOK); TOK[ea * 16384 + ra] = trow; TOK[eb * 16384 + rb] = trow; }
        __syncthreads();
    }
}

__device__ __forceinline__ int build_tables(const P& p, LAS int* PST, LAS int* TEX) {
    const unsigned* CNT = (const unsigned*)(p.ws + WS_CTL) + CW_CNT;
    if (threadIdx.x < 64) {
        const int ln = threadIdx.x, e = ln & 31;
        const int cnt = ln < 32 ? (int)__hip_atomic_load(&CNT[e * 64], __ATOMIC_RELAXED, __HIP_MEMORY_SCOPE_AGENT) : 0;
        const int nt = (cnt + 255) >> 8, sh = (nt > 0 && cnt - ((nt - 1) << 8) <= 128) ? 1 : 0, pk = nt | (sh << 16);
        int inc = pk;
#pragma unroll
        for (int o = 1; o < 32; o <<= 1) { const int v = __shfl_up(inc, o); if (ln >= o) inc += v; }
        const int tot = __shfl(inc, 31), exc = inc - pk;
        const int tb = exc & 0xffff, sb = exc >> 16, ntl = tot & 0xffff, nshort = tot >> 16;
        if (ln < 32) { PST[e] = tb << 8; PST[40 + e] = cnt; if (e == 31) PST[32] = ntl << 8;
            const int pf = tb - sb;
            for (int t = 0; t < nt; ++t) { TEX[tb + t] = e;
                if (sh && t == nt - 1) TEX[192 + (ntl - nshort) + sb] = (tb + t) | (1 << 16); else TEX[192 + pf + t] = tb + t; } } }
    __syncthreads();
    return PST[32] >> 8;
}

struct A12 { int e0[2], e1[2], k0[2], k1[2]; float w0[2], w1[2]; u32x2 xr[2][4]; };
__device__ __forceinline__ void p12_load(const P& p, const int r0, const int lane, A12& a) {
    const int* RT = (const int*)(p.ws + WS_ROUTE);
#pragma unroll
    for (int q = 0; q < 2; ++q) { const int* r = RT + (size_t)(r0 + q) * 8; a.e0[q] = r[0]; a.e1[q] = r[1]; a.k0[q] = r[2]; a.k1[q] = r[3]; a.w0[q] = ((const float*)r)[4]; a.w1[q] = ((const float*)r)[5];
#pragma unroll
        for (int j = 0; j < 4; ++j) a.xr[q][j] = __builtin_nontemporal_load((const u32x2*)((const bf16_t*)(p.ws + WS_X1) + (size_t)(r0 + q) * D + 4 * lane + 256 * j)); }
}
__device__ __forceinline__ void phase12(const P& p, LAS unsigned char* lds, float* dstbase, const bool tabs_done, A12& pre, const bool pre_done) {
    const int tid = threadIdx.x, lane = tid & 63, wave = tid >> 6;
    LAS int* PST = (LAS int*)lds; if (!tabs_done) (void)build_tables(p, PST, PST + 128);
    const float* mod = (const float*)(p.ws + WS_MOD); const unsigned char* Y = (const unsigned char*)(p.ws + WS_Z);
    const int gw = blockIdx.x * 8 + wave, NGW = gridDim.x * 8;
    int r0 = gw * 2;
    if (!pre_done && r0 < MX) p12_load(p, r0, lane, pre);
    for (; r0 < MX; r0 += NGW * 2) {
        const A12 cur = pre;
        unsigned ya[2][4], yb[2][4];
#pragma unroll
        for (int q = 0; q < 2; ++q) { const int s0 = PST[cur.e0[q]] + cur.k0[q], s1 = PST[cur.e1[q]] + cur.k1[q];
#pragma unroll
            for (int j = 0; j < 4; ++j) { const int k = 4 * lane + 256 * j;
                ya[q][j] = __builtin_nontemporal_load((const unsigned*)(Y + (size_t)s0 * D + k)); yb[q][j] = __builtin_nontemporal_load((const unsigned*)(Y + (size_t)s1 * D + k)); } }
        if (r0 + NGW * 2 < MX) p12_load(p, r0 + NGW * 2, lane, pre);
#pragma unroll
        for (int q = 0; q < 2; ++q) { const int row = r0 + q; const float* g2 = mod + (size_t)(row >> 12) * 6144 + 5120;
            f32x4 v[4]; float ss = 0.f;
#pragma unroll
            for (int j = 0; j < 4; ++j) { const int k = 4 * lane + 256 * j; const f32x4 g = *(const f32x4*)(g2 + k);
                float fa[4], fb[4]; up4_fp8(ya[q][j], fa); up4_fp8(yb[q][j], fb);
                const float u0 = cur.w0[q] * (1.f / Y_SCALE), u1 = cur.w1[q] * (1.f / Y_SCALE);
                const u32x2 xr = cur.xr[q][j]; const f32x4 x1 = {bflo(xr.x), bfhi(xr.x), bflo(xr.y), bfhi(xr.y)};
                f32x4 m; m.x = u0 * fa[0] + u1 * fb[0]; m.y = u0 * fa[1] + u1 * fb[1]; m.z = u0 * fa[2] + u1 * fb[2]; m.w = u0 * fa[3] + u1 * fb[3];
                v[j] = x1 + g * m; ss += v[j].x * v[j].x + v[j].y * v[j].y + v[j].z * v[j].z + v[j].w * v[j].w; }
            const float rstd = 1.f / sqrtf(wave_sum(ss) * (1.f / D) + EPS);
#pragma unroll
            for (int j = 0; j < 4; ++j) { const int k = 4 * lane + 256 * j; const f32x4 g = *(const f32x4*)(p.in[24] + k); *(f32x4*)(dstbase + (size_t)row * D + k) = v[j] * rstd * g; } }
    }
}

constexpr int NPH = 13;
__global__ void __launch_bounds__(NTHR, 2) mega(P p) {
    extern __shared__ __attribute__((aligned(16))) unsigned char lds_raw[];
    LAS unsigned char* lds = (LAS unsigned char*)lds_raw;
    volatile LAS unsigned* xst = (volatile LAS unsigned*)(lds + LDS_XB);
    if (threadIdx.x < 2) xst[threadIdx.x] = 0u;
    __syncthreads();
    XcdBarrier xb = xcd_barrier_post((unsigned*)(p.ws + WS_CTL) + CW_BAR, xst);
    const unsigned long long tl0 = (TL_SEL >= 0) ? __builtin_amdgcn_s_memrealtime() : 0ull;
    const int lo = p.ph_lo, hi = p.ph_hi;
    const int G = gridDim.x, bx = blockIdx.x;
    const int vcu = (G % 8 == 0) ? (bx % 8) * (G / 8) + bx / 8 : bx;
    const int ncv = (CONV_BLOCKS && G == 256 && lo == 0 && hi > 2) ? CONV_BLOCKS : 0;
#ifndef PHASE_MASK
#define PRE4 1
#define PRETAB 1
#define PRE6 1
#define PRE8 1
#define PHASE_MASK 0x1fff
#endif
#define IN(k) (((PHASE_MASK >> (k)) & 1) && lo <= (k) && (k) < hi)
#define TL_SPIN(k) do { if (TL_SEL == (k) && bx == 0 && threadIdx.x == 0) { const unsigned long long e_ = __builtin_amdgcn_s_memrealtime() - tl0; const unsigned long long s_ = __builtin_amdgcn_s_memrealtime(); while (__builtin_amdgcn_s_memrealtime() - s_ < e_) __builtin_amdgcn_s_sleep(8); } } while (0)
#define SEAM(k) do { if ((k) + 1 < hi) { xcd_barrier(xb); TL_SPIN(k); } } while (0)
#define REPN(k) (1 + ((REP_MASK >> (k)) & 1))
    if (IN(0)) { _Pragma("nounroll") for (int rep = 0; rep < REPN(0); ++rep) { if (rep) xcd_barrier(xb); phase0(p, lds, ncv == 0); } for (int q = 0; q < EXTRA_SYNCS; ++q) xcd_barrier(xb); if (!(FUSE01 && N_LAUNCH_MODE == 1)) SEAM(0); }
    if (IN(1)) { _Pragma("nounroll") for (int rep = 0; rep < REPN(1); ++rep) { if (rep) xcd_barrier(xb); phase1(p); } SEAM(1); }
    if (IN(2)) {
        pg8::SchedDense S; S.nM = ncv ? MX / 256 : MT / 256; S.nN = NPADW / 256; S.nwg = S.nM * S.nN; S.nx = ncv ? 32 : 0; S.G = G - ncv; S.c = bx; S.K = 1024; S.brows = NPADW; S.A = (const char*)(p.ws + WS_A); S.Bt = (const char*)(p.ws + WS_WINT);
        EpiZ E; E.Z = (bf16_t*)(p.ws + WS_Z); E.G = (float*)(p.ws + WS_GATES);
        if (bx < G - ncv) pg8::gemm_phase(lds, 1024, S, E);
        else convert_experts(p, lds, bx - (G - ncv), ncv);
        SEAM(2); }
    if (IN(3) && IN(4) && SPLIT34) {
        phase3(p, lds);
        const XbTok tk = xcd_arrive(xb);
        phase4_gla(p, lds);
        xcd_wait_long(xb, tk);
        phase4_ml(p, lds);
        SEAM(4);
    } else {
        if (IN(3)) { phase3(p, lds); SEAM(3); }
        if (IN(4)) { phase4_gla(p, lds); phase4_ml(p, lds); SEAM(4); }
    }
    G6Regs R6;
    if (IN(5)) { phase5(p, lds);
        if (6 < hi) { if (PRE6) { const XbTok tk = xcd_arrive(xb); if ((int)bx < 1024) g6_load(p, bx, threadIdx.x, R6); xcd_wait(xb, tk); } else xcd_barrier(xb); TL_SPIN(5); } }
    if (IN(6)) { phase6(p, lds, R6, PRE6 && lo <= 5); SEAM(6); }
    if (IN(7)) {
        pg8::SchedDense S; S.nM = MX / 256; S.nN = 4; S.nwg = S.nM * S.nN; S.nx = 0; S.G = G; S.c = bx; S.K = 1024; S.brows = 1024; S.A = (const char*)(p.ws + WS_A); S.Bt = (const char*)(p.ws + WS_WOUTT);
        EpiX1 E; E.x = p.in[0]; E.mod = (const float*)(p.ws + WS_MOD); E.x1 = (bf16_t*)(p.ws + WS_X1); E.pss = (float*)(p.ws + WS_PSS);
        _Pragma("nounroll") for (int rep = 0; rep < REPN(7); ++rep) { if (rep) xcd_barrier(xb); pg8::gemm_phase(lds, 1024, S, E); }
        if (8 < hi) { if (PRE8) { const XbTok tk = xcd_arrive(xb); phase8_pre(p, lds); xcd_wait(xb, tk); } else xcd_barrier(xb); TL_SPIN(7); } }
    if (IN(8)) { _Pragma("nounroll") for (int rep = 0; rep < REPN(8); ++rep) { if (rep) { xcd_barrier(xb); if (bx == 0 && threadIdx.x < 32) ((unsigned*)(p.ws + WS_CTL))[CW_CNT + threadIdx.x * 64] = 0u; xcd_barrier(xb); } phase8(p, lds, PRE8 && rep == 0 && lo <= 7); } if (10 < hi) { xcd_barrier(xb); TL_SPIN(8); } }
    int nt11 = -1; bool tab12 = false, pre12 = false; A12 a12;
    if (IN(10)) {
        LAS int* PST = (LAS int*)(lds + MOE_TAB); LAS int* TEX = PST + 128;
        const int ntiles = build_tables(p, PST, TEX);
        pg8::SchedMoE S; S.mode = 1; S.ctl = (unsigned*)(p.ws + WS_CTL); S.ntiles = ntiles; S.G = G; S.c = vcu; S.K = 1024; S.brows = 1024; S.ord = TEX + 192; S.tex = TEX; S.pst = PST; S.cnt = PST + 40; S.tok = (const int*)(p.ws + WS_TOK); S.gather = true;
        S.A = (const char*)(p.ws + WS_MQ); S.Bt = (const char*)(p.ws + WS_E1T); S.bstride = (size_t)1024 * 1024 * 2;
        EpiH E; E.H = (bf16_t*)(p.ws + WS_UM);
        unsigned long long tacc = 0ull, tprev = (STAGE_SEL >= 0) ? __builtin_amdgcn_s_memrealtime() : 0ull;
        _Pragma("nounroll") for (int rep = 0; rep < REPN(10); ++rep) { if (rep) xcd_barrier(xb); pg8::gemm_phase<EpiH, pg8::SchedMoE, true>(lds, 1024, S, E); }
        STGF(4, 0);
        {
            const int rem = (ntiles * 4) % G, nslack = rem ? G - rem : G, sidx = rem ? vcu - rem : vcu;
            if (sidx >= 0) { const int wave = threadIdx.x >> 6, lane = threadIdx.x & 63; LAS float* scr = (LAS float*)(lds + wave * TR_SCR); bf16_t* E2T = (bf16_t*)(p.ws + WS_E2T);
                unsigned* e2c = (unsigned*)(p.ws + WS_CTL) + CW_E2;
                constexpr int NT2 = 32 * 8 * 16, THIRD = ((NT2 + 2) / 3 + 7) & ~7;
                for (int k = 0; k < 3; ++k)
                    for (int slot = sidx * 8 + wave; slot < THIRD; slot += nslack * 8) { const int r = k * THIRD + slot;
                        if (r < NT2) { const int e = r >> 7, q = r & 127;
                            transpose_item<true>(p.in[23] + (size_t)e * 512 * 1024, 512, 1024, 1024, E2T + (size_t)e * 1024 * 512, scr, q >> 4, q & 15, lane, RmId());
                            asm volatile("s_waitcnt vmcnt(0)" ::: "memory");
                            if (lane == 0) __hip_atomic_fetch_add(e2c + 16 * e, 1u, __ATOMIC_RELAXED, __HIP_MEMORY_SCOPE_AGENT); } } } }
        STGF(4, 1);
        STG_SPIN(4);
        if (11 < hi) { __syncthreads(); nt11 = ntiles; TL_SPIN(10); } }
    if (IN(11)) {
        LAS int* PST = (LAS int*)(lds + MOE_TAB); LAS int* TEX = PST + 128;
        const int ntiles = nt11 >= 0 ? nt11 : build_tables(p, PST, TEX);
        pg8::SchedMoE S; S.mode = 2; S.ctl = (unsigned*)(p.ws + WS_CTL); S.ntiles = ntiles; S.G = G; S.c = vcu; S.K = 512; S.brows = 1024; S.ord = TEX + 192; S.tex = TEX; S.pst = PST; S.cnt = PST + 40; S.tok = nullptr; S.gather = false; S.A = (const char*)(p.ws + WS_UM); S.Bt = (const char*)(p.ws + WS_E2T); S.bstride = (size_t)1024 * 512 * 2;
        EpiY E; E.Y = (unsigned char*)(p.ws + WS_Z);
        _Pragma("nounroll") for (int rep = 0; rep < REPN(11); ++rep) { if (rep) xcd_barrier(xb); pg8::gemm_phase(lds, 512, S, E); }
        if (12 < hi) { if (PRETAB) { const XbTok tk = xcd_arrive(xb); (void)build_tables(p, (LAS int*)lds, (LAS int*)lds + 128); tab12 = true;
                { const int r0_ = (bx * 8 + (int)(threadIdx.x >> 6)) * 2; if (r0_ < MX) { p12_load(p, r0_, threadIdx.x & 63, a12); pre12 = true; } }
                xcd_wait(xb, tk); } else xcd_barrier(xb); TL_SPIN(11); } }
    if (IN(12)) { phase12(p, lds, p.out, tab12, a12, pre12); }
#undef IN
#undef SEAM
}

extern "C" void kernel_launch(void* const* d_in, const int* in_sizes, int n_in, void* d_out, int out_size, void* d_ws, size_t ws_size, hipStream_t stream) {
    static int grid = 0;
    if (grid == 0) {
        if (n_in != 25 || out_size != MX * D || ws_size < WS_END) { fprintf(stderr, "kernel_launch: unexpected problem (n_in %d out %d ws %zu)\n", n_in, out_size, ws_size); grid = -1; return; }
        int dev = 0, cus = 0, per_cu = 0;
        hipGetDevice(&dev); hipDeviceGetAttribute(&cus, hipDeviceAttributeMultiprocessorCount, dev);
        if (hipFuncSetAttribute((const void*)mega, hipFuncAttributeMaxDynamicSharedMemorySize, LDS_BYTES) != hipSuccess) { fprintf(stderr, "kernel_launch: hipFuncSetAttribute failed\n"); grid = -1; return; }
        if (hipOccupancyMaxActiveBlocksPerMultiprocessor(&per_cu, (const void*)mega, NTHR, LDS_BYTES) != hipSuccess || per_cu < 1) { fprintf(stderr, "kernel_launch: occupancy query says %d\n", per_cu); per_cu = 1; }
        (void)hipGetLastError();
        grid = cus & ~7;
    }
    if (grid < 0) return;
    P a{};
    for (int i = 0; i < 25; ++i) a.in[i] = (const float*)d_in[i];
    a.out = (float*)d_out; a.ws = (unsigned char*)d_ws;
#if N_LAUNCH_MODE == 1
    a.ph_lo = 0; a.ph_hi = NPH;
    for (int rep = 0; rep < FWD_REPS; ++rep) {
        hipMemsetAsync((char*)d_ws + WS_CTL, 0, 64 * 1024, stream);
        void* args[] = {&a};
        hipError_t e = hipLaunchCooperativeKernel((const void*)mega, dim3(grid), dim3(NTHR), args, LDS_BYTES, stream);
        if (e != hipSuccess) fprintf(stderr, "cooperative launch failed: %s (grid %d)\n", hipGetErrorString(e), grid);
    }
#else
    hipMemsetAsync((char*)d_ws + WS_CTL, 0, 64 * 1024, stream);
    for (int ph = 0; ph < NPH; ++ph) { a.ph_lo = ph; a.ph_hi = ph + 1; hipLaunchKernelGGL(mega, dim3(grid), dim3(NTHR), LDS_BYTES, stream, a); }
#endif
}
```
